# Optimizing an MI355X kernel written in HIP

```python
import math
import jax, jax.numpy as jnp
from jax import lax
import numpy as np

D_MODEL = 1024
BATCH = 8
SEQ = 2048
DEPTH = 2

GLA_HEADS = 4
GLA_DK = 64
GLA_DV = 128
GLA_LOWRANK = 16
GLA_TAU = 16.0
GLA_CHUNK = 64
DIFF_HEADS = 4
DIFF_DQK = 64
DIFF_DV = 128
Q_BLOCK = 128
NUM_BUCKETS = 32
MAX_DISTANCE = 128
S5_GROUPS = 32
S5_GROUP_CH = 16
S5_STATE = 64
S5_WIDTH = S5_GROUPS * S5_GROUP_CH
S5_DT_MIN = 1e-3
S5_DT_MAX = 1e-1
D_FF = 2816
N_BRANCH = 3
ADA_CHUNKS = 9
EPS = 1e-6

GLA_QK_W = GLA_HEADS * GLA_DK
GLA_V_W = GLA_HEADS * GLA_DV
DIFF_QK_W = DIFF_HEADS * 2 * DIFF_DQK
DIFF_V_W = DIFF_HEADS * DIFF_DV
BRANCH_W = 512
SPLIT_WIDTHS = (GLA_QK_W, GLA_QK_W, GLA_V_W, GLA_V_W, GLA_LOWRANK,
                DIFF_QK_W, DIFF_QK_W, DIFF_V_W, S5_WIDTH, N_BRANCH * D_MODEL)
IN_W = 256 + 256 + 512 + 512 + 16 + 512 + 512 + 512 + 512 + 3 * 1024

kernel_name = 'hybrid_gla_diffattn_s5_macaron_block'


def rmsnorm(x, g):
    xf = x.astype(jnp.float32)
    y = xf * lax.rsqrt(jnp.mean(xf * xf, axis=-1, keepdims=True) + EPS)
    return (y * g.astype(jnp.float32)).astype(x.dtype)


def modulate(x, g, shift, scale):
    return rmsnorm(x, g) * (1.0 + scale[:, None, :]) + shift[:, None, :]


def swiglu(u, w_up, w_down):
    gu = u @ w_up
    gate, up = gu[..., :D_FF], gu[..., D_FF:]
    return (jax.nn.silu(gate) * up) @ w_down


def gla_mixer(q, k, v, r, a_low, w_alpha, b_alpha, norm_g):
    bsz, L, _ = q.shape
    n_chunks = L // GLA_CHUNK
    f32 = jnp.float32

    def heads(t, d):
        return t.astype(f32).reshape(bsz, n_chunks, GLA_CHUNK, GLA_HEADS, d).transpose(0, 3, 1, 2, 4)

    log_a = jax.nn.log_sigmoid((a_low @ w_alpha + b_alpha).astype(f32)) / GLA_TAU
    qh = heads(q, GLA_DK) * (GLA_DK ** -0.5)
    kh = heads(k, GLA_DK)
    vh = heads(v, GLA_DV)
    b = jnp.cumsum(heads(log_a, GLA_DK), axis=3)
    b_last = b[:, :, :, -1:, :]
    q_dec = qh * jnp.exp(b)
    k_dec = kh * jnp.exp(-b)
    causal = jnp.tril(jnp.ones((GLA_CHUNK, GLA_CHUNK), dtype=bool))
    att = jnp.where(causal, jnp.einsum('bhncd,bhnsd->bhncs', q_dec, k_dec), 0.0)
    o_intra = jnp.einsum('bhncs,bhnse->bhnce', att, vh)
    d_state = jnp.einsum('bhncd,bhnce->bhnde', kh * jnp.exp(b_last - b), vh)
    chunk_decay = jnp.exp(b_last[:, :, :, 0, :])

    def step(S, inp):
        dec, ds = inp
        return dec[..., None] * S + ds, S

    s0 = jnp.zeros((bsz, GLA_HEADS, GLA_DK, GLA_DV), f32)
    _, s_prev = lax.scan(step, s0, (jnp.moveaxis(chunk_decay, 2, 0), jnp.moveaxis(d_state, 2, 0)))
    s_prev = jnp.moveaxis(s_prev, 0, 2)
    o = o_intra + jnp.einsum('bhncd,bhnde->bhnce', q_dec, s_prev)
    o = o * lax.rsqrt(jnp.mean(o * o, axis=-1, keepdims=True) + EPS)
    o = o.transpose(0, 2, 3, 1, 4).reshape(bsz, L, GLA_V_W) * norm_g.astype(f32)
    return (o * jax.nn.silu(r.astype(f32))).astype(q.dtype)


def t5_bucket(dist):
    max_exact = NUM_BUCKETS // 2
    d = jnp.maximum(dist, 1).astype(jnp.float32)
    large = max_exact + (jnp.log(d / max_exact) / math.log(MAX_DISTANCE / max_exact)
                         * (NUM_BUCKETS - max_exact)).astype(jnp.int32)
    large = jnp.minimum(large, NUM_BUCKETS - 1)
    return jnp.where(dist < max_exact, dist, large)


def diff_attention(q, k, v, lam_vecs, lam_init, norm_g, rel_bias):
    bsz, L, _ = q.shape
    f32 = jnp.float32
    n_maps = 2 * DIFF_HEADS
    qm = q.astype(f32).reshape(bsz, L, n_maps, DIFF_DQK).transpose(0, 2, 1, 3) * (DIFF_DQK ** -0.5)
    km = k.astype(f32).reshape(bsz, L, n_maps, DIFF_DQK).transpose(0, 2, 1, 3)
    vh = v.reshape(bsz, L, DIFF_HEADS, DIFF_DV).transpose(0, 2, 1, 3)
    lv = lam_vecs.astype(f32)
    lam = jnp.exp(jnp.sum(lv[0] * lv[1])) - jnp.exp(jnp.sum(lv[2] * lv[3])) + lam_init
    outs = []
    for blk in range(L // Q_BLOCK):
        s, e = blk * Q_BLOCK, (blk + 1) * Q_BLOCK
        logits = jnp.einsum('bmqd,bmkd->bmqk', qm[:, :, s:e], km[:, :, :e])
        dist = jnp.arange(s, e)[:, None] - jnp.arange(e)[None, :]
        bias = rel_bias.astype(f32)[t5_bucket(jnp.maximum(dist, 0))].transpose(2, 0, 1)
        logits = jnp.where(dist >= 0, logits + bias, -jnp.inf)
        p = jax.nn.softmax(logits, axis=-1).reshape(bsz, DIFF_HEADS, 2, Q_BLOCK, e)
        a = p[:, :, 0] - lam * p[:, :, 1]
        outs.append(jnp.einsum('bhqk,bhkd->bhqd', a, vh[:, :, :e].astype(f32)))
    o = jnp.concatenate(outs, axis=2)
    o = o * lax.rsqrt(jnp.mean(o * o, axis=-1, keepdims=True) + EPS)
    o = o.transpose(0, 2, 1, 3).reshape(bsz, L, DIFF_V_W) * norm_g.astype(f32) * (1.0 - lam_init)
    return o.astype(q.dtype)


def s5_mixer(u, lam_re, lam_im, log_step, b_re, b_im, c_re, c_im, d_skip, w_glu, b_glu):
    bsz, L, _ = u.shape
    f32 = jnp.float32
    uf = u.astype(f32).reshape(bsz, L, S5_GROUPS, S5_GROUP_CH)
    lr, li = lam_re.astype(f32), lam_im.astype(f32)
    dt = jnp.exp(log_step.astype(f32))[:, None]
    mag = jnp.exp(lr * dt)
    abar_re, abar_im = mag * jnp.cos(li * dt), mag * jnp.sin(li * dt)
    nr, ni = abar_re - 1.0, abar_im
    den = lr * lr + li * li
    f_re = (nr * lr + ni * li) / den
    f_im = (ni * lr - nr * li) / den
    br, bi = b_re.astype(f32), b_im.astype(f32)
    bbar_re = f_re[..., None] * br - f_im[..., None] * bi
    bbar_im = f_re[..., None] * bi + f_im[..., None] * br
    bu_re = jnp.einsum('blgh,gph->blgp', uf, bbar_re)
    bu_im = jnp.einsum('blgh,gph->blgp', uf, bbar_im)
    a_re = jnp.broadcast_to(abar_re, bu_re.shape)
    a_im = jnp.broadcast_to(abar_im, bu_im.shape)

    def combine(e1, e2):
        a1r, a1i, b1r, b1i = e1
        a2r, a2i, b2r, b2i = e2
        return (a2r * a1r - a2i * a1i,
                a2r * a1i + a2i * a1r,
                a2r * b1r - a2i * b1i + b2r,
                a2r * b1i + a2i * b1r + b2i)

    _, _, xr, xi = lax.associative_scan(combine, (a_re, a_im, bu_re, bu_im), axis=1)
    y = (jnp.einsum('gnp,blgp->blgn', c_re.astype(f32), xr)
         - jnp.einsum('gnp,blgp->blgn', c_im.astype(f32), xi))
    y = y + d_skip.astype(f32) * uf
    y = jax.nn.gelu(y.reshape(bsz, L, S5_WIDTH))
    z = y @ w_glu.astype(f32) + b_glu.astype(f32)
    return (z[..., :S5_WIDTH] * jax.nn.sigmoid(z[..., S5_WIDTH:])).astype(u.dtype)


def hybrid_mixer(u, layer_idx, w_in, gla_w_alpha, gla_b_alpha, gla_norm, diff_lambda, diff_norm,
                 s5_lam_re, s5_lam_im, s5_log_step, s5_b_re, s5_b_im, s5_c_re, s5_c_im, s5_d,
                 s5_w_glu, s5_b_glu, w_branch, w_out, rel_bias):
    bsz, L, _ = u.shape
    proj = u @ w_in
    offsets = [int(o) for o in np.cumsum(SPLIT_WIDTHS)[:-1]]
    (g_q, g_k, g_v, g_r, g_a, d_q, d_k, d_v, s_u, gate_logits) = jnp.split(proj, offsets, axis=-1)
    y_gla = gla_mixer(g_q, g_k, g_v, g_r, g_a, gla_w_alpha, gla_b_alpha, gla_norm)
    lam_init = 0.8 - 0.6 * math.exp(-0.3 * layer_idx)
    y_diff = diff_attention(d_q, d_k, d_v, diff_lambda, lam_init, diff_norm, rel_bias)
    y_s5 = s5_mixer(s_u, s5_lam_re, s5_lam_im, s5_log_step, s5_b_re, s5_b_im, s5_c_re, s5_c_im,
                    s5_d, s5_w_glu, s5_b_glu)
    gates = jax.nn.sigmoid(gate_logits.astype(jnp.float32)).reshape(bsz, L, N_BRANCH, D_MODEL).astype(u.dtype)
    merged = (gates[:, :, 0] * (y_gla @ w_branch[0])
              + gates[:, :, 1] * (y_diff @ w_branch[1])
              + gates[:, :, 2] * (y_s5 @ w_branch[2]))
    return merged @ w_out


def setup_inputs(seed: int = 0) -> dict:
    key = jax.random.key(seed)
    ks = jax.random.split(key, 32)
    f32 = jnp.float32
    nrm = lambda k, shape, s: jax.random.normal(k, shape, f32) * s
    n_idx = jnp.arange(S5_STATE, dtype=f32)
    return {
        'x': nrm(ks[0], (BATCH, SEQ, D_MODEL), 1.0),
        'c': nrm(ks[1], (BATCH, D_MODEL), 1.0),
        'rel_bias': nrm(ks[2], (NUM_BUCKETS, 2 * DIFF_HEADS), 0.5),
        'w_ada': nrm(ks[3], (DEPTH, D_MODEL, ADA_CHUNKS * D_MODEL), D_MODEL ** -0.5),
        'b_ada': nrm(ks[4], (DEPTH, ADA_CHUNKS * D_MODEL), 0.02),
        'norm_pre': 1.0 + nrm(ks[5], (DEPTH, 3, D_MODEL), 0.05),
        'norm_post': 1.0 + nrm(ks[6], (DEPTH, 3, D_MODEL), 0.05),
        'ffn1_w_up': nrm(ks[7], (DEPTH, D_MODEL, 2 * D_FF), D_MODEL ** -0.5),
        'ffn1_w_down': nrm(ks[8], (DEPTH, D_FF, D_MODEL), D_FF ** -0.5),
        'ffn2_w_up': nrm(ks[9], (DEPTH, D_MODEL, 2 * D_FF), D_MODEL ** -0.5),
        'ffn2_w_down': nrm(ks[10], (DEPTH, D_FF, D_MODEL), D_FF ** -0.5),
        'w_in': nrm(ks[11], (DEPTH, D_MODEL, IN_W), D_MODEL ** -0.5),
        'gla_w_alpha': nrm(ks[12], (DEPTH, GLA_LOWRANK, GLA_QK_W), GLA_LOWRANK ** -0.5),
        'gla_b_alpha': nrm(ks[13], (DEPTH, GLA_QK_W), 0.1),
        'gla_norm': 1.0 + nrm(ks[14], (DEPTH, GLA_V_W), 0.05),
        'diff_lambda': nrm(ks[15], (DEPTH, 4, DIFF_DQK), 0.1),
        'diff_norm': 1.0 + nrm(ks[16], (DEPTH, DIFF_V_W), 0.05),
        's5_lam_re': -0.5 + nrm(ks[17], (DEPTH, S5_GROUPS, S5_STATE), 0.01),
        's5_lam_im': math.pi * n_idx + nrm(ks[18], (DEPTH, S5_GROUPS, S5_STATE), 0.01),
        's5_log_step': jax.random.uniform(ks[19], (DEPTH, S5_GROUPS), f32,
                                          math.log(S5_DT_MIN), math.log(S5_DT_MAX)),
        's5_b_re': nrm(ks[20], (DEPTH, S5_GROUPS, S5_STATE, S5_GROUP_CH), (2 * S5_GROUP_CH) ** -0.5),
        's5_b_im': nrm(ks[21], (DEPTH, S5_GROUPS, S5_STATE, S5_GROUP_CH), (2 * S5_GROUP_CH) ** -0.5),
        's5_c_re': nrm(ks[22], (DEPTH, S5_GROUPS, S5_GROUP_CH, S5_STATE), (2 * S5_STATE) ** -0.5),
        's5_c_im': nrm(ks[23], (DEPTH, S5_GROUPS, S5_GROUP_CH, S5_STATE), (2 * S5_STATE) ** -0.5),
        's5_d': nrm(ks[24], (DEPTH, S5_GROUPS, S5_GROUP_CH), 1.0),
        's5_w_glu': nrm(ks[25], (DEPTH, S5_WIDTH, 2 * S5_WIDTH), S5_WIDTH ** -0.5),
        's5_b_glu': nrm(ks[26], (DEPTH, 2 * S5_WIDTH), 0.02),
        'w_branch': nrm(ks[27], (DEPTH, N_BRANCH, BRANCH_W, D_MODEL), BRANCH_W ** -0.5),
        'w_out': nrm(ks[28], (DEPTH, D_MODEL, D_MODEL), D_MODEL ** -0.5),
    }


def reference(x, c, rel_bias, w_ada, b_ada, norm_pre, norm_post, ffn1_w_up, ffn1_w_down,
              ffn2_w_up, ffn2_w_down, w_in, gla_w_alpha, gla_b_alpha, gla_norm, diff_lambda,
              diff_norm, s5_lam_re, s5_lam_im, s5_log_step, s5_b_re, s5_b_im, s5_c_re, s5_c_im,
              s5_d, s5_w_glu, s5_b_glu, w_branch, w_out):
    h = x
    cond = jax.nn.silu(c)
    bsz = c.shape[0]
    for l in range(DEPTH):
        ada = (cond @ w_ada[l] + b_ada[l]).reshape(bsz, ADA_CHUNKS, D_MODEL)
        u = modulate(h, norm_pre[l, 0], ada[:, 0], ada[:, 1])
        y = swiglu(u, ffn1_w_up[l], ffn1_w_down[l])
        h = h + 0.5 * ada[:, 2][:, None, :] * rmsnorm(y, norm_post[l, 0])
        u = modulate(h, norm_pre[l, 1], ada[:, 3], ada[:, 4])
        y = hybrid_mixer(u, l, w_in[l], gla_w_alpha[l], gla_b_alpha[l], gla_norm[l], diff_lambda[l],
                         diff_norm[l], s5_lam_re[l], s5_lam_im[l], s5_log_step[l], s5_b_re[l],
                         s5_b_im[l], s5_c_re[l], s5_c_im[l], s5_d[l], s5_w_glu[l], s5_b_glu[l],
                         w_branch[l], w_out[l], rel_bias)
        h = h + ada[:, 5][:, None, :] * rmsnorm(y, norm_post[l, 1])
        u = modulate(h, norm_pre[l, 2], ada[:, 6], ada[:, 7])
        y = swiglu(u, ffn2_w_up[l], ffn2_w_down[l])
        h = h + 0.5 * ada[:, 8][:, None, :] * rmsnorm(y, norm_post[l, 2])
    return h
```

```cpp
#include <hip/hip_runtime.h>
#include <cstdio>
#include <cstdint>
#include <cmath>

constexpr int D = 1024, BATCH = 8, SEQ = 2048, DEPTH = 2, M = BATCH * SEQ;
constexpr int DFF = 2816, INW = 6672, PW = 6912;
constexpr int ADA = 9 * D;
constexpr float EPS = 1e-6f;
constexpr float LOG2E = 1.4426950408889634f;
constexpr float QSCALE = 0.125f * LOG2E;
constexpr int C_DQ = 0, C_DK = 512, C_DV = 1024, C_GQ = 1536, C_GK = 1792, C_GR = 2048, C_GV = 2560, C_SU = 3072, C_GATE = 3584, C_GA = 6656;
constexpr int C_O = C_GQ;
constexpr int C_YGLA = C_GV, C_YDIFF = C_DV, C_YS5PRE = C_SU, C_YS5 = C_DQ, C_MERGED = C_GQ;

typedef unsigned short bf16_t;
typedef short bf16x8 __attribute__((ext_vector_type(8)));
typedef float f32x4 __attribute__((ext_vector_type(4)));
__device__ __forceinline__ float bf2f(bf16_t v) { return __uint_as_float(((unsigned)v) << 16); }
__device__ __forceinline__ bf16_t f2bf(float f) { unsigned u = __float_as_uint(f); return (bf16_t)((u + 0x7fffu + ((u >> 16) & 1u)) >> 16); }
__device__ __forceinline__ float sigmoidf_(float x) { return 1.f / (1.f + __expf(-x)); }
__device__ __forceinline__ float siluf_(float x) { return x / (1.f + __expf(-x)); }
__device__ __forceinline__ float wave_sum(float v) {
#pragma unroll
    for (int o = 1; o < 64; o <<= 1) v += __shfl_xor(v, o);
    return v;
}
__device__ __forceinline__ float wave_max(float v) {
#pragma unroll
    for (int o = 1; o < 64; o <<= 1) v = fmaxf(v, __shfl_xor(v, o));
    return v;
}
__device__ __forceinline__ int ref2my(int c) {
    if (c < 256) return C_GQ + c;
    if (c < 512) return C_GK + (c - 256);
    if (c < 1024) return C_GV + (c - 512);
    if (c < 1536) return C_GR + (c - 1024);
    if (c < 1552) return C_GA + (c - 1536);
    if (c < 2064) return C_DQ + (c - 1552);
    if (c < 2576) return C_DK + (c - 2064);
    if (c < 3088) return C_DV + (c - 2576);
    if (c < 3600) return C_SU + (c - 3088);
    return C_GATE + (c - 3600);
}
__device__ const unsigned char T5B[128] = {0, 1, 2, 3, 4, 5, 6, 7, 8, 9, 10, 11, 12, 13, 14, 15, 16, 16, 16, 17, 17, 18, 18, 18, 19, 19, 19, 20, 20, 20, 20, 21, 21, 21, 21, 22, 22, 22, 22, 22, 23, 23, 23, 23, 23, 23, 24, 24, 24, 24, 24, 24, 25, 25, 25, 25, 25, 25, 25, 26, 26, 26, 26, 26, 26, 26, 26, 27, 27, 27, 27, 27, 27, 27, 27, 27, 27, 28, 28, 28, 28, 28, 28, 28, 28, 28, 28, 29, 29, 29, 29, 29, 29, 29, 29, 29, 29, 29, 29, 30, 30, 30, 30, 30, 30, 30, 30, 30, 30, 30, 30, 30, 30, 31, 31, 31, 31, 31, 31, 31, 31, 31, 31, 31, 31, 31, 31, 31};

constexpr size_t MiB = 1u << 20;
constexpr size_t WS_CTL = 0, WS_ADA = 1 * MiB, WS_S5ST = 2 * MiB, WS_W = 6 * MiB, WS_U = 59 * MiB, WS_GLA = 91 * MiB, WS_R0 = 123 * MiB, WS_END = 339 * MiB;
constexpr size_t WS_Y = WS_GLA;
constexpr size_t R0_HID = 0, R0_PROJ = 0;

__global__ __launch_bounds__(256) void k_ada(const float* c, const float* w_ada, const float* b_ada, float* ada) {
    __shared__ float cond[BATCH][D];
    for (int i = threadIdx.x; i < BATCH * D; i += 256) cond[i / D][i % D] = siluf_(c[i]);
    __syncthreads();
    const int idx = blockIdx.x * 256 + threadIdx.x;
    const int l = idx / ADA, col = idx % ADA;
    float acc[BATCH];
#pragma unroll
    for (int b = 0; b < BATCH; ++b) acc[b] = 0.f;
    const float* w = w_ada + (size_t)l * D * ADA + col;
    for (int k = 0; k < D; ++k) {
        const float wv = w[(size_t)k * ADA];
#pragma unroll
        for (int b = 0; b < BATCH; ++b) acc[b] += cond[b][k] * wv;
    }
    const float bb = b_ada[l * ADA + col];
#pragma unroll
    for (int b = 0; b < BATCH; ++b) ada[((size_t)l * BATCH + b) * ADA + col] = acc[b] + bb;
}

__global__ __launch_bounds__(256) void k_rowpass(const float* h_in, float* h_out, const bf16_t* y, const float* gpost, const float* gate, float coef,
                                                 const float* gpre, const float* shift, const float* scale, bf16_t* u) {
    const int lane = threadIdx.x & 63, row = blockIdx.x * 4 + (threadIdx.x >> 6), b = row / SEQ;
    f32x4 hv[4];
#pragma unroll
    for (int j = 0; j < 4; ++j) hv[j] = *(const f32x4*)(h_in + (size_t)row * D + j * 256 + lane * 4);
    if (y) {
        float yv[4][4]; float ss = 0.f;
#pragma unroll
        for (int j = 0; j < 4; ++j) {
            const uint2 raw = *(const uint2*)(y + (size_t)row * D + j * 256 + lane * 4);
            yv[j][0] = __uint_as_float(raw.x << 16); yv[j][1] = __uint_as_float(raw.x & 0xffff0000u);
            yv[j][2] = __uint_as_float(raw.y << 16); yv[j][3] = __uint_as_float(raw.y & 0xffff0000u);
#pragma unroll
            for (int i = 0; i < 4; ++i) ss += yv[j][i] * yv[j][i];
        }
        const float r = rsqrtf(wave_sum(ss) * (1.f / D) + EPS);
#pragma unroll
        for (int j = 0; j < 4; ++j) {
            const int c0 = j * 256 + lane * 4;
            const f32x4 gp = *(const f32x4*)(gpost + c0), gt = *(const f32x4*)(gate + (size_t)b * ADA + c0);
#pragma unroll
            for (int i = 0; i < 4; ++i) hv[j][i] += coef * gt[i] * (yv[j][i] * r * gp[i]);
        }
    }
    if (y || h_in != h_out) {
#pragma unroll
        for (int j = 0; j < 4; ++j) *(f32x4*)(h_out + (size_t)row * D + j * 256 + lane * 4) = hv[j];
    }
    if (u) {
        float ss = 0.f;
#pragma unroll
        for (int j = 0; j < 4; ++j)
#pragma unroll
            for (int i = 0; i < 4; ++i) ss += hv[j][i] * hv[j][i];
        const float r = rsqrtf(wave_sum(ss) * (1.f / D) + EPS);
#pragma unroll
        for (int j = 0; j < 4; ++j) {
            const int c0 = j * 256 + lane * 4;
            const f32x4 g = *(const f32x4*)(gpre + c0), sh = *(const f32x4*)(shift + (size_t)b * ADA + c0), sc = *(const f32x4*)(scale + (size_t)b * ADA + c0);
            float o[4];
#pragma unroll
            for (int i = 0; i < 4; ++i) o[i] = hv[j][i] * r * g[i] * (1.f + sc[i]) + sh[i];
            uint2 w; w.x = (unsigned)f2bf(o[0]) | ((unsigned)f2bf(o[1]) << 16); w.y = (unsigned)f2bf(o[2]) | ((unsigned)f2bf(o[3]) << 16);
            *(uint2*)(u + (size_t)row * D + c0) = w;
        }
    }
}

template <class Epi, bool DUAL>
__global__ __launch_bounds__(256) void k_ngemm(const bf16_t* A, int lda, const float* W, int ldw, int N, int K, int pair_off, Epi epi) {
    __shared__ __attribute__((aligned(16))) bf16_t As[64][40];
    __shared__ __attribute__((aligned(16))) bf16_t Bs[2][64][40];
    const int t = threadIdx.x, lane = t & 63, w = t >> 6, fr = lane & 15, fq = lane >> 4;
    const int m0 = blockIdx.y * 64, n0 = blockIdx.x * 64;
    f32x4 acc[4], acc2[4];
#pragma unroll
    for (int i = 0; i < 4; ++i) { acc[i] = (f32x4){0.f, 0.f, 0.f, 0.f}; acc2[i] = (f32x4){0.f, 0.f, 0.f, 0.f}; }
    for (int k0 = 0; k0 < K; k0 += 32) {
        { const int r = t >> 2, ch = t & 3; *(uint4*)&As[r][ch * 8] = *(const uint4*)(A + (size_t)(m0 + r) * lda + k0 + ch * 8); }
        { const int k = t >> 3, nc = t & 7;
#pragma unroll
          for (int i = 0; i < 8; ++i) { const int n = n0 + nc * 8 + i;
              Bs[0][nc * 8 + i][k] = (n < N) ? f2bf(W[(size_t)(k0 + k) * ldw + n]) : (bf16_t)0;
              if (DUAL) Bs[1][nc * 8 + i][k] = (n < N) ? f2bf(W[(size_t)(k0 + k) * ldw + n + pair_off]) : (bf16_t)0; } }
        __syncthreads();
        const bf16x8 a = *(const bf16x8*)&As[16 * w + fr][fq * 8];
#pragma unroll
        for (int nt = 0; nt < 4; ++nt) {
            const bf16x8 b = *(const bf16x8*)&Bs[0][16 * nt + fr][fq * 8];
            acc[nt] = __builtin_amdgcn_mfma_f32_16x16x32_bf16(a, b, acc[nt], 0, 0, 0);
            if (DUAL) { const bf16x8 b2 = *(const bf16x8*)&Bs[1][16 * nt + fr][fq * 8]; acc2[nt] = __builtin_amdgcn_mfma_f32_16x16x32_bf16(a, b2, acc2[nt], 0, 0, 0); }
        }
        __syncthreads();
    }
#pragma unroll
    for (int nt = 0; nt < 4; ++nt)
#pragma unroll
        for (int j = 0; j < 4; ++j) { const int row = m0 + 16 * w + fq * 4 + j, col = n0 + 16 * nt + fr; if (col < N) epi(row, col, acc[nt][j], acc2[nt][j]); }
}
struct EpiUp { bf16_t* hid; __device__ void operator()(int r, int c, float g, float u) const { hid[(size_t)r * DFF + c] = f2bf(siluf_(g) * u); } };
struct EpiY { bf16_t* y; __device__ void operator()(int r, int c, float v, float) const { y[(size_t)r * D + c] = f2bf(v); } };
struct EpiProj { bf16_t* proj; __device__ void operator()(int r, int c, float v, float) const { const int mc = ref2my(c);
    if (mc < C_DK) v *= QSCALE; else if (mc >= C_GQ && mc < C_GK) v *= 0.125f; proj[(size_t)r * PW + mc] = f2bf(v); } };
struct EpiGlu { bf16_t* out; const float* bias; __device__ void operator()(int r, int c, float a, float g) const { out[(size_t)r * PW + c] = f2bf((a + bias[c]) * sigmoidf_(g + bias[512 + c])); } };
struct EpiBranch { bf16_t* proj; int i; __device__ void operator()(int r, int c, float v, float) const {
    const float g = sigmoidf_(bf2f(proj[(size_t)r * PW + C_GATE + i * D + c])); bf16_t* o = proj + (size_t)r * PW + C_MERGED + c;
    const float prev = (i == 0) ? 0.f : bf2f(*o); *o = f2bf(prev + g * v); } };

__global__ __launch_bounds__(256) void k_gla_naive(bf16_t* proj, const float* w_alpha, const float* b_alpha, const float* norm_g) {
    const int b = blockIdx.x >> 2, h = blockIdx.x & 3, t = threadIdx.x, lane = t & 63, e = t & 127, half = t >> 7;
    __shared__ float sa[64], sq[64], sk[64], part[2][128], red[2];
    float S[32];
#pragma unroll
    for (int i = 0; i < 32; ++i) S[i] = 0.f;
    float wa[16]; float ba = 0.f;
    if (t < 64) { for (int j = 0; j < 16; ++j) wa[j] = w_alpha[j * 256 + h * 64 + t]; ba = b_alpha[h * 64 + t]; }
    const float ng = norm_g[h * 128 + e];
    for (int s = 0; s < SEQ; ++s) {
        bf16_t* row = proj + (size_t)(b * SEQ + s) * PW;
        if (t < 64) {
            float z = ba;
#pragma unroll
            for (int j = 0; j < 16; ++j) z += bf2f(row[C_GA + j]) * wa[j];
            const float ls = fminf(z, 0.f) - log1pf(__expf(-fabsf(z)));
            sa[t] = __expf(ls * (1.f / 16.f)); sq[t] = bf2f(row[C_GQ + h * 64 + t]); sk[t] = bf2f(row[C_GK + h * 64 + t]);
        }
        const float v = bf2f(row[C_GV + h * 128 + e]);
        const float rr = bf2f(row[C_GR + h * 128 + e]);
        __syncthreads();
        float p = 0.f;
#pragma unroll
        for (int i = 0; i < 32; ++i) { const int d = half * 32 + i; S[i] = sa[d] * S[i] + sk[d] * v; p += sq[d] * S[i]; }
        part[half][e] = p;
        __syncthreads();
        float o = 0.f;
        if (t < 128) { o = part[0][e] + part[1][e]; const float ss = wave_sum(o * o); if (lane == 0) red[t >> 6] = ss; }
        __syncthreads();
        if (t < 128) { const float r = rsqrtf((red[0] + red[1]) * (1.f / 128.f) + EPS); row[C_YGLA + h * 128 + e] = f2bf(o * r * ng * siluf_(rr)); }
        __syncthreads();
    }
}

__global__ __launch_bounds__(64) void k_s5_naive(bf16_t* proj, const float* lam_re, const float* lam_im, const float* log_step, const float* b_re, const float* b_im,
                                                 const float* c_re, const float* c_im, const float* d_skip) {
    const int b = blockIdx.x >> 5, g = blockIdx.x & 31, p = threadIdx.x;
    const float lr = lam_re[g * 64 + p], li = lam_im[g * 64 + p], dt = expf(log_step[g]);
    const float mag = expf(lr * dt), ar = mag * cosf(li * dt), ai = mag * sinf(li * dt);
    const float nr = ar - 1.f, ni = ai, den = lr * lr + li * li, fre = (nr * lr + ni * li) / den, fim = (ni * lr - nr * li) / den;
    float bbr[16], bbi[16], cr[16], ci[16];
#pragma unroll
    for (int h = 0; h < 16; ++h) { const float br = b_re[(g * 64 + p) * 16 + h], bi = b_im[(g * 64 + p) * 16 + h]; bbr[h] = fre * br - fim * bi; bbi[h] = fre * bi + fim * br;
        cr[h] = c_re[(g * 16 + h) * 64 + p]; ci[h] = c_im[(g * 16 + h) * 64 + p]; }
    const float dsk = (p < 16) ? d_skip[g * 16 + p] : 0.f;
    float xr = 0.f, xi = 0.f;
    for (int s = 0; s < SEQ; ++s) {
        bf16_t* row = proj + (size_t)(b * SEQ + s) * PW + C_SU + g * 16;
        float u[16];
#pragma unroll
        for (int h = 0; h < 16; ++h) u[h] = bf2f(row[h]);
        float bur = 0.f, bui = 0.f;
#pragma unroll
        for (int h = 0; h < 16; ++h) { bur += bbr[h] * u[h]; bui += bbi[h] * u[h]; }
        const float nxr = ar * xr - ai * xi + bur, nxi = ar * xi + ai * xr + bui; xr = nxr; xi = nxi;
        float yn = 0.f;
#pragma unroll
        for (int n = 0; n < 16; ++n) { const float v = wave_sum(cr[n] * xr - ci[n] * xi); if (p == n) yn = v + dsk * u[n]; }
        if (p < 16) { const float x3 = yn * yn * yn; const float gl = 0.5f * yn * (1.f + tanhf(0.7978845608028654f * (yn + 0.044715f * x3))); row[p] = f2bf(gl); }
    }
}

__global__ __launch_bounds__(256) void k_attn_naive(bf16_t* proj, const float* rel_bias) {
    __shared__ float sc[4][SEQ];
    __shared__ float sq[4][64];
    const int w = threadIdx.x >> 6, lane = threadIdx.x & 63;
    const int gw = blockIdx.x * 4 + w;
    const int q = gw % SEQ, m = (gw / SEQ) % 8, b = gw / (SEQ * 8);
    const bf16_t* base = proj + (size_t)b * SEQ * PW;
    sq[w][lane] = bf2f(base[(size_t)q * PW + C_DQ + m * 64 + lane]);
    __syncthreads();
    float mx = -INFINITY;
    for (int s0 = 0; s0 <= q; s0 += 64) {
        const int s = s0 + lane;
        float v = -INFINITY;
        if (s <= q) {
            const bf16_t* kr = base + (size_t)s * PW + C_DK + m * 64; float a = 0.f;
            for (int d = 0; d < 64; ++d) a += sq[w][d] * bf2f(kr[d]);
            const int dist = q - s; const int bk = T5B[dist < 127 ? dist : 127];
            v = a + rel_bias[bk * 8 + m] * LOG2E;
        }
        sc[w][s] = v; mx = fmaxf(mx, v);
    }
    mx = wave_max(mx);
    float sum = 0.f;
    for (int s0 = 0; s0 <= q; s0 += 64) { const int s = s0 + lane; if (s <= q) { const float pz = exp2f(sc[w][s] - mx); sc[w][s] = pz; sum += pz; } }
    sum = wave_sum(sum);
    __syncthreads();
    const int hh = m >> 1; float o0 = 0.f, o1 = 0.f;
    for (int s = 0; s <= q; ++s) { const float pz = sc[w][s]; const unsigned vv = *(const unsigned*)(base + (size_t)s * PW + C_DV + hh * 128 + lane * 2);
        o0 += pz * __uint_as_float(vv << 16); o1 += pz * __uint_as_float(vv & 0xffff0000u); }
    __syncthreads();
    const float inv = 1.f / sum;
    bf16_t* orow = proj + (size_t)(b * SEQ + q) * PW + C_O + m * 128 + lane * 2;
    *(unsigned*)orow = (unsigned)f2bf(o0 * inv) | ((unsigned)f2bf(o1 * inv) << 16);
}

__global__ __launch_bounds__(256) void k_diff_fin(bf16_t* proj, const float* lamv, const float* norm_g, float lam_init) {
    const int lane = threadIdx.x & 63, row = blockIdx.x * 4 + (threadIdx.x >> 6);
    const float lam = __expf(wave_sum(lamv[lane] * lamv[64 + lane])) - __expf(wave_sum(lamv[128 + lane] * lamv[192 + lane])) + lam_init;
    bf16_t* r = proj + (size_t)row * PW;
#pragma unroll
    for (int h = 0; h < 4; ++h) {
        const unsigned a = *(const unsigned*)(r + C_O + (2 * h) * 128 + lane * 2), c = *(const unsigned*)(r + C_O + (2 * h + 1) * 128 + lane * 2);
        const float o0 = __uint_as_float(a << 16) - lam * __uint_as_float(c << 16), o1 = __uint_as_float(a & 0xffff0000u) - lam * __uint_as_float(c & 0xffff0000u);
        const float rs = rsqrtf(wave_sum(o0 * o0 + o1 * o1) * (1.f / 128.f) + EPS) * (1.f - lam_init);
        const float g0 = norm_g[h * 128 + lane * 2], g1 = norm_g[h * 128 + lane * 2 + 1];
        *(unsigned*)(r + C_YDIFF + h * 128 + lane * 2) = (unsigned)f2bf(o0 * rs * g0) | ((unsigned)f2bf(o1 * rs * g1) << 16);
    }
}

extern "C" void kernel_launch(void* const* d_in, const int* in_sizes, int n_in, void* d_out, int out_size, void* d_ws, size_t ws_size, hipStream_t stream) {
    if (n_in != 29 || in_sizes[0] != M * D || out_size != M * D || ws_size < WS_END) {
        fprintf(stderr, "kernel_launch: unexpected shapes/workspace: n_in %d in0 %d out %d ws %zu (need %zu)\n", n_in, n_in > 0 ? in_sizes[0] : -1, out_size, ws_size, (size_t)WS_END);
        return;
    }
    const float* x = (const float*)d_in[0]; const float* c = (const float*)d_in[1]; const float* rel_bias = (const float*)d_in[2];
    const float* w_ada = (const float*)d_in[3]; const float* b_ada = (const float*)d_in[4]; const float* norm_pre = (const float*)d_in[5]; const float* norm_post = (const float*)d_in[6];
    const float* f1u = (const float*)d_in[7]; const float* f1d = (const float*)d_in[8]; const float* f2u = (const float*)d_in[9]; const float* f2d = (const float*)d_in[10];
    const float* w_in = (const float*)d_in[11]; const float* gwa = (const float*)d_in[12]; const float* gba = (const float*)d_in[13]; const float* gnorm = (const float*)d_in[14];
    const float* dlam = (const float*)d_in[15]; const float* dnorm = (const float*)d_in[16];
    const float* s_lr = (const float*)d_in[17]; const float* s_li = (const float*)d_in[18]; const float* s_ls = (const float*)d_in[19];
    const float* s_br = (const float*)d_in[20]; const float* s_bi = (const float*)d_in[21]; const float* s_cr = (const float*)d_in[22]; const float* s_ci = (const float*)d_in[23];
    const float* s_d = (const float*)d_in[24]; const float* s_wg = (const float*)d_in[25]; const float* s_bg = (const float*)d_in[26];
    const float* w_br = (const float*)d_in[27]; const float* w_out = (const float*)d_in[28];
    unsigned char* ws = (unsigned char*)d_ws;
    float* ada = (float*)(ws + WS_ADA); bf16_t* u = (bf16_t*)(ws + WS_U); bf16_t* y = (bf16_t*)(ws + WS_Y);
    bf16_t* hid = (bf16_t*)(ws + WS_R0 + R0_HID); bf16_t* proj = (bf16_t*)(ws + WS_R0 + R0_PROJ);
    float* h = (float*)d_out;

    k_ada<<<DEPTH * ADA / 256, 256, 0, stream>>>(c, w_ada, b_ada, ada);
    for (int l = 0; l < DEPTH; ++l) {
        const float* adal = ada + (size_t)l * BATCH * ADA;
        const float* npre = norm_pre + l * 3 * D; const float* npost = norm_post + l * 3 * D;
        if (l == 0) k_rowpass<<<M / 4, 256, 0, stream>>>(x, h, nullptr, nullptr, nullptr, 0.f, npre, adal + 0 * D, adal + 1 * D, u);
        k_ngemm<EpiUp, true><<<dim3(DFF / 64, M / 64), 256, 0, stream>>>(u, D, f1u + (size_t)l * D * 2 * DFF, 2 * DFF, DFF, D, DFF, EpiUp{hid});
        k_ngemm<EpiY, false><<<dim3(D / 64, M / 64), 256, 0, stream>>>(hid, DFF, f1d + (size_t)l * DFF * D, D, D, DFF, 0, EpiY{y});
        k_rowpass<<<M / 4, 256, 0, stream>>>(h, h, y, npost + 0 * D, adal + 2 * D, 0.5f, npre + 1 * D, adal + 3 * D, adal + 4 * D, u);
        k_ngemm<EpiProj, false><<<dim3((INW + 63) / 64, M / 64), 256, 0, stream>>>(u, D, w_in + (size_t)l * D * INW, INW, INW, D, 0, EpiProj{proj});
        k_gla_naive<<<BATCH * 4, 256, 0, stream>>>(proj, gwa + l * 16 * 256, gba + l * 256, gnorm + l * 512);
        k_s5_naive<<<BATCH * 32, 64, 0, stream>>>(proj, s_lr + l * 2048, s_li + l * 2048, s_ls + l * 32, s_br + l * 32768, s_bi + l * 32768, s_cr + l * 32768, s_ci + l * 32768, s_d + l * 512);
        k_attn_naive<<<BATCH * 8 * SEQ / 4, 256, 0, stream>>>(proj, rel_bias);
        const float lam_init = 0.8f - 0.6f * expf(-0.3f * (float)l);
        k_diff_fin<<<M / 4, 256, 0, stream>>>(proj, dlam + l * 256, dnorm + l * 512, lam_init);
        k_ngemm<EpiGlu, true><<<dim3(512 / 64, M / 64), 256, 0, stream>>>(proj + C_YS5PRE, PW, s_wg + (size_t)l * 512 * 1024, 1024, 512, 512, 512, EpiGlu{proj + C_YS5, s_bg + l * 1024});
        const int ycol[3] = {C_YGLA, C_YDIFF, C_YS5};
        for (int i = 0; i < 3; ++i)
            k_ngemm<EpiBranch, false><<<dim3(D / 64, M / 64), 256, 0, stream>>>(proj + ycol[i], PW, w_br + ((size_t)l * 3 + i) * 512 * D, D, D, 512, 0, EpiBranch{proj, i});
        k_ngemm<EpiY, false><<<dim3(D / 64, M / 64), 256, 0, stream>>>(proj + C_MERGED, PW, w_out + (size_t)l * D * D, D, D, D, 0, EpiY{y});
        k_rowpass<<<M / 4, 256, 0, stream>>>(h, h, y, npost + 1 * D, adal + 5 * D, 1.0f, npre + 2 * D, adal + 6 * D, adal + 7 * D, u);
        k_ngemm<EpiUp, true><<<dim3(DFF / 64, M / 64), 256, 0, stream>>>(u, D, f2u + (size_t)l * D * 2 * DFF, 2 * DFF, DFF, D, DFF, EpiUp{hid});
        k_ngemm<EpiY, false><<<dim3(D / 64, M / 64), 256, 0, stream>>>(hid, DFF, f2d + (size_t)l * DFF * D, D, D, DFF, 0, EpiY{y});
        const bool last = (l == DEPTH - 1);
        const float* nadal = ada + (size_t)(l + 1) * BATCH * ADA; const float* nnpre = norm_pre + (l + 1) * 3 * D;
        k_rowpass<<<M / 4, 256, 0, stream>>>(h, h, y, npost + 2 * D, adal + 8 * D, 0.5f, last ? nullptr : nnpre, last ? nullptr : nadal + 0 * D, last ? nullptr : nadal + 1 * D, last ? nullptr : u);
    }
}
```

```cpp
#include <hip/hip_runtime.h>
#include <cstdio>
#include <cstdint>
#include <cmath>

constexpr int D = 1024, BATCH = 8, SEQ = 2048, DEPTH = 2, M = BATCH * SEQ;
constexpr int DFF = 2816, INW = 6672, PW = 6912;
constexpr int ADA = 9 * D;
constexpr float EPS = 1e-6f;
constexpr float LOG2E = 1.4426950408889634f;
constexpr float QSCALE = 0.125f * LOG2E;
constexpr int C_GV = 0, C_DQ = 512, C_DK = 1024, C_DV = 1536, C_GQ = 2048, C_GK = 2304, C_GR = 2560, C_SU = 3072, C_GATE = 3584, C_GA = 6656;
constexpr int C_O = C_GQ;
constexpr int C_YGLA = C_GV, C_YDIFF = C_DQ, C_YS5 = C_DK, C_YS5PRE = C_SU, C_MERGED = C_GQ;

typedef unsigned short bf16_t;
typedef short bf16x8 __attribute__((ext_vector_type(8)));
typedef float f32x4 __attribute__((ext_vector_type(4)));
typedef unsigned u32x4 __attribute__((ext_vector_type(4)));
__device__ __forceinline__ float bf2f(bf16_t v) { return __uint_as_float(((unsigned)v) << 16); }
__device__ __forceinline__ bf16_t f2bf(float f) { unsigned u = __float_as_uint(f); return (bf16_t)((u + 0x7fffu + ((u >> 16) & 1u)) >> 16); }
__device__ __forceinline__ unsigned pk2(float lo, float hi) { return (unsigned)f2bf(lo) | ((unsigned)f2bf(hi) << 16); }
__device__ __forceinline__ float blo(unsigned w) { return __uint_as_float(w << 16); }
__device__ __forceinline__ float bhi(unsigned w) { return __uint_as_float(w & 0xffff0000u); }
__device__ __forceinline__ float sigmoidf_(float x) { return 1.f / (1.f + __expf(-x)); }
__device__ __forceinline__ float siluf_(float x) { return x / (1.f + __expf(-x)); }
__device__ __forceinline__ float wave_sum(float v) {
#pragma unroll
    for (int o = 1; o < 64; o <<= 1) v += __shfl_xor(v, o);
    return v;
}
__device__ __forceinline__ float wave_max(float v) {
#pragma unroll
    for (int o = 1; o < 64; o <<= 1) v = fmaxf(v, __shfl_xor(v, o));
    return v;
}
__device__ __forceinline__ int ref2my(int c) {
    if (c < 256) return C_GQ + c;
    if (c < 512) return C_GK + (c - 256);
    if (c < 1024) return C_GV + (c - 512);
    if (c < 1536) return C_GR + (c - 1024);
    if (c < 1552) return C_GA + (c - 1536);
    if (c < 2064) return C_DQ + (c - 1552);
    if (c < 2576) return C_DK + (c - 2064);
    if (c < 3088) return C_DV + (c - 2576);
    if (c < 3600) return C_SU + (c - 3088);
    return C_GATE + (c - 3600);
}
__device__ __forceinline__ int my2ref(int c) {
    if (c < C_DQ) return 512 + c;
    if (c < C_DK) return 1552 + (c - C_DQ);
    if (c < C_DV) return 2064 + (c - C_DK);
    if (c < C_GQ) return 2576 + (c - C_DV);
    if (c < C_GK) return c - C_GQ;
    if (c < C_GR) return 256 + (c - C_GK);
    if (c < C_SU) return 1024 + (c - C_GR);
    if (c < C_GATE) return 3088 + (c - C_SU);
    if (c < C_GA) return 3600 + (c - C_GATE);
    if (c < C_GA + 16) return 1536 + (c - C_GA);
    return -1;
}
__device__ const unsigned char T5B[128] = {0, 1, 2, 3, 4, 5, 6, 7, 8, 9, 10, 11, 12, 13, 14, 15, 16, 16, 16, 17, 17, 18, 18, 18, 19, 19, 19, 20, 20, 20, 20, 21, 21, 21, 21, 22, 22, 22, 22, 22, 23, 23, 23, 23, 23, 23, 24, 24, 24, 24, 24, 24, 25, 25, 25, 25, 25, 25, 25, 26, 26, 26, 26, 26, 26, 26, 26, 27, 27, 27, 27, 27, 27, 27, 27, 27, 27, 28, 28, 28, 28, 28, 28, 28, 28, 28, 28, 29, 29, 29, 29, 29, 29, 29, 29, 29, 29, 29, 29, 30, 30, 30, 30, 30, 30, 30, 30, 30, 30, 30, 30, 30, 30, 31, 31, 31, 31, 31, 31, 31, 31, 31, 31, 31, 31, 31, 31, 31};

constexpr size_t MiB = 1u << 20;
constexpr size_t WS_CTL = 0, CTL_ZERO_BYTES = 1 * MiB, WS_ADA = 1 * MiB, WS_S5ST = 2 * MiB, WS_W = 6 * MiB, WS_U = 59 * MiB, WS_GLA = 91 * MiB, WS_R0 = 123 * MiB, WS_END = 339 * MiB;
constexpr size_t WS_Y = WS_GLA;
constexpr size_t W_UP1 = 0, W_DN1 = W_UP1 + (size_t)2 * DFF * D, W_UP2 = W_DN1 + (size_t)D * DFF, W_DN2 = W_UP2 + (size_t)2 * DFF * D, W_IN = W_DN2 + (size_t)D * DFF,
                 W_GLU = W_IN + (size_t)PW * D, W_BR = W_GLU + (size_t)1024 * 512, W_OUT = W_BR + (size_t)3 * 1024 * 512, W_END = W_OUT + (size_t)D * D;
static_assert(W_END * 2 <= 53 * MiB, "weights fit");

__device__ __forceinline__ void rowpass_row(int row, int lane, const float* h_in, float* h_out, const bf16_t* y, const float* gpost, const float* gate, float coef,
                                            const float* gpre, const float* shift, const float* scale, bf16_t* u) {
    const int b = row / SEQ;
    f32x4 hv[4];
#pragma unroll
    for (int j = 0; j < 4; ++j) hv[j] = *(const f32x4*)(h_in + (size_t)row * D + j * 256 + lane * 4);
    if (y) {
        float yv[4][4]; float ss = 0.f;
#pragma unroll
        for (int j = 0; j < 4; ++j) {
            const uint2 raw = *(const uint2*)(y + (size_t)row * D + j * 256 + lane * 4);
            yv[j][0] = blo(raw.x); yv[j][1] = bhi(raw.x); yv[j][2] = blo(raw.y); yv[j][3] = bhi(raw.y);
#pragma unroll
            for (int i = 0; i < 4; ++i) ss += yv[j][i] * yv[j][i];
        }
        const float r = rsqrtf(wave_sum(ss) * (1.f / D) + EPS);
#pragma unroll
        for (int j = 0; j < 4; ++j) {
            const int c0 = j * 256 + lane * 4;
            const f32x4 gp = *(const f32x4*)(gpost + c0), gt = *(const f32x4*)(gate + (size_t)b * ADA + c0);
#pragma unroll
            for (int i = 0; i < 4; ++i) hv[j][i] += coef * gt[i] * (yv[j][i] * r * gp[i]);
        }
    }
    if (y || h_in != h_out) {
#pragma unroll
        for (int j = 0; j < 4; ++j) *(f32x4*)(h_out + (size_t)row * D + j * 256 + lane * 4) = hv[j];
    }
    if (u) {
        float ss = 0.f;
#pragma unroll
        for (int j = 0; j < 4; ++j)
#pragma unroll
            for (int i = 0; i < 4; ++i) ss += hv[j][i] * hv[j][i];
        const float r = rsqrtf(wave_sum(ss) * (1.f / D) + EPS);
#pragma unroll
        for (int j = 0; j < 4; ++j) {
            const int c0 = j * 256 + lane * 4;
            const f32x4 g = *(const f32x4*)(gpre + c0), sh = *(const f32x4*)(shift + (size_t)b * ADA + c0), sc = *(const f32x4*)(scale + (size_t)b * ADA + c0);
            float o[4];
#pragma unroll
            for (int i = 0; i < 4; ++i) o[i] = hv[j][i] * r * g[i] * (1.f + sc[i]) + sh[i];
            uint2 w; w.x = pk2(o[0], o[1]); w.y = pk2(o[2], o[3]);
            *(uint2*)(u + (size_t)row * D + c0) = w;
        }
    }
}

__global__ __launch_bounds__(256) void k_gla_naive(bf16_t* proj, const float* w_alpha, const float* b_alpha, const float* norm_g) {
    const int b = blockIdx.x >> 2, h = blockIdx.x & 3, t = threadIdx.x, lane = t & 63, e = t & 127, half = t >> 7;
    __shared__ float sa[64], sq[64], sk[64], part[2][128], red[2];
    float S[32];
#pragma unroll
    for (int i = 0; i < 32; ++i) S[i] = 0.f;
    float wa[16]; float ba = 0.f;
#pragma unroll
    for (int j = 0; j < 16; ++j) wa[j] = 0.f;
    if (t < 64) { for (int j = 0; j < 16; ++j) wa[j] = w_alpha[j * 256 + h * 64 + t]; ba = b_alpha[h * 64 + t]; }
    const float ng = norm_g[h * 128 + e];
    for (int s = 0; s < SEQ; ++s) {
        bf16_t* row = proj + (size_t)(b * SEQ + s) * PW;
        if (t < 64) {
            float z = ba;
#pragma unroll
            for (int j = 0; j < 16; ++j) z += bf2f(row[C_GA + j]) * wa[j];
            const float ls = fminf(z, 0.f) - log1pf(__expf(-fabsf(z)));
            sa[t] = __expf(ls * (1.f / 16.f)); sq[t] = bf2f(row[C_GQ + h * 64 + t]); sk[t] = bf2f(row[C_GK + h * 64 + t]);
        }
        const float v = bf2f(row[C_GV + h * 128 + e]);
        const float rr = bf2f(row[C_GR + h * 128 + e]);
        __syncthreads();
        float p = 0.f;
#pragma unroll
        for (int i = 0; i < 32; ++i) { const int d = half * 32 + i; S[i] = sa[d] * S[i] + sk[d] * v; p += sq[d] * S[i]; }
        part[half][e] = p;
        __syncthreads();
        float o = 0.f;
        if (t < 128) { o = part[0][e] + part[1][e]; const float ss = wave_sum(o * o); if (lane == 0) red[t >> 6] = ss; }
        __syncthreads();
        if (t < 128) { const float r = rsqrtf((red[0] + red[1]) * (1.f / 128.f) + EPS); row[C_YGLA + h * 128 + e] = f2bf(o * r * ng * siluf_(rr)); }
        __syncthreads();
    }
}

__global__ __launch_bounds__(64) void k_s5_naive(bf16_t* proj, const float* lam_re, const float* lam_im, const float* log_step, const float* b_re, const float* b_im,
                                                 const float* c_re, const float* c_im, const float* d_skip) {
    const int b = blockIdx.x >> 5, g = blockIdx.x & 31, p = threadIdx.x;
    const float lr = lam_re[g * 64 + p], li = lam_im[g * 64 + p], dt = expf(log_step[g]);
    const float mag = expf(lr * dt), ar = mag * cosf(li * dt), ai = mag * sinf(li * dt);
    const float nr = ar - 1.f, ni = ai, den = lr * lr + li * li, fre = (nr * lr + ni * li) / den, fim = (ni * lr - nr * li) / den;
    float bbr[16], bbi[16], cr[16], ci[16];
#pragma unroll
    for (int h = 0; h < 16; ++h) { const float br = b_re[(g * 64 + p) * 16 + h], bi = b_im[(g * 64 + p) * 16 + h]; bbr[h] = fre * br - fim * bi; bbi[h] = fre * bi + fim * br;
        cr[h] = c_re[(g * 16 + h) * 64 + p]; ci[h] = c_im[(g * 16 + h) * 64 + p]; }
    const float dsk = (p < 16) ? d_skip[g * 16 + p] : 0.f;
    float xr = 0.f, xi = 0.f;
    for (int s = 0; s < SEQ; ++s) {
        bf16_t* row = proj + (size_t)(b * SEQ + s) * PW + C_SU + g * 16;
        float u[16];
#pragma unroll
        for (int h = 0; h < 16; ++h) u[h] = bf2f(row[h]);
        float bur = 0.f, bui = 0.f;
#pragma unroll
        for (int h = 0; h < 16; ++h) { bur += bbr[h] * u[h]; bui += bbi[h] * u[h]; }
        const float nxr = ar * xr - ai * xi + bur, nxi = ar * xi + ai * xr + bui; xr = nxr; xi = nxi;
        float yn = 0.f;
#pragma unroll
        for (int n = 0; n < 16; ++n) { const float v = wave_sum(cr[n] * xr - ci[n] * xi); if (p == n) yn = v + dsk * u[n]; }
        if (p < 16) { const float x3 = yn * yn * yn; const float gl = 0.5f * yn * (1.f + tanhf(0.7978845608028654f * (yn + 0.044715f * x3))); row[p] = f2bf(gl); }
    }
}

__global__ __launch_bounds__(256) void k_attn_naive(bf16_t* proj, const float* rel_bias) {
    __shared__ float sc[4][SEQ];
    __shared__ float sq[4][64];
    const int w = threadIdx.x >> 6, lane = threadIdx.x & 63;
    const int gw = blockIdx.x * 4 + w;
    const int q = gw % SEQ, m = (gw / SEQ) % 8, b = gw / (SEQ * 8);
    const bf16_t* base = proj + (size_t)b * SEQ * PW;
    sq[w][lane] = bf2f(base[(size_t)q * PW + C_DQ + m * 64 + lane]);
    __syncthreads();
    float mx = -INFINITY;
    for (int s0 = 0; s0 <= q; s0 += 64) {
        const int s = s0 + lane;
        float v = -INFINITY;
        if (s <= q) {
            const bf16_t* kr = base + (size_t)s * PW + C_DK + m * 64; float a = 0.f;
            for (int d = 0; d < 64; ++d) a += sq[w][d] * bf2f(kr[d]);
            const int dist = q - s; const int bk = T5B[dist < 127 ? dist : 127];
            v = a + rel_bias[bk * 8 + m] * LOG2E;
        }
        sc[w][s] = v; mx = fmaxf(mx, v);
    }
    mx = wave_max(mx);
    float sum = 0.f;
    for (int s0 = 0; s0 <= q; s0 += 64) { const int s = s0 + lane; if (s <= q) { const float pz = exp2f(sc[w][s] - mx); sc[w][s] = pz; sum += pz; } }
    sum = wave_sum(sum);
    __syncthreads();
    const int hh = m >> 1; float o0 = 0.f, o1 = 0.f;
    for (int s = 0; s <= q; ++s) { const float pz = sc[w][s]; const unsigned vv = *(const unsigned*)(base + (size_t)s * PW + C_DV + hh * 128 + lane * 2);
        o0 += pz * blo(vv); o1 += pz * bhi(vv); }
    __syncthreads();
    const float inv = 1.f / sum;
    bf16_t* orow = proj + (size_t)(b * SEQ + q) * PW + C_O + m * 128 + lane * 2;
    *(unsigned*)orow = pk2(o0 * inv, o1 * inv);
}

__device__ __forceinline__ void diff_fin_row(bf16_t* r, int lane, float lam, const float* norm_g, float lam_init) {
#pragma unroll
    for (int h = 0; h < 4; ++h) {
        const unsigned a = *(const unsigned*)(r + C_O + (2 * h) * 128 + lane * 2), c = *(const unsigned*)(r + C_O + (2 * h + 1) * 128 + lane * 2);
        const float o0 = blo(a) - lam * blo(c), o1 = bhi(a) - lam * bhi(c);
        const float rs = rsqrtf(wave_sum(o0 * o0 + o1 * o1) * (1.f / 128.f) + EPS) * (1.f - lam_init);
        const float g0 = norm_g[h * 128 + lane * 2], g1 = norm_g[h * 128 + lane * 2 + 1];
        *(unsigned*)(r + C_YDIFF + h * 128 + lane * 2) = pk2(o0 * rs * g0, o1 * rs * g1);
    }
}
__global__ __launch_bounds__(256) void k_diff_fin(bf16_t* proj, const float* lamv, const float* norm_g, float lam_init) {
    const int lane = threadIdx.x & 63, row = blockIdx.x * 4 + (threadIdx.x >> 6);
    const float lam = __expf(wave_sum(lamv[lane] * lamv[64 + lane])) - __expf(wave_sum(lamv[128 + lane] * lamv[192 + lane])) + lam_init;
    diff_fin_row(proj + (size_t)row * PW, lane, lam, norm_g, lam_init);
}

namespace pg8 {
#define PG8_LAS __attribute__((address_space(3)))
constexpr int BM = 256, BK = 64, HALF = 128, HTB = HALF * BK * 2  , STAGE_BYTES = 8 * HTB, NXCD = 8, WGM = 8;

__host__ __device__ __forceinline__ int lds_byte(int r, int c) { const int st = (r >> 4) * 2 + (c >> 5), rr = r & 15, cc = c & 31, ob = rr * 64 + cc * 2; return st * 1024 + (ob ^ (((ob >> 9) & 1) << 5)); }
__host__ __device__ __forceinline__ void stage_rc(int b, int& R, int& C) { const int st = b / 1024, sb = b % 1024, swz = sb ^ (((sb >> 9) & 1) << 5); R = (st >> 1) * 16 + swz / 64; C = (st & 1) * 32 + (swz % 64) / 2; }
__host__ __device__ __forceinline__ int perm32(int rho) { const int n = rho >> 4, i = rho & 15; return 8 * (i >> 2) + 4 * n + (i & 3); }

struct Unit { int pm, pn, z; };
template <int LDA, int LDB, int KK, int ZA, int ZB> struct GemmT { const bf16_t* A; const bf16_t* Bt; static constexpr int lda = LDA, ldb = LDB, K = KK; static constexpr size_t zA = ZA, zB = ZB; };

struct StaticOrder {
    int nM, nN, nwg, G, c, nZ;
    __host__ __device__ void init(int M_, int N_, int G_, int c_, int nZ_ = 1) { nM = M_ / BM; nN = N_ / BM; nwg = nM * nN; G = G_; c = c_; nZ = nZ_; }
    __host__ __device__ bool next(int i, Unit& u) const {
        const long L = (long)(i / nZ) * G + c; if (L >= nwg) return false;
        int wgid = (int)L; { const int q = nwg / NXCD, r = nwg % NXCD, xcd = wgid % NXCD, off = wgid / NXCD; wgid = (xcd < r ? xcd * (q + 1) : r * (q + 1) + (xcd - r) * q) + off; }
        const int nig = WGM * nN, gid = wgid / nig, fm = gid * WGM, gsz = (nM - fm) < WGM ? (nM - fm) : WGM;
        u.pm = fm + ((wgid % nig) % gsz); u.pn = (wgid % nig) / gsz; u.z = i % nZ; return true;
    }
    __device__ __forceinline__ void a_ready(const Unit&) const {}
    __device__ __forceinline__ void done(const Unit&) const {}
};
__device__ __forceinline__ unsigned cvt_pk_bf16(float lo, float hi) { unsigned r; asm volatile("v_cvt_pk_bf16_f32 %0, %1, %2" : "=v"(r) : "v"(lo), "v"(hi)); return r; }

__device__ __forceinline__ u32x4 pack8(const f32x4 v0, const f32x4 v1) { u32x4 w; w.x = cvt_pk_bf16(v0[0], v0[1]); w.y = cvt_pk_bf16(v0[2], v0[3]); w.z = cvt_pk_bf16(v1[0], v1[1]); w.w = cvt_pk_bf16(v1[2], v1[3]); return w; }
__device__ __forceinline__ float fsig(float x) { return __builtin_amdgcn_rcpf(1.f + __expf(-x)); }
template <int ldc, int mode> struct EpiStore {
    static constexpr bool PERM = true, AFTER_DRAIN = false;
    bf16_t* O;
    __device__ __forceinline__ void operator()(const f32x4 (&acc)[2][2][4][2], const Unit& u, int wr, int wc, int fr, int fq) const {
        float sc = 1.f; if (mode == 1) { if (u.pn == 2 || u.pn == 3) sc = QSCALE; else if (u.pn == 8) sc = 0.125f; }
        const int row0 = u.pm * BM + wr * 64 + fr, col0 = u.pn * BM + wc * 32 + 8 * fq;
#pragma unroll
        for (int ai = 0; ai < 2; ++ai)
#pragma unroll
            for (int m = 0; m < 4; ++m) { bf16_t* rowp = O + (size_t)(row0 + ai * HALF + m * 16) * ldc + col0;
#pragma unroll
                for (int bj = 0; bj < 2; ++bj) *(u32x4*)(rowp + bj * HALF) = pack8(acc[ai][bj][m][0] * sc, acc[ai][bj][m][1] * sc); }
    }
};
struct EpiSwiGLU {
    static constexpr bool PERM = true, AFTER_DRAIN = false;
    bf16_t* H;
    __device__ __forceinline__ void operator()(const f32x4 (&acc)[2][2][4][2], const Unit& u, int wr, int wc, int fr, int fq) const {
        const int row0 = u.pm * BM + wr * 64 + fr, col0 = u.pn * HALF + wc * 32 + 8 * fq;
#pragma unroll
        for (int ai = 0; ai < 2; ++ai)
#pragma unroll
            for (int m = 0; m < 4; ++m) { f32x4 o[2];
#pragma unroll
                for (int n = 0; n < 2; ++n)
#pragma unroll
                    for (int j = 0; j < 4; ++j) { const float g = acc[ai][0][m][n][j]; o[n][j] = g * fsig(g) * acc[ai][1][m][n][j]; }
                *(u32x4*)(H + (size_t)(row0 + ai * HALF + m * 16) * DFF + col0) = pack8(o[0], o[1]); }
    }
};
struct EpiGLU {
    static constexpr bool PERM = true, AFTER_DRAIN = false;
    bf16_t* P; const float* bias;
    __device__ __forceinline__ void operator()(const f32x4 (&acc)[2][2][4][2], const Unit& u, int wr, int wc, int fr, int fq) const {
        const int row0 = u.pm * BM + wr * 64 + fr, col0 = u.pn * HALF + wc * 32 + 8 * fq;
        f32x4 bv[2], bg[2];
#pragma unroll
        for (int n = 0; n < 2; ++n) { bv[n] = *(const f32x4*)(bias + col0 + 4 * n); bg[n] = *(const f32x4*)(bias + 512 + col0 + 4 * n); }
#pragma unroll
        for (int ai = 0; ai < 2; ++ai)
#pragma unroll
            for (int m = 0; m < 4; ++m) { f32x4 o[2];
#pragma unroll
                for (int n = 0; n < 2; ++n)
#pragma unroll
                    for (int j = 0; j < 4; ++j) o[n][j] = (acc[ai][0][m][n][j] + bv[n][j]) * fsig(acc[ai][1][m][n][j] + bg[n][j]);
                *(u32x4*)(P + (size_t)(row0 + ai * HALF + m * 16) * PW + C_YS5 + col0) = pack8(o[0], o[1]); }
    }
};
struct EpiBranch {
    static constexpr bool PERM = true, AFTER_DRAIN = false;
    bf16_t* P;
    __device__ __forceinline__ void operator()(const f32x4 (&acc)[2][2][4][2], const Unit& u, int wr, int wc, int fr, int fq) const {
        const int row0 = u.pm * BM + wr * 64 + fr, col0 = u.pn * BM + wc * 32 + 8 * fq;
#pragma unroll
        for (int ai = 0; ai < 2; ++ai)
#pragma unroll
            for (int m = 0; m < 4; ++m) { bf16_t* rowp = P + (size_t)(row0 + ai * HALF + m * 16) * PW;
#pragma unroll
                for (int bj = 0; bj < 2; ++bj) { const int col = col0 + bj * HALF;
                    const u32x4 gw = *(const u32x4*)(rowp + C_GATE + u.z * D + col);
                    u32x4 pw = (u32x4){0u, 0u, 0u, 0u}; if (u.z > 0) pw = *(const u32x4*)(rowp + C_MERGED + col);
                    f32x4 o[2];
#pragma unroll
                    for (int n = 0; n < 2; ++n) { const unsigned g0 = gw[2 * n], g1 = gw[2 * n + 1], p0 = pw[2 * n], p1 = pw[2 * n + 1];
                        o[n][0] = blo(p0) + fsig(blo(g0)) * acc[ai][bj][m][n][0]; o[n][1] = bhi(p0) + fsig(bhi(g0)) * acc[ai][bj][m][n][1];
                        o[n][2] = blo(p1) + fsig(blo(g1)) * acc[ai][bj][m][n][2]; o[n][3] = bhi(p1) + fsig(bhi(g1)) * acc[ai][bj][m][n][3]; }
                    *(u32x4*)(rowp + C_MERGED + col) = pack8(o[0], o[1]); } }
    }
};

template <class Epi, class Sched, class GemmX, bool ALIGN_EPI = false, bool SP2 = false>
__device__ __forceinline__ void gemm_phase(PG8_LAS unsigned char* lds, const GemmX g, const Sched& S, const Epi& E) {
    int tid_ = threadIdx.x; asm volatile("" : "+v"(tid_));
    const int tid = tid_, wid = __builtin_amdgcn_readfirstlane(tid >> 6), lane = tid & 63, wr = wid >> 2, wc = wid & 3, fr = lane & 15, fq = lane >> 4;
    const int K = g.K, nt = K / BK;
    unsigned voffA[2], voffB[2];
#pragma unroll
    for (int i = 0; i < 2; ++i) { int R, C; stage_rc(tid * 16 + i * 8192, R, C); const int Rb = Epi::PERM ? ((R & ~31) + perm32(R & 31)) : R;
        voffA[i] = (unsigned)(R * g.lda + C) * 2u; voffB[i] = (unsigned)(Rb * g.ldb + C) * 2u; }
    const size_t kstep = (size_t)(BK * 2);
    const size_t hstepA = (size_t)HALF * g.lda * 2, hstepB = (size_t)HALF * g.ldb * 2;
    const size_t tstepA = 2 * hstepA, tstepB = 2 * hstepB;
    const unsigned ldsw = (unsigned)wid * 1024u;
    const int aoff = lds_byte(wr * 64 + fr, fq * 8), boff = lds_byte(wc * 32 + fr, fq * 8);
#define PG8_SA(b, h) (((b) * 2 + (h)) * HTB)
#define PG8_SB(b, h) ((4 + (b) * 2 + (h)) * HTB)
#define PG8_STAGE(bufoff, gbase, voff) do { _Pragma("unroll") for (int _i = 0; _i < 2; ++_i) \
        __builtin_amdgcn_global_load_lds((const unsigned*)((const char*)(gbase) + (voff)[_i]), (PG8_LAS unsigned*)(lds + (bufoff) + ldsw + _i * 8192), 16, 0, 0); } while (0)
#define PG8_LDA(dst, b, h) do { _Pragma("unroll") for (int m = 0; m < 4; ++m) _Pragma("unroll") for (int k = 0; k < 2; ++k) dst[m][k] = *(const PG8_LAS bf16x8*)(lds + PG8_SA(b, h) + aoff + m * 2048 + k * 1024); } while (0)
#define PG8_LDB(dst, b, h) do { _Pragma("unroll") for (int n = 0; n < 2; ++n) _Pragma("unroll") for (int k = 0; k < 2; ++k) dst[n][k] = *(const PG8_LAS bf16x8*)(lds + PG8_SB(b, h) + boff + n * 2048 + k * 1024); } while (0)
#define PG8_MMA(ai, bj, At, Bt) do { __builtin_amdgcn_s_setprio(1); _Pragma("unroll") for (int m = 0; m < 4; ++m) _Pragma("unroll") for (int n = 0; n < 2; ++n) _Pragma("unroll") for (int k = 0; k < 2; ++k) \
        acc[ai][bj][m][n] = __builtin_amdgcn_mfma_f32_16x16x32_bf16(Bt[n][k], At[m][k], acc[ai][bj][m][n], 0, 0, 0); __builtin_amdgcn_s_setprio(0); } while (0)
#define PG8_WAIT_V(n) asm volatile("s_waitcnt vmcnt(" #n ")" ::: "memory")
#define PG8_WAIT_L(n) asm volatile("s_waitcnt lgkmcnt(" #n ")" ::: "memory")
#define PG8_BAR __builtin_amdgcn_s_barrier()
#define PG8_SCHED __builtin_amdgcn_sched_barrier(0)
    Unit cur, nxt; int ui = 0;
    if (!S.next(0, cur)) return;
    f32x4 acc[2][2][4][2];
#pragma unroll
    for (int a = 0; a < 2; ++a)
#pragma unroll
        for (int b = 0; b < 2; ++b)
#pragma unroll
            for (int m = 0; m < 4; ++m)
#pragma unroll
                for (int n = 0; n < 2; ++n) acc[a][b][m][n] = (f32x4){0.f, 0.f, 0.f, 0.f};
    bf16x8 At[4][2], B0[2][2], B1[2][2];
    const char* cA = (const char*)g.A + (size_t)cur.pm * tstepA + (size_t)cur.z * g.zA; const char* cB = (const char*)g.Bt + (size_t)cur.pn * tstepB + (size_t)cur.z * g.zB;
    S.a_ready(cur);
    if constexpr (SP2) {
        PG8_STAGE(PG8_SB(0, 0), cB, voffB); PG8_STAGE(PG8_SB(0, 1), cB + hstepB, voffB); PG8_STAGE(PG8_SA(0, 0), cA, voffA); PG8_STAGE(PG8_SA(0, 1), cA + hstepA, voffA);
        if (wr == 1) PG8_BAR;
        PG8_WAIT_V(2); PG8_BAR;
        PG8_STAGE(PG8_SB(1, 0), cB + kstep, voffB); PG8_STAGE(PG8_SA(1, 0), cA + kstep, voffA); PG8_STAGE(PG8_SB(1, 1), cB + hstepB + kstep, voffB);
        PG8_WAIT_V(6); PG8_BAR;
    } else {
        PG8_STAGE(PG8_SB(0, 0), cB, voffB); PG8_STAGE(PG8_SA(0, 0), cA, voffA); PG8_STAGE(PG8_SB(0, 1), cB + hstepB, voffB); PG8_STAGE(PG8_SA(0, 1), cA + hstepA, voffA);
        if (wr == 1) PG8_BAR;
        PG8_WAIT_V(4); PG8_BAR;
        PG8_STAGE(PG8_SB(1, 0), cB + kstep, voffB); PG8_STAGE(PG8_SA(1, 0), cA + kstep, voffA); PG8_STAGE(PG8_SB(1, 1), cB + hstepB + kstep, voffB);
        PG8_WAIT_V(6); PG8_BAR;
    }
    for (;;) {
        const bool has_next = S.next(ui + 1, nxt);
        const char* nA = has_next ? (const char*)g.A + (size_t)nxt.pm * tstepA + (size_t)nxt.z * g.zA : cA; const char* nB = has_next ? (const char*)g.Bt + (size_t)nxt.pn * tstepB + (size_t)nxt.z * g.zB : cB;
        for (int t = 0; t < nt; t += 2) {
            const bool last = (t == nt - 2);
            const char* a1 = cA + (size_t)(t + 1) * kstep;
            const char* a2 = last ? nA : cA + (size_t)(t + 2) * kstep; const char* b2 = last ? nB : cB + (size_t)(t + 2) * kstep;
            const char* a3 = a2 + kstep; const char* b3 = b2 + kstep;
            if (last && has_next) S.a_ready(nxt);
            if constexpr (SP2) {
            PG8_LDB(B0, 0, 0); PG8_LDB(B1, 0, 1); PG8_SCHED; PG8_LDA(At, 0, 0); PG8_STAGE(PG8_SA(1, 1), a1 + hstepA, voffA);
            PG8_WAIT_V(8); PG8_WAIT_L(0); PG8_BAR; PG8_MMA(0, 0, At, B0); PG8_MMA(0, 1, At, B1); PG8_BAR; PG8_SCHED;
            PG8_LDA(At, 0, 1); PG8_STAGE(PG8_SB(0, 0), b2, voffB); PG8_STAGE(PG8_SB(0, 1), b2 + hstepB, voffB); PG8_STAGE(PG8_SA(0, 0), a2, voffA);
            PG8_WAIT_V(8); PG8_WAIT_L(0); PG8_BAR; PG8_MMA(1, 0, At, B0); PG8_MMA(1, 1, At, B1); PG8_BAR; PG8_SCHED;
            PG8_LDB(B0, 1, 0); PG8_LDB(B1, 1, 1); PG8_SCHED; PG8_LDA(At, 1, 0); PG8_STAGE(PG8_SA(0, 1), a2 + hstepA, voffA);
            PG8_WAIT_V(8); PG8_WAIT_L(0); PG8_BAR; PG8_MMA(0, 0, At, B0); PG8_MMA(0, 1, At, B1); PG8_BAR; PG8_SCHED;
            PG8_LDA(At, 1, 1); PG8_STAGE(PG8_SB(1, 0), b3, voffB); PG8_STAGE(PG8_SB(1, 1), b3 + hstepB, voffB); PG8_STAGE(PG8_SA(1, 0), a3, voffA);
            PG8_WAIT_V(8); PG8_WAIT_L(0); PG8_BAR; PG8_MMA(1, 0, At, B0); PG8_MMA(1, 1, At, B1); PG8_BAR; PG8_SCHED;
            } else {
            PG8_LDB(B0, 0, 0); PG8_SCHED; PG8_LDA(At, 0, 0); PG8_STAGE(PG8_SA(1, 1), a1 + hstepA, voffA);
            PG8_WAIT_L(8); PG8_BAR; PG8_WAIT_L(0); PG8_MMA(0, 0, At, B0); PG8_BAR; PG8_SCHED;
            PG8_LDB(B1, 0, 1); PG8_STAGE(PG8_SB(0, 0), b2, voffB);
            PG8_BAR; PG8_WAIT_L(0); PG8_MMA(0, 1, At, B1); PG8_BAR;
            PG8_LDA(At, 0, 1); PG8_STAGE(PG8_SA(0, 0), a2, voffA);
            PG8_BAR; PG8_WAIT_L(0); PG8_MMA(1, 0, At, B0); PG8_BAR; PG8_SCHED;
            PG8_STAGE(PG8_SB(0, 1), b2 + hstepB, voffB);
            PG8_WAIT_V(6); PG8_BAR; PG8_MMA(1, 1, At, B1); PG8_BAR;
            PG8_LDB(B0, 1, 0); PG8_SCHED; PG8_LDA(At, 1, 0); PG8_STAGE(PG8_SA(0, 1), a2 + hstepA, voffA);
            PG8_WAIT_L(8); PG8_BAR; PG8_WAIT_L(0); PG8_MMA(0, 0, At, B0); PG8_BAR; PG8_SCHED;
            PG8_LDB(B1, 1, 1); PG8_STAGE(PG8_SB(1, 0), b3, voffB);
            PG8_BAR; PG8_WAIT_L(0); PG8_MMA(0, 1, At, B1); PG8_BAR;
            PG8_LDA(At, 1, 1); PG8_STAGE(PG8_SA(1, 0), a3, voffA);
            PG8_BAR; PG8_WAIT_L(0); PG8_MMA(1, 0, At, B0); PG8_BAR; PG8_SCHED;
            PG8_STAGE(PG8_SB(1, 1), b3 + hstepB, voffB);
            PG8_WAIT_V(6); PG8_BAR; PG8_MMA(1, 1, At, B1); PG8_BAR;
            }
        }
        if constexpr (ALIGN_EPI) { if (wr == 0) PG8_BAR; }
        if constexpr (!Epi::AFTER_DRAIN) { E(acc, cur, wr, wc, fr, fq); S.done(cur); }
        if (!has_next) break;
#pragma unroll
        for (int a = 0; a < 2; ++a)
#pragma unroll
            for (int b = 0; b < 2; ++b)
#pragma unroll
                for (int m = 0; m < 4; ++m)
#pragma unroll
                    for (int n = 0; n < 2; ++n) acc[a][b][m][n] = (f32x4){0.f, 0.f, 0.f, 0.f};
        cur = nxt; cA = nA; cB = nB; ++ui;
        if constexpr (ALIGN_EPI) { if (wr == 1) PG8_BAR; }
    }
    PG8_WAIT_V(0);
    if constexpr (!ALIGN_EPI) { if (wr == 0) PG8_BAR; }
    PG8_BAR;
    if constexpr (Epi::AFTER_DRAIN) { E.fused(acc, cur, wr, wc, fr, fq, lds, wid, lane); S.done(cur); }
#undef PG8_SA
#undef PG8_SB
#undef PG8_STAGE
#undef PG8_LDA
#undef PG8_LDB
#undef PG8_MMA
#undef PG8_WAIT_V
#undef PG8_WAIT_L
#undef PG8_BAR
#undef PG8_SCHED
}
}

#define GAS __attribute__((address_space(1)))
#define LAS __attribute__((address_space(3)))
typedef unsigned v4u __attribute__((ext_vector_type(4)));
typedef GAS unsigned gu32;
typedef GAS unsigned long long gu64;
#define RLX_AGENT __ATOMIC_RELAXED, __HIP_MEMORY_SCOPE_AGENT
#define LDS_WAIT() asm volatile("s_waitcnt lgkmcnt(0)" ::: "memory")
#define VM_WAIT() asm volatile("s_waitcnt vmcnt(0)" ::: "memory")

#define XB_TMO      128
#define XB_XCNT(j)  (256  + 64 * (j))
#define XB_XSUB(j)  (1280 + 64 * (j))
#define XB_XGEN(j)  (2304 + 64 * (j))
#define XB_TOP      3328
#define XB_TOPGEN   3392
#define XCD_BAR_WORDS 3456
#define XB_SPIN_CAP (1u << 18)

__device__ __forceinline__ unsigned xb_ld(unsigned* p)              { return __hip_atomic_load(p, __ATOMIC_RELAXED, __HIP_MEMORY_SCOPE_AGENT); }
__device__ __forceinline__ unsigned xb_add(unsigned* p, unsigned v) { return __hip_atomic_fetch_add(p, v, __ATOMIC_RELAXED, __HIP_MEMORY_SCOPE_AGENT); }
__device__ __forceinline__ unsigned xb_xcc_id() { return (unsigned)__builtin_amdgcn_s_getreg((3 << 11) | 20) & 0xFu; }
#define XB_SPIN(cond, bar) do { unsigned _sp = 0; while (cond) { __builtin_amdgcn_s_sleep(1); \
    if ((++_sp & 255u) == 0u) { if (xb_ld(&(bar)[XB_TMO])) break; if (_sp > XB_SPIN_CAP) { atomicAdd(&(bar)[XB_TMO], 1u); break; } } } } while (0)

struct XcdBarrier {
    unsigned* bar; unsigned x;
    volatile LAS unsigned* st;
};

__device__ __forceinline__ XcdBarrier xcd_barrier_post(unsigned* bar, volatile LAS unsigned* st) {
    XcdBarrier b; b.bar = bar; b.x = xb_xcc_id(); b.st = st;
    if (threadIdx.x == 0) (void)xb_add(&bar[XB_XCNT(b.x)], 1u);
    return b;
}
__device__ __forceinline__ void xcd_barrier_complete(unsigned* bar, unsigned x, unsigned& nloc, unsigned& nx) {
    const unsigned G = gridDim.x * gridDim.y * gridDim.z;
    unsigned sum, cnt, mine, sp = 0u;
    for (;;) {
        sum = 0u; cnt = 0u; mine = 0u;
#pragma unroll
        for (unsigned j = 0; j < 16; ++j) { const unsigned c = xb_ld(&bar[XB_XCNT(j)]); sum += c; cnt += (c > 0u) ? 1u : 0u; mine = (j == x) ? c : mine; }
        if (sum == G) break;
        __builtin_amdgcn_s_sleep(1);
        if ((++sp & 255u) == 0u) { if (xb_ld(&bar[XB_TMO])) break; if (sp > XB_SPIN_CAP) { atomicAdd(&bar[XB_TMO], 1u); break; } }
    }
    nloc = mine > 0u ? mine : 1u; nx = cnt > 0u ? cnt : 1u;
}

__device__ __forceinline__ void xcd_barrier(const XcdBarrier& b) {
    asm volatile("s_waitcnt vmcnt(0)" ::: "memory");
    __syncthreads();
    if (threadIdx.x == 0) {
        unsigned* bar = b.bar;
        __builtin_amdgcn_s_waitcnt(0);
        unsigned nloc = b.st[0], nx = b.st[1];
        if (nloc == 0u) { xcd_barrier_complete(bar, b.x, nloc, nx); b.st[0] = nloc; b.st[1] = nx; }
        const unsigned old = xb_add(&bar[XB_XSUB(b.x)], 1u);
        const unsigned gen = old / nloc;
        if (old + 1u == (gen + 1u) * nloc) {
            __builtin_amdgcn_fence(__ATOMIC_RELEASE, "agent");
            asm volatile("s_waitcnt vmcnt(0)" ::: "memory");
            const unsigned og = xb_add(&bar[XB_TOP], 1u);
            const unsigned tg = og / nx;
            if (og + 1u == (tg + 1u) * nx) xb_add(&bar[XB_TOPGEN], 1u);
            else XB_SPIN(xb_ld(&bar[XB_TOPGEN]) == tg, bar);
            __builtin_amdgcn_fence(__ATOMIC_ACQUIRE, "agent");
            xb_add(&bar[XB_XGEN(b.x)], 1u);
            asm volatile("s_waitcnt vmcnt(0)" ::: "memory");
        } else {
            XB_SPIN(xb_ld(&bar[XB_XGEN(b.x)]) == gen, bar);
            __builtin_amdgcn_fence(__ATOMIC_ACQUIRE, "agent");
            asm volatile("s_waitcnt vmcnt(0)" ::: "memory");
        }
    }
    __syncthreads();
}

constexpr int NWAVES = 8;
constexpr int RING_OFF = 0, RING_BYTES = 131072;
constexpr int LDSCTL_OFF = RING_BYTES, MISC_OFF = LDSCTL_OFF + 320;
constexpr int LDS_BYTES = 147456;
constexpr int CW_BAR = 4096;
constexpr int PH_PROLOGUE = 0, PH_ROW0 = 1, PH_LAYER0 = 2, NPL = 15;
enum { S_UP1 = 0, S_DN1, S_ROWA, S_WIN, S_GLA, S_S5, S_ATTN, S_DFIN, S_GLU, S_BRANCH, S_WOUT, S_ROWB, S_UP2, S_DN2, S_ROWC };
constexpr int N_PHASES = PH_LAYER0 + DEPTH * NPL;

struct Args { const float* in[29]; float* out; unsigned char* ws; int ph_lo, ph_hi; };
struct Frame {
    LAS unsigned char* lds;
    int tid, lane, wave, vcu, G;
    const float* const* in; float* out; unsigned char* ws;
};

template <int MAP> __device__ __forceinline__ int conv_src(int n) {
    if (MAP == 0) return n;
    if (MAP == 1) { const int t = n >> 8, r = n & 255; return r < 128 ? 128 * t + r : DFF + 128 * t + (r - 128); }
    if (MAP == 2) return my2ref(n);
    { const int t = n >> 8, r = n & 255; return r < 128 ? 128 * t + r : 512 + 128 * t + (r - 128); }
}
template <int MAP> __device__ __forceinline__ void conv_item(const float* W, int K, int N, int Np, bf16_t* WT, LAS float* scr, int item, int lane) {
    const int nblk = Np / 32, kb = item / nblk, nb = item % nblk, k0 = 64 * kb, n0 = 32 * nb;
    const int src = conv_src<MAP>(n0 + (lane & 31));
#pragma unroll 8
    for (int i = 0; i < 32; ++i) { const int kk = 2 * i + (lane >> 5); scr[kk * 33 + (lane & 31)] = (src >= 0) ? W[(size_t)(k0 + kk) * N + src] : 0.f; }
    LDS_WAIT(); asm volatile("" ::: "memory");
    const int c = lane & 7;
#pragma unroll
    for (int j = 0; j < 4; ++j) { const int n = (lane >> 3) + 8 * j; const LAS float* s = scr + (8 * c) * 33 + n;
        v4u o; o.x = pk2(s[0 * 33], s[1 * 33]); o.y = pk2(s[2 * 33], s[3 * 33]); o.z = pk2(s[4 * 33], s[5 * 33]); o.w = pk2(s[6 * 33], s[7 * 33]);
        *(GAS v4u*)(WT + (size_t)(n0 + n) * K + k0 + 8 * c) = o; }
    LDS_WAIT(); asm volatile("" ::: "memory");
}
__device__ __forceinline__ void convert_layer(Frame& F, int l) {
    LAS float* scr = (LAS float*)(F.lds + RING_OFF + F.wave * 16384);
    const int gw = F.vcu * NWAVES + F.wave, NGW = F.G * NWAVES;
    bf16_t* wb = (bf16_t*)(F.ws + WS_W);
    constexpr int I_UP = (D / 64) * (2 * DFF / 32), I_DN = (DFF / 64) * (D / 32), I_IN = (D / 64) * (PW / 32), I_GLU = (512 / 64) * (1024 / 32), I_BR = I_GLU, I_OUT = (D / 64) * (D / 32);
    constexpr int NITEMS = 2 * I_UP + 2 * I_DN + I_IN + I_GLU + 3 * I_BR + I_OUT;
    const float* f1u = F.in[7] + (size_t)l * D * 2 * DFF; const float* f1d = F.in[8] + (size_t)l * DFF * D;
    const float* f2u = F.in[9] + (size_t)l * D * 2 * DFF; const float* f2d = F.in[10] + (size_t)l * DFF * D;
    const float* win = F.in[11] + (size_t)l * D * INW; const float* wglu = F.in[25] + (size_t)l * 512 * 1024;
    const float* wbr = F.in[27] + (size_t)l * 3 * 512 * D; const float* wout = F.in[28] + (size_t)l * D * D;
    for (int it = gw; it < NITEMS; it += NGW) {
        int r = it;
        if (r < I_UP) { conv_item<1>(f1u, D, 2 * DFF, 2 * DFF, wb + W_UP1, scr, r, F.lane); continue; } r -= I_UP;
        if (r < I_DN) { conv_item<0>(f1d, DFF, D, D, wb + W_DN1, scr, r, F.lane); continue; } r -= I_DN;
        if (r < I_UP) { conv_item<1>(f2u, D, 2 * DFF, 2 * DFF, wb + W_UP2, scr, r, F.lane); continue; } r -= I_UP;
        if (r < I_DN) { conv_item<0>(f2d, DFF, D, D, wb + W_DN2, scr, r, F.lane); continue; } r -= I_DN;
        if (r < I_IN) { conv_item<2>(win, D, INW, PW, wb + W_IN, scr, r, F.lane); continue; } r -= I_IN;
        if (r < I_GLU) { conv_item<3>(wglu, 512, 1024, 1024, wb + W_GLU, scr, r, F.lane); continue; } r -= I_GLU;
        if (r < 3 * I_BR) { const int i = r / I_BR; conv_item<0>(wbr + (size_t)i * 512 * D, 512, D, D, wb + W_BR + (size_t)i * 1024 * 512, scr, r % I_BR, F.lane); continue; } r -= 3 * I_BR;
        conv_item<0>(wout, D, D, D, wb + W_OUT, scr, r, F.lane);
    }
}
__device__ __forceinline__ void ada_phase(Frame& F) {
    if (F.vcu < 2 * 72) {
        const int l = F.vcu / 72, cb = F.vcu % 72;
        LAS float* cond = (LAS float*)(F.lds + RING_OFF);
        LAS float* red = (LAS float*)(F.lds + RING_OFF + 32768);
        const float* c = F.in[1];
        for (int i = F.tid; i < BATCH * D; i += NWAVES * 64) cond[i] = siluf_(c[i]);
        __syncthreads();
        float acc[BATCH][2];
#pragma unroll
        for (int b = 0; b < BATCH; ++b) { acc[b][0] = 0.f; acc[b][1] = 0.f; }
        const float* w = F.in[3] + ((size_t)l * D + F.wave * 128) * ADA + cb * 128 + 2 * F.lane;
#pragma unroll 4
        for (int k = 0; k < 128; ++k) { const float2 wv = *(const float2*)(w + (size_t)k * ADA);
#pragma unroll
            for (int b = 0; b < BATCH; ++b) { const float cv = cond[b * D + F.wave * 128 + k]; acc[b][0] += cv * wv.x; acc[b][1] += cv * wv.y; } }
#pragma unroll
        for (int b = 0; b < BATCH; ++b) { red[(F.wave * 8 + b) * 128 + 2 * F.lane] = acc[b][0]; red[(F.wave * 8 + b) * 128 + 2 * F.lane + 1] = acc[b][1]; }
        __syncthreads();
        float* ada = (float*)(F.ws + WS_ADA);
        for (int o = F.tid; o < BATCH * 128; o += NWAVES * 64) { const int b = o >> 7, cc = o & 127; float s = F.in[4][l * ADA + cb * 128 + cc];
#pragma unroll
            for (int w8 = 0; w8 < 8; ++w8) s += red[(w8 * 8 + b) * 128 + cc];
            ada[((size_t)l * BATCH + b) * ADA + cb * 128 + cc] = s; }
        __syncthreads();
    }
}
__device__ __forceinline__ void rowpass_phase(Frame& F, int l, int sub) {
    const int gw = F.vcu * NWAVES + F.wave, NGW = F.G * NWAVES;
    const float* ada = (const float*)(F.ws + WS_ADA); const float* adal = ada + (size_t)l * BATCH * ADA;
    const float* npre = F.in[5] + l * 3 * D; const float* npost = F.in[6] + l * 3 * D;
    bf16_t* u = (bf16_t*)(F.ws + WS_U); const bf16_t* y = (const bf16_t*)(F.ws + WS_Y);
    const float* h_in = F.out; const bf16_t* yy = y; const float* gpost = nullptr; const float* gate = nullptr; float coef = 0.f;
    const float* gpre = nullptr; const float* shift = nullptr; const float* scale = nullptr; bf16_t* uu = u;
    if (sub == 0) { h_in = F.in[0]; yy = nullptr; gpre = npre; shift = adal; scale = adal + D; }
    else if (sub == 1) { gpost = npost; gate = adal + 2 * D; coef = 0.5f; gpre = npre + D; shift = adal + 3 * D; scale = adal + 4 * D; }
    else if (sub == 2) { gpost = npost + D; gate = adal + 5 * D; coef = 1.0f; gpre = npre + 2 * D; shift = adal + 6 * D; scale = adal + 7 * D; }
    else { gpost = npost + 2 * D; gate = adal + 8 * D; coef = 0.5f;
        if (l + 1 < DEPTH) { gpre = F.in[5] + (l + 1) * 3 * D; shift = adal + (size_t)BATCH * ADA; scale = shift + D; } else uu = nullptr; }
    for (int row = gw; row < M; row += NGW) rowpass_row(row, F.lane, h_in, F.out, yy, gpost, gate, coef, gpre, shift, scale, uu);
}
__device__ __forceinline__ void dfin_phase(Frame& F, int l) {
    const int gw = F.vcu * NWAVES + F.wave, NGW = F.G * NWAVES;
    const float* lamv = F.in[15] + l * 256; const float lam_init = 0.8f - 0.6f * __expf(-0.3f * (float)l);
    const float lam = __expf(wave_sum(lamv[F.lane] * lamv[64 + F.lane])) - __expf(wave_sum(lamv[128 + F.lane] * lamv[192 + F.lane])) + lam_init;
    bf16_t* proj = (bf16_t*)(F.ws + WS_R0);
    for (int row = gw; row < M; row += NGW) diff_fin_row(proj + (size_t)row * PW, F.lane, lam, F.in[16] + l * 512, lam_init);
}

__device__ __forceinline__ void run_phase(Frame& F, int ph) {
    bf16_t* wb = (bf16_t*)(F.ws + WS_W); bf16_t* u = (bf16_t*)(F.ws + WS_U); bf16_t* y = (bf16_t*)(F.ws + WS_Y);
    bf16_t* hid = (bf16_t*)(F.ws + WS_R0); bf16_t* proj = (bf16_t*)(F.ws + WS_R0);
    if (ph == PH_PROLOGUE) { ada_phase(F); convert_layer(F, 0); return; }
    if (ph == PH_ROW0) { rowpass_phase(F, 0, 0); return; }
    const int l = (ph - PH_LAYER0) / NPL, s = (ph - PH_LAYER0) % NPL;
    const int cid = (int)blockIdx.x;
    switch (s) {
    case S_UP1: case S_UP2: {
        typedef pg8::GemmT<D, D, D, 0, 0> GT; GT g{u, wb + (s == S_UP1 ? W_UP1 : W_UP2)}; pg8::StaticOrder S; S.init(M, 2 * DFF, F.G, cid);
        pg8::EpiSwiGLU E{hid}; pg8::gemm_phase<pg8::EpiSwiGLU, pg8::StaticOrder, GT, true, true>(F.lds + RING_OFF, g, S, E); break; }
    case S_DN1: case S_DN2: {
        typedef pg8::GemmT<DFF, DFF, DFF, 0, 0> GT; GT g{hid, wb + (s == S_DN1 ? W_DN1 : W_DN2)}; pg8::StaticOrder S; S.init(M, D, F.G, cid);
        typedef pg8::EpiStore<D, 0> ET; ET E{y}; pg8::gemm_phase<ET, pg8::StaticOrder, GT, true, true>(F.lds + RING_OFF, g, S, E); break; }
    case S_ROWA: rowpass_phase(F, l, 1); break;
    case S_WIN: {
        typedef pg8::GemmT<D, D, D, 0, 0> GT; GT g{u, wb + W_IN}; pg8::StaticOrder S; S.init(M, PW, F.G, cid);
        typedef pg8::EpiStore<PW, 1> ET; ET E{proj}; pg8::gemm_phase<ET, pg8::StaticOrder, GT, true, true>(F.lds + RING_OFF, g, S, E); break; }
    case S_DFIN: dfin_phase(F, l); break;
    case S_GLU: {
        typedef pg8::GemmT<PW, 512, 512, 0, 0> GT; GT g{proj + C_YS5PRE, wb + W_GLU}; pg8::StaticOrder S; S.init(M, 1024, F.G, cid);
        pg8::EpiGLU E{proj, F.in[26] + l * 1024}; pg8::gemm_phase<pg8::EpiGLU, pg8::StaticOrder, GT, true, true>(F.lds + RING_OFF, g, S, E); break; }
    case S_BRANCH: {
        typedef pg8::GemmT<PW, 512, 512, 512 * 2, 1024 * 512 * 2> GT; GT g{proj + C_YGLA, wb + W_BR}; pg8::StaticOrder S; S.init(M, D, F.G, cid, 3);
        pg8::EpiBranch E{proj}; pg8::gemm_phase<pg8::EpiBranch, pg8::StaticOrder, GT, true, true>(F.lds + RING_OFF, g, S, E); break; }
    case S_WOUT: {
        typedef pg8::GemmT<PW, D, D, 0, 0> GT; GT g{proj + C_MERGED, wb + W_OUT}; pg8::StaticOrder S; S.init(M, D, F.G, cid);
        typedef pg8::EpiStore<D, 0> ET; ET E{y}; pg8::gemm_phase<ET, pg8::StaticOrder, GT, true, true>(F.lds + RING_OFF, g, S, E); break; }
    case S_ROWB: rowpass_phase(F, l, 2); break;
    case S_ROWC: rowpass_phase(F, l, 3); if (l + 1 < DEPTH) convert_layer(F, l + 1); break;
    default: break;
    }
}

__global__ void __launch_bounds__(NWAVES * 64, 2) mk_fwd(Args args) {
    extern __shared__ __attribute__((aligned(16))) unsigned char lds[];
    Frame F;
    F.lds = (LAS unsigned char*)lds;
    F.tid = threadIdx.x; F.lane = F.tid & 63; F.wave = __builtin_amdgcn_readfirstlane(F.tid >> 6);
    F.G = gridDim.x; { const int bx = blockIdx.x; F.vcu = (F.G % 8 == 0) ? (bx % 8) * (F.G / 8) + bx / 8 : bx; }
    F.in = args.in; F.out = args.out; F.ws = args.ws;
    for (int ph = args.ph_lo; ph < args.ph_hi; ++ph) {
        int t_ = threadIdx.x; asm volatile("" : "+v"(t_));
        F.tid = t_; F.lane = t_ & 63; F.wave = __builtin_amdgcn_readfirstlane(t_ >> 6);
        run_phase(F, ph);
    }
}

extern "C" void kernel_launch(void* const* d_in, const int* in_sizes, int n_in, void* d_out, int out_size, void* d_ws, size_t ws_size, hipStream_t stream) {
    static int grid = 0;
    if (grid == 0) {
        if (n_in != 29 || in_sizes[0] != M * D || out_size != M * D || ws_size < WS_END) {
            fprintf(stderr, "kernel_launch: unexpected shapes/workspace: n_in %d in0 %d out %d ws %zu (need %zu)\n", n_in, n_in > 0 ? in_sizes[0] : -1, out_size, ws_size, (size_t)WS_END); grid = -1; return; }
        int dev = 0, cus = 0;
        if (hipGetDevice(&dev) != hipSuccess || hipDeviceGetAttribute(&cus, hipDeviceAttributeMultiprocessorCount, dev) != hipSuccess) { grid = -1; return; }
        if (hipFuncSetAttribute((const void*)mk_fwd, hipFuncAttributeMaxDynamicSharedMemorySize, LDS_BYTES) != hipSuccess) { fprintf(stderr, "kernel_launch: hipFuncSetAttribute failed\n"); grid = -1; return; }
        grid = cus;
    }
    if (grid < 0) return;
    Args a{};
    for (int i = 0; i < 29; ++i) a.in[i] = (const float*)d_in[i];
    a.out = (float*)d_out; a.ws = (unsigned char*)d_ws;
    bf16_t* proj = (bf16_t*)((unsigned char*)d_ws + WS_R0);
    const float* rel_bias = (const float*)d_in[2];
    for (int ph = 0; ph < N_PHASES; ++ph) {
        const int l = ph < PH_LAYER0 ? 0 : (ph - PH_LAYER0) / NPL, s = ph < PH_LAYER0 ? -1 : (ph - PH_LAYER0) % NPL;
        if (s == S_GLA) { k_gla_naive<<<BATCH * 4, 256, 0, stream>>>(proj, (const float*)d_in[12] + l * 16 * 256, (const float*)d_in[13] + l * 256, (const float*)d_in[14] + l * 512); continue; }
        if (s == S_S5) { k_s5_naive<<<BATCH * 32, 64, 0, stream>>>(proj, (const float*)d_in[17] + l * 2048, (const float*)d_in[18] + l * 2048, (const float*)d_in[19] + l * 32, (const float*)d_in[20] + l * 32768,
                                                                     (const float*)d_in[21] + l * 32768, (const float*)d_in[22] + l * 32768, (const float*)d_in[23] + l * 32768, (const float*)d_in[24] + l * 512); continue; }
        if (s == S_ATTN) { k_attn_naive<<<BATCH * 8 * SEQ / 4, 256, 0, stream>>>(proj, rel_bias); continue; }
        a.ph_lo = ph; a.ph_hi = ph + 1;
        hipLaunchKernelGGL(mk_fwd, dim3(grid), dim3(NWAVES * 64), LDS_BYTES, stream, a);
    }
}
```

```cpp
#include <hip/hip_runtime.h>
#include <cstdio>
#include <cstdint>
#include <cmath>

constexpr int D = 1024, BATCH = 8, SEQ = 2048, DEPTH = 2, M = BATCH * SEQ;
constexpr int DFF = 2816, INW = 6672, PW = 6912;
constexpr int ADA = 9 * D;
constexpr float EPS = 1e-6f;
constexpr float LOG2E = 1.4426950408889634f;
constexpr float QSCALE = 0.125f * LOG2E;
constexpr int C_GV = 0, C_DQ = 512, C_DK = 1024, C_DV = 1536, C_GQ = 2048, C_GK = 2304, C_GR = 2560, C_SU = 3072, C_GATE = 3584, C_GA = 6656;
constexpr int C_O = C_GQ;
constexpr int C_YGLA = C_GV, C_YDIFF = C_DQ, C_YS5 = C_DK, C_YS5PRE = C_SU, C_MERGED = C_GQ;

typedef unsigned short bf16_t;
typedef short bf16x8 __attribute__((ext_vector_type(8)));
typedef float f32x4 __attribute__((ext_vector_type(4)));
typedef unsigned u32x4 __attribute__((ext_vector_type(4)));
__device__ __forceinline__ float bf2f(bf16_t v) { return __uint_as_float(((unsigned)v) << 16); }
__device__ __forceinline__ bf16_t f2bf(float f) { unsigned u = __float_as_uint(f); return (bf16_t)((u + 0x7fffu + ((u >> 16) & 1u)) >> 16); }
__device__ __forceinline__ unsigned pk2(float lo, float hi) { return (unsigned)f2bf(lo) | ((unsigned)f2bf(hi) << 16); }
__device__ __forceinline__ float blo(unsigned w) { return __uint_as_float(w << 16); }
__device__ __forceinline__ float bhi(unsigned w) { return __uint_as_float(w & 0xffff0000u); }
__device__ __forceinline__ float sigmoidf_(float x) { return 1.f / (1.f + __expf(-x)); }
__device__ __forceinline__ float siluf_(float x) { return x / (1.f + __expf(-x)); }
__device__ __forceinline__ float wave_sum(float v) {
#pragma unroll
    for (int o = 1; o < 64; o <<= 1) v += __shfl_xor(v, o);
    return v;
}
__device__ __forceinline__ float wave_max(float v) {
#pragma unroll
    for (int o = 1; o < 64; o <<= 1) v = fmaxf(v, __shfl_xor(v, o));
    return v;
}
__device__ __forceinline__ int ref2my(int c) {
    if (c < 256) return C_GQ + c;
    if (c < 512) return C_GK + (c - 256);
    if (c < 1024) return C_GV + (c - 512);
    if (c < 1536) return C_GR + (c - 1024);
    if (c < 1552) return C_GA + (c - 1536);
    if (c < 2064) return C_DQ + (c - 1552);
    if (c < 2576) return C_DK + (c - 2064);
    if (c < 3088) return C_DV + (c - 2576);
    if (c < 3600) return C_SU + (c - 3088);
    return C_GATE + (c - 3600);
}
__device__ __forceinline__ int my2ref(int c) {
    if (c < C_DQ) return 512 + c;
    if (c < C_DK) return 1552 + (c - C_DQ);
    if (c < C_DV) return 2064 + (c - C_DK);
    if (c < C_GQ) return 2576 + (c - C_DV);
    if (c < C_GK) return c - C_GQ;
    if (c < C_GR) return 256 + (c - C_GK);
    if (c < C_SU) return 1024 + (c - C_GR);
    if (c < C_GATE) return 3088 + (c - C_SU);
    if (c < C_GA) return 3600 + (c - C_GATE);
    if (c < C_GA + 16) return 1536 + (c - C_GA);
    return -1;
}
__device__ const unsigned char T5B[128] = {0, 1, 2, 3, 4, 5, 6, 7, 8, 9, 10, 11, 12, 13, 14, 15, 16, 16, 16, 17, 17, 18, 18, 18, 19, 19, 19, 20, 20, 20, 20, 21, 21, 21, 21, 22, 22, 22, 22, 22, 23, 23, 23, 23, 23, 23, 24, 24, 24, 24, 24, 24, 25, 25, 25, 25, 25, 25, 25, 26, 26, 26, 26, 26, 26, 26, 26, 27, 27, 27, 27, 27, 27, 27, 27, 27, 27, 28, 28, 28, 28, 28, 28, 28, 28, 28, 28, 29, 29, 29, 29, 29, 29, 29, 29, 29, 29, 29, 29, 30, 30, 30, 30, 30, 30, 30, 30, 30, 30, 30, 30, 30, 30, 31, 31, 31, 31, 31, 31, 31, 31, 31, 31, 31, 31, 31, 31, 31};

constexpr size_t MiB = 1u << 20;
constexpr size_t WS_CTL = 0, CTL_ZERO_BYTES = 1 * MiB, WS_ADA = 1 * MiB, WS_S5ST = 2 * MiB, WS_W = 6 * MiB, WS_U = 59 * MiB, WS_GLA = 91 * MiB, WS_R0 = 123 * MiB, WS_END = 339 * MiB;
constexpr size_t WS_Y = WS_GLA;
constexpr size_t W_UP1 = 0, W_DN1 = W_UP1 + (size_t)2 * DFF * D, W_UP2 = W_DN1 + (size_t)D * DFF, W_DN2 = W_UP2 + (size_t)2 * DFF * D, W_IN = W_DN2 + (size_t)D * DFF,
                 W_GLU = W_IN + (size_t)PW * D, W_BR = W_GLU + (size_t)1024 * 512, W_OUT = W_BR + (size_t)3 * 1024 * 512, W_END = W_OUT + (size_t)D * D;
static_assert(W_END * 2 <= 53 * MiB, "weights fit");

__device__ __forceinline__ void rowpass_row(int row, int lane, const float* h_in, float* h_out, const bf16_t* y, const float* gpost, const float* gate, float coef,
                                            const float* gpre, const float* shift, const float* scale, bf16_t* u) {
    const int b = row / SEQ;
    f32x4 hv[4];
#pragma unroll
    for (int j = 0; j < 4; ++j) hv[j] = *(const f32x4*)(h_in + (size_t)row * D + j * 256 + lane * 4);
    if (y) {
        float yv[4][4]; float ss = 0.f;
#pragma unroll
        for (int j = 0; j < 4; ++j) {
            const uint2 raw = *(const uint2*)(y + (size_t)row * D + j * 256 + lane * 4);
            yv[j][0] = blo(raw.x); yv[j][1] = bhi(raw.x); yv[j][2] = blo(raw.y); yv[j][3] = bhi(raw.y);
#pragma unroll
            for (int i = 0; i < 4; ++i) ss += yv[j][i] * yv[j][i];
        }
        const float r = rsqrtf(wave_sum(ss) * (1.f / D) + EPS);
#pragma unroll
        for (int j = 0; j < 4; ++j) {
            const int c0 = j * 256 + lane * 4;
            const f32x4 gp = *(const f32x4*)(gpost + c0), gt = *(const f32x4*)(gate + (size_t)b * ADA + c0);
#pragma unroll
            for (int i = 0; i < 4; ++i) hv[j][i] += coef * gt[i] * (yv[j][i] * r * gp[i]);
        }
    }
    if (y || h_in != h_out) {
#pragma unroll
        for (int j = 0; j < 4; ++j) *(f32x4*)(h_out + (size_t)row * D + j * 256 + lane * 4) = hv[j];
    }
    if (u) {
        float ss = 0.f;
#pragma unroll
        for (int j = 0; j < 4; ++j)
#pragma unroll
            for (int i = 0; i < 4; ++i) ss += hv[j][i] * hv[j][i];
        const float r = rsqrtf(wave_sum(ss) * (1.f / D) + EPS);
#pragma unroll
        for (int j = 0; j < 4; ++j) {
            const int c0 = j * 256 + lane * 4;
            const f32x4 g = *(const f32x4*)(gpre + c0), sh = *(const f32x4*)(shift + (size_t)b * ADA + c0), sc = *(const f32x4*)(scale + (size_t)b * ADA + c0);
            float o[4];
#pragma unroll
            for (int i = 0; i < 4; ++i) o[i] = hv[j][i] * r * g[i] * (1.f + sc[i]) + sh[i];
            uint2 w; w.x = pk2(o[0], o[1]); w.y = pk2(o[2], o[3]);
            *(uint2*)(u + (size_t)row * D + c0) = w;
        }
    }
}

__global__ __launch_bounds__(256) void k_gla_naive(bf16_t* proj, const float* w_alpha, const float* b_alpha, const float* norm_g) {
    const int b = blockIdx.x >> 2, h = blockIdx.x & 3, t = threadIdx.x, lane = t & 63, e = t & 127, half = t >> 7;
    __shared__ float sa[64], sq[64], sk[64], part[2][128], red[2];
    float S[32];
#pragma unroll
    for (int i = 0; i < 32; ++i) S[i] = 0.f;
    float wa[16]; float ba = 0.f;
#pragma unroll
    for (int j = 0; j < 16; ++j) wa[j] = 0.f;
    if (t < 64) { for (int j = 0; j < 16; ++j) wa[j] = w_alpha[j * 256 + h * 64 + t]; ba = b_alpha[h * 64 + t]; }
    const float ng = norm_g[h * 128 + e];
    for (int s = 0; s < SEQ; ++s) {
        bf16_t* row = proj + (size_t)(b * SEQ + s) * PW;
        if (t < 64) {
            float z = ba;
#pragma unroll
            for (int j = 0; j < 16; ++j) z += bf2f(row[C_GA + j]) * wa[j];
            const float ls = fminf(z, 0.f) - log1pf(__expf(-fabsf(z)));
            sa[t] = __expf(ls * (1.f / 16.f)); sq[t] = bf2f(row[C_GQ + h * 64 + t]); sk[t] = bf2f(row[C_GK + h * 64 + t]);
        }
        const float v = bf2f(row[C_GV + h * 128 + e]);
        const float rr = bf2f(row[C_GR + h * 128 + e]);
        __syncthreads();
        float p = 0.f;
#pragma unroll
        for (int i = 0; i < 32; ++i) { const int d = half * 32 + i; S[i] = sa[d] * S[i] + sk[d] * v; p += sq[d] * S[i]; }
        part[half][e] = p;
        __syncthreads();
        float o = 0.f;
        if (t < 128) { o = part[0][e] + part[1][e]; const float ss = wave_sum(o * o); if (lane == 0) red[t >> 6] = ss; }
        __syncthreads();
        if (t < 128) { const float r = rsqrtf((red[0] + red[1]) * (1.f / 128.f) + EPS); row[C_YGLA + h * 128 + e] = f2bf(o * r * ng * siluf_(rr)); }
        __syncthreads();
    }
}

__global__ __launch_bounds__(64) void k_s5_naive(bf16_t* proj, const float* lam_re, const float* lam_im, const float* log_step, const float* b_re, const float* b_im,
                                                 const float* c_re, const float* c_im, const float* d_skip) {
    const int b = blockIdx.x >> 5, g = blockIdx.x & 31, p = threadIdx.x;
    const float lr = lam_re[g * 64 + p], li = lam_im[g * 64 + p], dt = expf(log_step[g]);
    const float mag = expf(lr * dt), ar = mag * cosf(li * dt), ai = mag * sinf(li * dt);
    const float nr = ar - 1.f, ni = ai, den = lr * lr + li * li, fre = (nr * lr + ni * li) / den, fim = (ni * lr - nr * li) / den;
    float bbr[16], bbi[16], cr[16], ci[16];
#pragma unroll
    for (int h = 0; h < 16; ++h) { const float br = b_re[(g * 64 + p) * 16 + h], bi = b_im[(g * 64 + p) * 16 + h]; bbr[h] = fre * br - fim * bi; bbi[h] = fre * bi + fim * br;
        cr[h] = c_re[(g * 16 + h) * 64 + p]; ci[h] = c_im[(g * 16 + h) * 64 + p]; }
    const float dsk = (p < 16) ? d_skip[g * 16 + p] : 0.f;
    float xr = 0.f, xi = 0.f;
    for (int s = 0; s < SEQ; ++s) {
        bf16_t* row = proj + (size_t)(b * SEQ + s) * PW + C_SU + g * 16;
        float u[16];
#pragma unroll
        for (int h = 0; h < 16; ++h) u[h] = bf2f(row[h]);
        float bur = 0.f, bui = 0.f;
#pragma unroll
        for (int h = 0; h < 16; ++h) { bur += bbr[h] * u[h]; bui += bbi[h] * u[h]; }
        const float nxr = ar * xr - ai * xi + bur, nxi = ar * xi + ai * xr + bui; xr = nxr; xi = nxi;
        float yn = 0.f;
#pragma unroll
        for (int n = 0; n < 16; ++n) { const float v = wave_sum(cr[n] * xr - ci[n] * xi); if (p == n) yn = v + dsk * u[n]; }
        if (p < 16) { const float x3 = yn * yn * yn; const float gl = 0.5f * yn * (1.f + tanhf(0.7978845608028654f * (yn + 0.044715f * x3))); row[p] = f2bf(gl); }
    }
}

__global__ __launch_bounds__(256) void k_attn_naive(bf16_t* proj, const float* rel_bias) {
    __shared__ float sc[4][SEQ];
    __shared__ float sq[4][64];
    const int w = threadIdx.x >> 6, lane = threadIdx.x & 63;
    const int gw = blockIdx.x * 4 + w;
    const int q = gw % SEQ, m = (gw / SEQ) % 8, b = gw / (SEQ * 8);
    const bf16_t* base = proj + (size_t)b * SEQ * PW;
    sq[w][lane] = bf2f(base[(size_t)q * PW + C_DQ + m * 64 + lane]);
    __syncthreads();
    float mx = -INFINITY;
    for (int s0 = 0; s0 <= q; s0 += 64) {
        const int s = s0 + lane;
        float v = -INFINITY;
        if (s <= q) {
            const bf16_t* kr = base + (size_t)s * PW + C_DK + m * 64; float a = 0.f;
            for (int d = 0; d < 64; ++d) a += sq[w][d] * bf2f(kr[d]);
            const int dist = q - s; const int bk = T5B[dist < 127 ? dist : 127];
            v = a + rel_bias[bk * 8 + m] * LOG2E;
        }
        sc[w][s] = v; mx = fmaxf(mx, v);
    }
    mx = wave_max(mx);
    float sum = 0.f;
    for (int s0 = 0; s0 <= q; s0 += 64) { const int s = s0 + lane; if (s <= q) { const float pz = exp2f(sc[w][s] - mx); sc[w][s] = pz; sum += pz; } }
    sum = wave_sum(sum);
    __syncthreads();
    const int hh = m >> 1; float o0 = 0.f, o1 = 0.f;
    for (int s = 0; s <= q; ++s) { const float pz = sc[w][s]; const unsigned vv = *(const unsigned*)(base + (size_t)s * PW + C_DV + hh * 128 + lane * 2);
        o0 += pz * blo(vv); o1 += pz * bhi(vv); }
    __syncthreads();
    const float inv = 1.f / sum;
    bf16_t* orow = proj + (size_t)(b * SEQ + q) * PW + C_O + m * 128 + lane * 2;
    *(unsigned*)orow = pk2(o0 * inv, o1 * inv);
}

__device__ __forceinline__ void diff_fin_row(bf16_t* r, int lane, float lam, const float* norm_g, float lam_init) {
#pragma unroll
    for (int h = 0; h < 4; ++h) {
        const unsigned a = *(const unsigned*)(r + C_O + (2 * h) * 128 + lane * 2), c = *(const unsigned*)(r + C_O + (2 * h + 1) * 128 + lane * 2);
        const float o0 = blo(a) - lam * blo(c), o1 = bhi(a) - lam * bhi(c);
        const float rs = rsqrtf(wave_sum(o0 * o0 + o1 * o1) * (1.f / 128.f) + EPS) * (1.f - lam_init);
        const float g0 = norm_g[h * 128 + lane * 2], g1 = norm_g[h * 128 + lane * 2 + 1];
        *(unsigned*)(r + C_YDIFF + h * 128 + lane * 2) = pk2(o0 * rs * g0, o1 * rs * g1);
    }
}
__global__ __launch_bounds__(256) void k_diff_fin(bf16_t* proj, const float* lamv, const float* norm_g, float lam_init) {
    const int lane = threadIdx.x & 63, row = blockIdx.x * 4 + (threadIdx.x >> 6);
    const float lam = __expf(wave_sum(lamv[lane] * lamv[64 + lane])) - __expf(wave_sum(lamv[128 + lane] * lamv[192 + lane])) + lam_init;
    diff_fin_row(proj + (size_t)row * PW, lane, lam, norm_g, lam_init);
}

namespace pg8 {
#define PG8_LAS __attribute__((address_space(3)))
constexpr int BM = 256, BK = 64, HALF = 128, HTB = HALF * BK * 2  , STAGE_BYTES = 8 * HTB, NXCD = 8, WGM = 8;

__host__ __device__ __forceinline__ int lds_byte(int r, int c) { const int st = (r >> 4) * 2 + (c >> 5), rr = r & 15, cc = c & 31, ob = rr * 64 + cc * 2; return st * 1024 + (ob ^ (((ob >> 9) & 1) << 5)); }
__host__ __device__ __forceinline__ void stage_rc(int b, int& R, int& C) { const int st = b / 1024, sb = b % 1024, swz = sb ^ (((sb >> 9) & 1) << 5); R = (st >> 1) * 16 + swz / 64; C = (st & 1) * 32 + (swz % 64) / 2; }
__host__ __device__ __forceinline__ int perm32(int rho) { const int n = rho >> 4, i = rho & 15; return 8 * (i >> 2) + 4 * n + (i & 3); }

struct Unit { int pm, pn, z; };
template <int LDA, int LDB, int KK, int ZA, int ZB> struct GemmT { const bf16_t* A; const bf16_t* Bt; static constexpr int lda = LDA, ldb = LDB, K = KK; static constexpr size_t zA = ZA, zB = ZB; };

struct StaticOrder {
    int nM, nN, nwg, G, c, nZ;
    __host__ __device__ void init(int M_, int N_, int G_, int c_, int nZ_ = 1) { nM = M_ / BM; nN = N_ / BM; nwg = nM * nN; G = G_; c = c_; nZ = nZ_; }
    __host__ __device__ bool next(int i, Unit& u) const {
        const long L = (long)(i / nZ) * G + c; if (L >= nwg) return false;
        int wgid = (int)L; { const int q = nwg / NXCD, r = nwg % NXCD, xcd = wgid % NXCD, off = wgid / NXCD; wgid = (xcd < r ? xcd * (q + 1) : r * (q + 1) + (xcd - r) * q) + off; }
        const int nig = WGM * nN, gid = wgid / nig, fm = gid * WGM, gsz = (nM - fm) < WGM ? (nM - fm) : WGM;
        u.pm = fm + ((wgid % nig) % gsz); u.pn = (wgid % nig) / gsz; u.z = i % nZ; return true;
    }
    __device__ __forceinline__ void a_ready(const Unit&) const {}
    __device__ __forceinline__ void done(const Unit&) const {}
};
__device__ __forceinline__ unsigned cvt_pk_bf16(float lo, float hi) { unsigned r; asm volatile("v_cvt_pk_bf16_f32 %0, %1, %2" : "=v"(r) : "v"(lo), "v"(hi)); return r; }

__device__ __forceinline__ u32x4 pack8(const f32x4 v0, const f32x4 v1) { u32x4 w; w.x = cvt_pk_bf16(v0[0], v0[1]); w.y = cvt_pk_bf16(v0[2], v0[3]); w.z = cvt_pk_bf16(v1[0], v1[1]); w.w = cvt_pk_bf16(v1[2], v1[3]); return w; }
__device__ __forceinline__ float fsig(float x) { return __builtin_amdgcn_rcpf(1.f + __expf(-x)); }
template <int ldc, int mode> struct EpiStore {
    static constexpr bool PERM = true, AFTER_DRAIN = false;
    bf16_t* O;
    __device__ __forceinline__ void operator()(const f32x4 (&acc)[2][2][4][2], const Unit& u, int wr, int wc, int fr, int fq) const {
        float sc = 1.f; if (mode == 1) { if (u.pn == 2 || u.pn == 3) sc = QSCALE; else if (u.pn == 8) sc = 0.125f; }
        const int row0 = u.pm * BM + wr * 64 + fr, col0 = u.pn * BM + wc * 32 + 8 * fq;
#pragma unroll
        for (int ai = 0; ai < 2; ++ai)
#pragma unroll
            for (int m = 0; m < 4; ++m) { bf16_t* rowp = O + (size_t)(row0 + ai * HALF + m * 16) * ldc + col0;
#pragma unroll
                for (int bj = 0; bj < 2; ++bj) *(u32x4*)(rowp + bj * HALF) = pack8(acc[ai][bj][m][0] * sc, acc[ai][bj][m][1] * sc); }
    }
};
struct EpiSwiGLU {
    static constexpr bool PERM = true, AFTER_DRAIN = false;
    bf16_t* H;
    __device__ __forceinline__ void operator()(const f32x4 (&acc)[2][2][4][2], const Unit& u, int wr, int wc, int fr, int fq) const {
        const int row0 = u.pm * BM + wr * 64 + fr, col0 = u.pn * HALF + wc * 32 + 8 * fq;
#pragma unroll
        for (int ai = 0; ai < 2; ++ai)
#pragma unroll
            for (int m = 0; m < 4; ++m) { f32x4 o[2];
#pragma unroll
                for (int n = 0; n < 2; ++n)
#pragma unroll
                    for (int j = 0; j < 4; ++j) { const float g = acc[ai][0][m][n][j]; o[n][j] = g * fsig(g) * acc[ai][1][m][n][j]; }
                *(u32x4*)(H + (size_t)(row0 + ai * HALF + m * 16) * DFF + col0) = pack8(o[0], o[1]); }
    }
};
struct EpiGLU {
    static constexpr bool PERM = true, AFTER_DRAIN = false;
    bf16_t* P; const float* bias;
    __device__ __forceinline__ void operator()(const f32x4 (&acc)[2][2][4][2], const Unit& u, int wr, int wc, int fr, int fq) const {
        const int row0 = u.pm * BM + wr * 64 + fr, col0 = u.pn * HALF + wc * 32 + 8 * fq;
        f32x4 bv[2], bg[2];
#pragma unroll
        for (int n = 0; n < 2; ++n) { bv[n] = *(const f32x4*)(bias + col0 + 4 * n); bg[n] = *(const f32x4*)(bias + 512 + col0 + 4 * n); }
#pragma unroll
        for (int ai = 0; ai < 2; ++ai)
#pragma unroll
            for (int m = 0; m < 4; ++m) { f32x4 o[2];
#pragma unroll
                for (int n = 0; n < 2; ++n)
#pragma unroll
                    for (int j = 0; j < 4; ++j) o[n][j] = (acc[ai][0][m][n][j] + bv[n][j]) * fsig(acc[ai][1][m][n][j] + bg[n][j]);
                *(u32x4*)(P + (size_t)(row0 + ai * HALF + m * 16) * PW + C_YS5 + col0) = pack8(o[0], o[1]); }
    }
};
struct EpiBranch {
    static constexpr bool PERM = true, AFTER_DRAIN = false;
    bf16_t* P;
    __device__ __forceinline__ void operator()(const f32x4 (&acc)[2][2][4][2], const Unit& u, int wr, int wc, int fr, int fq) const {
        const int row0 = u.pm * BM + wr * 64 + fr, col0 = u.pn * BM + wc * 32 + 8 * fq;
#pragma unroll
        for (int ai = 0; ai < 2; ++ai)
#pragma unroll
            for (int m = 0; m < 4; ++m) { bf16_t* rowp = P + (size_t)(row0 + ai * HALF + m * 16) * PW;
#pragma unroll
                for (int bj = 0; bj < 2; ++bj) { const int col = col0 + bj * HALF;
                    const u32x4 gw = *(const u32x4*)(rowp + C_GATE + u.z * D + col);
                    u32x4 pw = (u32x4){0u, 0u, 0u, 0u}; if (u.z > 0) pw = *(const u32x4*)(rowp + C_MERGED + col);
                    f32x4 o[2];
#pragma unroll
                    for (int n = 0; n < 2; ++n) { const unsigned g0 = gw[2 * n], g1 = gw[2 * n + 1], p0 = pw[2 * n], p1 = pw[2 * n + 1];
                        o[n][0] = blo(p0) + fsig(blo(g0)) * acc[ai][bj][m][n][0]; o[n][1] = bhi(p0) + fsig(bhi(g0)) * acc[ai][bj][m][n][1];
                        o[n][2] = blo(p1) + fsig(blo(g1)) * acc[ai][bj][m][n][2]; o[n][3] = bhi(p1) + fsig(bhi(g1)) * acc[ai][bj][m][n][3]; }
                    *(u32x4*)(rowp + C_MERGED + col) = pack8(o[0], o[1]); } }
    }
};

template <class Epi, class Sched, class GemmX, bool ALIGN_EPI = false, bool SP2 = false>
__device__ __forceinline__ void gemm_phase(PG8_LAS unsigned char* lds, const GemmX g, const Sched& S, const Epi& E) {
    int tid_ = threadIdx.x; asm volatile("" : "+v"(tid_));
    const int tid = tid_, wid = __builtin_amdgcn_readfirstlane(tid >> 6), lane = tid & 63, wr = wid >> 2, wc = wid & 3, fr = lane & 15, fq = lane >> 4;
    const int K = g.K, nt = K / BK;
    unsigned voffA[2], voffB[2];
#pragma unroll
    for (int i = 0; i < 2; ++i) { int R, C; stage_rc(tid * 16 + i * 8192, R, C); const int Rb = Epi::PERM ? ((R & ~31) + perm32(R & 31)) : R;
        voffA[i] = (unsigned)(R * g.lda + C) * 2u; voffB[i] = (unsigned)(Rb * g.ldb + C) * 2u; }
    const size_t kstep = (size_t)(BK * 2);
    const size_t hstepA = (size_t)HALF * g.lda * 2, hstepB = (size_t)HALF * g.ldb * 2;
    const size_t tstepA = 2 * hstepA, tstepB = 2 * hstepB;
    const unsigned ldsw = (unsigned)wid * 1024u;
    const int aoff = lds_byte(wr * 64 + fr, fq * 8), boff = lds_byte(wc * 32 + fr, fq * 8);
#define PG8_SA(b, h) (((b) * 2 + (h)) * HTB)
#define PG8_SB(b, h) ((4 + (b) * 2 + (h)) * HTB)
#define PG8_STAGE(bufoff, gbase, voff) do { _Pragma("unroll") for (int _i = 0; _i < 2; ++_i) \
        __builtin_amdgcn_global_load_lds((const unsigned*)((const char*)(gbase) + (voff)[_i]), (PG8_LAS unsigned*)(lds + (bufoff) + ldsw + _i * 8192), 16, 0, 0); } while (0)
#define PG8_LDA(dst, b, h) do { _Pragma("unroll") for (int m = 0; m < 4; ++m) _Pragma("unroll") for (int k = 0; k < 2; ++k) dst[m][k] = *(const PG8_LAS bf16x8*)(lds + PG8_SA(b, h) + aoff + m * 2048 + k * 1024); } while (0)
#define PG8_LDB(dst, b, h) do { _Pragma("unroll") for (int n = 0; n < 2; ++n) _Pragma("unroll") for (int k = 0; k < 2; ++k) dst[n][k] = *(const PG8_LAS bf16x8*)(lds + PG8_SB(b, h) + boff + n * 2048 + k * 1024); } while (0)
#define PG8_MMA(ai, bj, At, Bt) do { __builtin_amdgcn_s_setprio(1); _Pragma("unroll") for (int m = 0; m < 4; ++m) _Pragma("unroll") for (int n = 0; n < 2; ++n) _Pragma("unroll") for (int k = 0; k < 2; ++k) \
        acc[ai][bj][m][n] = __builtin_amdgcn_mfma_f32_16x16x32_bf16(Bt[n][k], At[m][k], acc[ai][bj][m][n], 0, 0, 0); __builtin_amdgcn_s_setprio(0); } while (0)
#define PG8_WAIT_V(n) asm volatile("s_waitcnt vmcnt(" #n ")" ::: "memory")
#define PG8_WAIT_L(n) asm volatile("s_waitcnt lgkmcnt(" #n ")" ::: "memory")
#define PG8_BAR __builtin_amdgcn_s_barrier()
#define PG8_SCHED __builtin_amdgcn_sched_barrier(0)
    Unit cur, nxt; int ui = 0;
    if (!S.next(0, cur)) return;
    f32x4 acc[2][2][4][2];
#pragma unroll
    for (int a = 0; a < 2; ++a)
#pragma unroll
        for (int b = 0; b < 2; ++b)
#pragma unroll
            for (int m = 0; m < 4; ++m)
#pragma unroll
                for (int n = 0; n < 2; ++n) acc[a][b][m][n] = (f32x4){0.f, 0.f, 0.f, 0.f};
    bf16x8 At[4][2], B0[2][2], B1[2][2];
    const char* cA = (const char*)g.A + (size_t)cur.pm * tstepA + (size_t)cur.z * g.zA; const char* cB = (const char*)g.Bt + (size_t)cur.pn * tstepB + (size_t)cur.z * g.zB;
    S.a_ready(cur);
    if constexpr (SP2) {
        PG8_STAGE(PG8_SB(0, 0), cB, voffB); PG8_STAGE(PG8_SB(0, 1), cB + hstepB, voffB); PG8_STAGE(PG8_SA(0, 0), cA, voffA); PG8_STAGE(PG8_SA(0, 1), cA + hstepA, voffA);
        if (wr == 1) PG8_BAR;
        PG8_WAIT_V(2); PG8_BAR;
        PG8_STAGE(PG8_SB(1, 0), cB + kstep, voffB); PG8_STAGE(PG8_SA(1, 0), cA + kstep, voffA); PG8_STAGE(PG8_SB(1, 1), cB + hstepB + kstep, voffB);
        PG8_WAIT_V(6); PG8_BAR;
    } else {
        PG8_STAGE(PG8_SB(0, 0), cB, voffB); PG8_STAGE(PG8_SA(0, 0), cA, voffA); PG8_STAGE(PG8_SB(0, 1), cB + hstepB, voffB); PG8_STAGE(PG8_SA(0, 1), cA + hstepA, voffA);
        if (wr == 1) PG8_BAR;
        PG8_WAIT_V(4); PG8_BAR;
        PG8_STAGE(PG8_SB(1, 0), cB + kstep, voffB); PG8_STAGE(PG8_SA(1, 0), cA + kstep, voffA); PG8_STAGE(PG8_SB(1, 1), cB + hstepB + kstep, voffB);
        PG8_WAIT_V(6); PG8_BAR;
    }
    for (;;) {
        const bool has_next = S.next(ui + 1, nxt);
        const char* nA = has_next ? (const char*)g.A + (size_t)nxt.pm * tstepA + (size_t)nxt.z * g.zA : cA; const char* nB = has_next ? (const char*)g.Bt + (size_t)nxt.pn * tstepB + (size_t)nxt.z * g.zB : cB;
        for (int t = 0; t < nt; t += 2) {
            const bool last = (t == nt - 2);
            const char* a1 = cA + (size_t)(t + 1) * kstep;
            const char* a2 = last ? nA : cA + (size_t)(t + 2) * kstep; const char* b2 = last ? nB : cB + (size_t)(t + 2) * kstep;
            const char* a3 = a2 + kstep; const char* b3 = b2 + kstep;
            if (last && has_next) S.a_ready(nxt);
            if constexpr (SP2) {
            PG8_LDB(B0, 0, 0); PG8_LDB(B1, 0, 1); PG8_SCHED; PG8_LDA(At, 0, 0); PG8_STAGE(PG8_SA(1, 1), a1 + hstepA, voffA);
            PG8_WAIT_V(8); PG8_WAIT_L(0); PG8_BAR; PG8_MMA(0, 0, At, B0); PG8_MMA(0, 1, At, B1); PG8_BAR; PG8_SCHED;
            PG8_LDA(At, 0, 1); PG8_STAGE(PG8_SB(0, 0), b2, voffB); PG8_STAGE(PG8_SB(0, 1), b2 + hstepB, voffB); PG8_STAGE(PG8_SA(0, 0), a2, voffA);
            PG8_WAIT_V(8); PG8_WAIT_L(0); PG8_BAR; PG8_MMA(1, 0, At, B0); PG8_MMA(1, 1, At, B1); PG8_BAR; PG8_SCHED;
            PG8_LDB(B0, 1, 0); PG8_LDB(B1, 1, 1); PG8_SCHED; PG8_LDA(At, 1, 0); PG8_STAGE(PG8_SA(0, 1), a2 + hstepA, voffA);
            PG8_WAIT_V(8); PG8_WAIT_L(0); PG8_BAR; PG8_MMA(0, 0, At, B0); PG8_MMA(0, 1, At, B1); PG8_BAR; PG8_SCHED;
            PG8_LDA(At, 1, 1); PG8_STAGE(PG8_SB(1, 0), b3, voffB); PG8_STAGE(PG8_SB(1, 1), b3 + hstepB, voffB); PG8_STAGE(PG8_SA(1, 0), a3, voffA);
            PG8_WAIT_V(8); PG8_WAIT_L(0); PG8_BAR; PG8_MMA(1, 0, At, B0); PG8_MMA(1, 1, At, B1); PG8_BAR; PG8_SCHED;
            } else {
            PG8_LDB(B0, 0, 0); PG8_SCHED; PG8_LDA(At, 0, 0); PG8_STAGE(PG8_SA(1, 1), a1 + hstepA, voffA);
            PG8_WAIT_L(8); PG8_BAR; PG8_WAIT_L(0); PG8_MMA(0, 0, At, B0); PG8_BAR; PG8_SCHED;
            PG8_LDB(B1, 0, 1); PG8_STAGE(PG8_SB(0, 0), b2, voffB);
            PG8_BAR; PG8_WAIT_L(0); PG8_MMA(0, 1, At, B1); PG8_BAR;
            PG8_LDA(At, 0, 1); PG8_STAGE(PG8_SA(0, 0), a2, voffA);
            PG8_BAR; PG8_WAIT_L(0); PG8_MMA(1, 0, At, B0); PG8_BAR; PG8_SCHED;
            PG8_STAGE(PG8_SB(0, 1), b2 + hstepB, voffB);
            PG8_WAIT_V(6); PG8_BAR; PG8_MMA(1, 1, At, B1); PG8_BAR;
            PG8_LDB(B0, 1, 0); PG8_SCHED; PG8_LDA(At, 1, 0); PG8_STAGE(PG8_SA(0, 1), a2 + hstepA, voffA);
            PG8_WAIT_L(8); PG8_BAR; PG8_WAIT_L(0); PG8_MMA(0, 0, At, B0); PG8_BAR; PG8_SCHED;
            PG8_LDB(B1, 1, 1); PG8_STAGE(PG8_SB(1, 0), b3, voffB);
            PG8_BAR; PG8_WAIT_L(0); PG8_MMA(0, 1, At, B1); PG8_BAR;
            PG8_LDA(At, 1, 1); PG8_STAGE(PG8_SA(1, 0), a3, voffA);
            PG8_BAR; PG8_WAIT_L(0); PG8_MMA(1, 0, At, B0); PG8_BAR; PG8_SCHED;
            PG8_STAGE(PG8_SB(1, 1), b3 + hstepB, voffB);
            PG8_WAIT_V(6); PG8_BAR; PG8_MMA(1, 1, At, B1); PG8_BAR;
            }
        }
        if constexpr (ALIGN_EPI) { if (wr == 0) PG8_BAR; }
        if constexpr (!Epi::AFTER_DRAIN) { E(acc, cur, wr, wc, fr, fq); S.done(cur); }
        if (!has_next) break;
#pragma unroll
        for (int a = 0; a < 2; ++a)
#pragma unroll
            for (int b = 0; b < 2; ++b)
#pragma unroll
                for (int m = 0; m < 4; ++m)
#pragma unroll
                    for (int n = 0; n < 2; ++n) acc[a][b][m][n] = (f32x4){0.f, 0.f, 0.f, 0.f};
        cur = nxt; cA = nA; cB = nB; ++ui;
        if constexpr (ALIGN_EPI) { if (wr == 1) PG8_BAR; }
    }
    PG8_WAIT_V(0);
    if constexpr (!ALIGN_EPI) { if (wr == 0) PG8_BAR; }
    PG8_BAR;
    if constexpr (Epi::AFTER_DRAIN) { E.fused(acc, cur, wr, wc, fr, fq, lds, wid, lane); S.done(cur); }
#undef PG8_SA
#undef PG8_SB
#undef PG8_STAGE
#undef PG8_LDA
#undef PG8_LDB
#undef PG8_MMA
#undef PG8_WAIT_V
#undef PG8_WAIT_L
#undef PG8_BAR
#undef PG8_SCHED
}
}

#define GAS __attribute__((address_space(1)))
#define LAS __attribute__((address_space(3)))
typedef unsigned v4u __attribute__((ext_vector_type(4)));
typedef GAS unsigned gu32;
typedef GAS unsigned long long gu64;
#define RLX_AGENT __ATOMIC_RELAXED, __HIP_MEMORY_SCOPE_AGENT
#define LDS_WAIT() asm volatile("s_waitcnt lgkmcnt(0)" ::: "memory")
#define VM_WAIT() asm volatile("s_waitcnt vmcnt(0)" ::: "memory")

#define XB_TMO      128
#define XB_XCNT(j)  (256  + 64 * (j))
#define XB_XSUB(j)  (1280 + 64 * (j))
#define XB_XGEN(j)  (2304 + 64 * (j))
#define XB_TOP      3328
#define XB_TOPGEN   3392
#define XCD_BAR_WORDS 3456
#define XB_SPIN_CAP (1u << 18)

__device__ __forceinline__ unsigned xb_ld(unsigned* p)              { return __hip_atomic_load(p, __ATOMIC_RELAXED, __HIP_MEMORY_SCOPE_AGENT); }
__device__ __forceinline__ unsigned xb_add(unsigned* p, unsigned v) { return __hip_atomic_fetch_add(p, v, __ATOMIC_RELAXED, __HIP_MEMORY_SCOPE_AGENT); }
__device__ __forceinline__ unsigned xb_xcc_id() { return (unsigned)__builtin_amdgcn_s_getreg((3 << 11) | 20) & 0xFu; }
#define XB_SPIN(cond, bar) do { unsigned _sp = 0; while (cond) { __builtin_amdgcn_s_sleep(1); \
    if ((++_sp & 255u) == 0u) { if (xb_ld(&(bar)[XB_TMO])) break; if (_sp > XB_SPIN_CAP) { atomicAdd(&(bar)[XB_TMO], 1u); break; } } } } while (0)

struct XcdBarrier {
    unsigned* bar; unsigned x;
    volatile LAS unsigned* st;
};

__device__ __forceinline__ XcdBarrier xcd_barrier_post(unsigned* bar, volatile LAS unsigned* st) {
    XcdBarrier b; b.bar = bar; b.x = xb_xcc_id(); b.st = st;
    if (threadIdx.x == 0) (void)xb_add(&bar[XB_XCNT(b.x)], 1u);
    return b;
}
__device__ __forceinline__ void xcd_barrier_complete(unsigned* bar, unsigned x, unsigned& nloc, unsigned& nx) {
    const unsigned G = gridDim.x * gridDim.y * gridDim.z;
    unsigned sum, cnt, mine, sp = 0u;
    for (;;) {
        sum = 0u; cnt = 0u; mine = 0u;
#pragma unroll
        for (unsigned j = 0; j < 16; ++j) { const unsigned c = xb_ld(&bar[XB_XCNT(j)]); sum += c; cnt += (c > 0u) ? 1u : 0u; mine = (j == x) ? c : mine; }
        if (sum == G) break;
        __builtin_amdgcn_s_sleep(1);
        if ((++sp & 255u) == 0u) { if (xb_ld(&bar[XB_TMO])) break; if (sp > XB_SPIN_CAP) { atomicAdd(&bar[XB_TMO], 1u); break; } }
    }
    nloc = mine > 0u ? mine : 1u; nx = cnt > 0u ? cnt : 1u;
}

__device__ __forceinline__ void xcd_barrier(const XcdBarrier& b) {
    asm volatile("s_waitcnt vmcnt(0)" ::: "memory");
    __syncthreads();
    if (threadIdx.x == 0) {
        unsigned* bar = b.bar;
        __builtin_amdgcn_s_waitcnt(0);
        unsigned nloc = b.st[0], nx = b.st[1];
        if (nloc == 0u) { xcd_barrier_complete(bar, b.x, nloc, nx); b.st[0] = nloc; b.st[1] = nx; }
        const unsigned old = xb_add(&bar[XB_XSUB(b.x)], 1u);
        const unsigned gen = old / nloc;
        if (old + 1u == (gen + 1u) * nloc) {
            __builtin_amdgcn_fence(__ATOMIC_RELEASE, "agent");
            asm volatile("s_waitcnt vmcnt(0)" ::: "memory");
            const unsigned og = xb_add(&bar[XB_TOP], 1u);
            const unsigned tg = og / nx;
            if (og + 1u == (tg + 1u) * nx) xb_add(&bar[XB_TOPGEN], 1u);
            else XB_SPIN(xb_ld(&bar[XB_TOPGEN]) == tg, bar);
            __builtin_amdgcn_fence(__ATOMIC_ACQUIRE, "agent");
            xb_add(&bar[XB_XGEN(b.x)], 1u);
            asm volatile("s_waitcnt vmcnt(0)" ::: "memory");
        } else {
            XB_SPIN(xb_ld(&bar[XB_XGEN(b.x)]) == gen, bar);
            __builtin_amdgcn_fence(__ATOMIC_ACQUIRE, "agent");
            asm volatile("s_waitcnt vmcnt(0)" ::: "memory");
        }
    }
    __syncthreads();
}

constexpr int NWAVES = 8;
constexpr int RING_OFF = 0, RING_BYTES = 131072;
constexpr int LDSCTL_OFF = RING_BYTES, MISC_OFF = LDSCTL_OFF + 320;
constexpr int LDS_BYTES = 147456;
constexpr int CW_BAR = 4096;
constexpr int PH_PROLOGUE = 0, PH_ROW0 = 1, PH_LAYER0 = 2, NPL = 15;
enum { S_UP1 = 0, S_DN1, S_ROWA, S_WIN, S_GLA, S_S5, S_ATTN, S_DFIN, S_GLU, S_BRANCH, S_WOUT, S_ROWB, S_UP2, S_DN2, S_ROWC };
constexpr int N_PHASES = PH_LAYER0 + DEPTH * NPL;

struct Args { const float* in[29]; float* out; unsigned char* ws; int ph_lo, ph_hi; };
struct Frame {
    LAS unsigned char* lds;
    int tid, lane, wave, vcu, G;
    const float* const* in; float* out; unsigned char* ws;
};

template <int MAP> __device__ __forceinline__ int conv_src(int n) {
    if (MAP == 0) return n;
    if (MAP == 1) { const int t = n >> 8, r = n & 255; return r < 128 ? 128 * t + r : DFF + 128 * t + (r - 128); }
    if (MAP == 2) return my2ref(n);
    { const int t = n >> 8, r = n & 255; return r < 128 ? 128 * t + r : 512 + 128 * t + (r - 128); }
}
template <int MAP> __device__ __forceinline__ void conv_item(const float* W, int K, int N, int Np, bf16_t* WT, LAS float* scr, int item, int lane) {
    const int nblk = Np / 32, kb = item / nblk, nb = item % nblk, k0 = 64 * kb, n0 = 32 * nb;
    const int src = conv_src<MAP>(n0 + (lane & 31));
#pragma unroll 8
    for (int i = 0; i < 32; ++i) { const int kk = 2 * i + (lane >> 5); scr[kk * 33 + (lane & 31)] = (src >= 0) ? W[(size_t)(k0 + kk) * N + src] : 0.f; }
    LDS_WAIT(); asm volatile("" ::: "memory");
    const int c = lane & 7;
#pragma unroll
    for (int j = 0; j < 4; ++j) { const int n = (lane >> 3) + 8 * j; const LAS float* s = scr + (8 * c) * 33 + n;
        v4u o; o.x = pk2(s[0 * 33], s[1 * 33]); o.y = pk2(s[2 * 33], s[3 * 33]); o.z = pk2(s[4 * 33], s[5 * 33]); o.w = pk2(s[6 * 33], s[7 * 33]);
        *(GAS v4u*)(WT + (size_t)(n0 + n) * K + k0 + 8 * c) = o; }
    LDS_WAIT(); asm volatile("" ::: "memory");
}
__device__ __forceinline__ void convert_layer(Frame& F, int l) {
    LAS float* scr = (LAS float*)(F.lds + RING_OFF + F.wave * 16384);
    const int gw = F.vcu * NWAVES + F.wave, NGW = F.G * NWAVES;
    bf16_t* wb = (bf16_t*)(F.ws + WS_W);
    constexpr int I_UP = (D / 64) * (2 * DFF / 32), I_DN = (DFF / 64) * (D / 32), I_IN = (D / 64) * (PW / 32), I_GLU = (512 / 64) * (1024 / 32), I_BR = I_GLU, I_OUT = (D / 64) * (D / 32);
    constexpr int NITEMS = 2 * I_UP + 2 * I_DN + I_IN + I_GLU + 3 * I_BR + I_OUT;
    const float* f1u = F.in[7] + (size_t)l * D * 2 * DFF; const float* f1d = F.in[8] + (size_t)l * DFF * D;
    const float* f2u = F.in[9] + (size_t)l * D * 2 * DFF; const float* f2d = F.in[10] + (size_t)l * DFF * D;
    const float* win = F.in[11] + (size_t)l * D * INW; const float* wglu = F.in[25] + (size_t)l * 512 * 1024;
    const float* wbr = F.in[27] + (size_t)l * 3 * 512 * D; const float* wout = F.in[28] + (size_t)l * D * D;
    for (int it = gw; it < NITEMS; it += NGW) {
        int r = it;
        if (r < I_UP) { conv_item<1>(f1u, D, 2 * DFF, 2 * DFF, wb + W_UP1, scr, r, F.lane); continue; } r -= I_UP;
        if (r < I_DN) { conv_item<0>(f1d, DFF, D, D, wb + W_DN1, scr, r, F.lane); continue; } r -= I_DN;
        if (r < I_UP) { conv_item<1>(f2u, D, 2 * DFF, 2 * DFF, wb + W_UP2, scr, r, F.lane); continue; } r -= I_UP;
        if (r < I_DN) { conv_item<0>(f2d, DFF, D, D, wb + W_DN2, scr, r, F.lane); continue; } r -= I_DN;
        if (r < I_IN) { conv_item<2>(win, D, INW, PW, wb + W_IN, scr, r, F.lane); continue; } r -= I_IN;
        if (r < I_GLU) { conv_item<3>(wglu, 512, 1024, 1024, wb + W_GLU, scr, r, F.lane); continue; } r -= I_GLU;
        if (r < 3 * I_BR) { const int i = r / I_BR; conv_item<0>(wbr + (size_t)i * 512 * D, 512, D, D, wb + W_BR + (size_t)i * 1024 * 512, scr, r % I_BR, F.lane); continue; } r -= 3 * I_BR;
        conv_item<0>(wout, D, D, D, wb + W_OUT, scr, r, F.lane);
    }
}
__device__ __forceinline__ void ada_phase(Frame& F) {
    if (F.vcu < 2 * 72) {
        const int l = F.vcu / 72, cb = F.vcu % 72;
        LAS float* cond = (LAS float*)(F.lds + RING_OFF);
        LAS float* red = (LAS float*)(F.lds + RING_OFF + 32768);
        const float* c = F.in[1];
        for (int i = F.tid; i < BATCH * D; i += NWAVES * 64) cond[i] = siluf_(c[i]);
        __syncthreads();
        float acc[BATCH][2];
#pragma unroll
        for (int b = 0; b < BATCH; ++b) { acc[b][0] = 0.f; acc[b][1] = 0.f; }
        const float* w = F.in[3] + ((size_t)l * D + F.wave * 128) * ADA + cb * 128 + 2 * F.lane;
#pragma unroll 4
        for (int k = 0; k < 128; ++k) { const float2 wv = *(const float2*)(w + (size_t)k * ADA);
#pragma unroll
            for (int b = 0; b < BATCH; ++b) { const float cv = cond[b * D + F.wave * 128 + k]; acc[b][0] += cv * wv.x; acc[b][1] += cv * wv.y; } }
#pragma unroll
        for (int b = 0; b < BATCH; ++b) { red[(F.wave * 8 + b) * 128 + 2 * F.lane] = acc[b][0]; red[(F.wave * 8 + b) * 128 + 2 * F.lane + 1] = acc[b][1]; }
        __syncthreads();
        float* ada = (float*)(F.ws + WS_ADA);
        for (int o = F.tid; o < BATCH * 128; o += NWAVES * 64) { const int b = o >> 7, cc = o & 127; float s = F.in[4][l * ADA + cb * 128 + cc];
#pragma unroll
            for (int w8 = 0; w8 < 8; ++w8) s += red[(w8 * 8 + b) * 128 + cc];
            ada[((size_t)l * BATCH + b) * ADA + cb * 128 + cc] = s; }
        __syncthreads();
    }
}
__device__ __forceinline__ void rowpass_phase(Frame& F, int l, int sub) {
    const int gw = F.vcu * NWAVES + F.wave, NGW = F.G * NWAVES;
    const float* ada = (const float*)(F.ws + WS_ADA); const float* adal = ada + (size_t)l * BATCH * ADA;
    const float* npre = F.in[5] + l * 3 * D; const float* npost = F.in[6] + l * 3 * D;
    bf16_t* u = (bf16_t*)(F.ws + WS_U); const bf16_t* y = (const bf16_t*)(F.ws + WS_Y);
    const float* h_in = F.out; const bf16_t* yy = y; const float* gpost = nullptr; const float* gate = nullptr; float coef = 0.f;
    const float* gpre = nullptr; const float* shift = nullptr; const float* scale = nullptr; bf16_t* uu = u;
    if (sub == 0) { h_in = F.in[0]; yy = nullptr; gpre = npre; shift = adal; scale = adal + D; }
    else if (sub == 1) { gpost = npost; gate = adal + 2 * D; coef = 0.5f; gpre = npre + D; shift = adal + 3 * D; scale = adal + 4 * D; }
    else if (sub == 2) { gpost = npost + D; gate = adal + 5 * D; coef = 1.0f; gpre = npre + 2 * D; shift = adal + 6 * D; scale = adal + 7 * D; }
    else { gpost = npost + 2 * D; gate = adal + 8 * D; coef = 0.5f;
        if (l + 1 < DEPTH) { gpre = F.in[5] + (l + 1) * 3 * D; shift = adal + (size_t)BATCH * ADA; scale = shift + D; } else uu = nullptr; }
    for (int row = gw; row < M; row += NGW) rowpass_row(row, F.lane, h_in, F.out, yy, gpost, gate, coef, gpre, shift, scale, uu);
}
__device__ __forceinline__ void dfin_phase(Frame& F, int l) {
    const int gw = F.vcu * NWAVES + F.wave, NGW = F.G * NWAVES;
    const float* lamv = F.in[15] + l * 256; const float lam_init = 0.8f - 0.6f * __expf(-0.3f * (float)l);
    const float lam = __expf(wave_sum(lamv[F.lane] * lamv[64 + F.lane])) - __expf(wave_sum(lamv[128 + F.lane] * lamv[192 + F.lane])) + lam_init;
    bf16_t* proj = (bf16_t*)(F.ws + WS_R0);
    for (int row = gw; row < M; row += NGW) diff_fin_row(proj + (size_t)row * PW, F.lane, lam, F.in[16] + l * 512, lam_init);
}


__device__ __forceinline__ void gla_naive_phase(Frame& F, int l) {
    if (F.vcu >= BATCH * 4) return;
    bf16_t* proj = (bf16_t*)(F.ws + WS_R0);
    const float* w_alpha = F.in[12] + l * 16 * 256; const float* b_alpha = F.in[13] + l * 256; const float* norm_g = F.in[14] + l * 512;
    const int b = F.vcu >> 2, h = F.vcu & 3, t = F.tid, lane = t & 63, e = t & 127, half = (t >> 7) & 1; const bool act = t < 256;
    LAS float* sa = (LAS float*)(F.lds + RING_OFF); LAS float* sq = sa + 64; LAS float* sk = sq + 64; LAS float* part = sk + 64; LAS float* red = part + 256;
    float S[32];
#pragma unroll
    for (int i = 0; i < 32; ++i) S[i] = 0.f;
    float wa[16]; float ba = 0.f;
#pragma unroll
    for (int j = 0; j < 16; ++j) wa[j] = 0.f;
    if (t < 64) { for (int j = 0; j < 16; ++j) wa[j] = w_alpha[j * 256 + h * 64 + t]; ba = b_alpha[h * 64 + t]; }
    const float ng = norm_g[h * 128 + e];
    for (int s = 0; s < SEQ; ++s) {
        bf16_t* row = proj + (size_t)(b * SEQ + s) * PW;
        if (t < 64) {
            float z = ba;
#pragma unroll
            for (int j = 0; j < 16; ++j) z += bf2f(row[C_GA + j]) * wa[j];
            const float ls = fminf(z, 0.f) - log1pf(__expf(-fabsf(z)));
            sa[t] = __expf(ls * (1.f / 16.f)); sq[t] = bf2f(row[C_GQ + h * 64 + t]); sk[t] = bf2f(row[C_GK + h * 64 + t]);
        }
        const float v = bf2f(row[C_GV + h * 128 + e]);
        const float rr = bf2f(row[C_GR + h * 128 + e]);
        __syncthreads();
        if (act) { float p = 0.f;
#pragma unroll
            for (int i = 0; i < 32; ++i) { const int d = half * 32 + i; S[i] = sa[d] * S[i] + sk[d] * v; p += sq[d] * S[i]; }
            part[half * 128 + e] = p; }
        __syncthreads();
        float o = 0.f;
        if (t < 128) { o = part[e] + part[128 + e]; const float ss = wave_sum(o * o); if (lane == 0) red[t >> 6] = ss; }
        __syncthreads();
        if (t < 128) { const float r = rsqrtf((red[0] + red[1]) * (1.f / 128.f) + EPS); row[C_YGLA + h * 128 + e] = f2bf(o * r * ng * siluf_(rr)); }
        __syncthreads();
    }
}
__device__ __forceinline__ void s5_naive_phase(Frame& F, int l) {
    if (F.wave != 0) return;
    const float* lam_re = F.in[17] + l * 2048; const float* lam_im = F.in[18] + l * 2048; const float* log_step = F.in[19] + l * 32;
    const float* b_re = F.in[20] + l * 32768; const float* b_im = F.in[21] + l * 32768; const float* c_re = F.in[22] + l * 32768; const float* c_im = F.in[23] + l * 32768; const float* d_skip = F.in[24] + l * 512;
    bf16_t* proj = (bf16_t*)(F.ws + WS_R0);
    for (int item = F.vcu; item < BATCH * 32; item += F.G) {
        const int b = item >> 5, g = item & 31, p = F.lane;
        const float lr = lam_re[g * 64 + p], li = lam_im[g * 64 + p], dt = expf(log_step[g]);
        const float mag = expf(lr * dt), ar = mag * cosf(li * dt), ai = mag * sinf(li * dt);
        const float nr = ar - 1.f, ni = ai, den = lr * lr + li * li, fre = (nr * lr + ni * li) / den, fim = (ni * lr - nr * li) / den;
        float bbr[16], bbi[16], cr[16], ci[16];
#pragma unroll
        for (int h = 0; h < 16; ++h) { const float br = b_re[(g * 64 + p) * 16 + h], bi = b_im[(g * 64 + p) * 16 + h]; bbr[h] = fre * br - fim * bi; bbi[h] = fre * bi + fim * br;
            cr[h] = c_re[(g * 16 + h) * 64 + p]; ci[h] = c_im[(g * 16 + h) * 64 + p]; }
        const float dsk = (p < 16) ? d_skip[g * 16 + p] : 0.f;
        float xr = 0.f, xi = 0.f;
        for (int s = 0; s < SEQ; ++s) {
            bf16_t* row = proj + (size_t)(b * SEQ + s) * PW + C_SU + g * 16;
            float u[16];
#pragma unroll
            for (int h = 0; h < 16; ++h) u[h] = bf2f(row[h]);
            float bur = 0.f, bui = 0.f;
#pragma unroll
            for (int h = 0; h < 16; ++h) { bur += bbr[h] * u[h]; bui += bbi[h] * u[h]; }
            const float nxr = ar * xr - ai * xi + bur, nxi = ar * xi + ai * xr + bui; xr = nxr; xi = nxi;
            float yn = 0.f;
#pragma unroll
            for (int n = 0; n < 16; ++n) { const float v = wave_sum(cr[n] * xr - ci[n] * xi); if (p == n) yn = v + dsk * u[n]; }
            if (p < 16) { const float x3 = yn * yn * yn; const float gl = 0.5f * yn * (1.f + tanhf(0.7978845608028654f * (yn + 0.044715f * x3))); row[p] = f2bf(gl); }
        }
    }
}
__device__ __forceinline__ void attn_naive_phase(Frame& F) {
    bf16_t* proj = (bf16_t*)(F.ws + WS_R0); const float* rel_bias = F.in[2];
    LAS float* sc = (LAS float*)(F.lds + RING_OFF + F.wave * 16384);
    LAS float* sq = sc + SEQ;
    const int gw0 = F.vcu * NWAVES + F.wave, NGW = F.G * NWAVES, lane = F.lane;
    for (int gw = gw0; gw < BATCH * 8 * SEQ; gw += NGW) {
        const int q = gw % SEQ, m = (gw / SEQ) % 8, b = gw / (SEQ * 8);
        const bf16_t* base = proj + (size_t)b * SEQ * PW;
        sq[lane] = bf2f(base[(size_t)q * PW + C_DQ + m * 64 + lane]);
        LDS_WAIT();
        float mx = -INFINITY;
        for (int s0 = 0; s0 <= q; s0 += 64) {
            const int s = s0 + lane; float v = -INFINITY;
            if (s <= q) { const bf16_t* kr = base + (size_t)s * PW + C_DK + m * 64; float a = 0.f;
                for (int d = 0; d < 64; ++d) a += sq[d] * bf2f(kr[d]);
                const int dist = q - s; const int bk = T5B[dist < 127 ? dist : 127]; v = a + rel_bias[bk * 8 + m] * LOG2E; }
            sc[s] = v; mx = fmaxf(mx, v);
        }
        mx = wave_max(mx);
        float sum = 0.f;
        for (int s0 = 0; s0 <= q; s0 += 64) { const int s = s0 + lane; if (s <= q) { const float pz = exp2f(sc[s] - mx); sc[s] = pz; sum += pz; } }
        sum = wave_sum(sum);
        LDS_WAIT();
        const int hh = m >> 1; float o0 = 0.f, o1 = 0.f;
        for (int s = 0; s <= q; ++s) { const float pz = sc[s]; const unsigned vv = *(const unsigned*)(base + (size_t)s * PW + C_DV + hh * 128 + lane * 2); o0 += pz * blo(vv); o1 += pz * bhi(vv); }
        LDS_WAIT();
        const float inv = 1.f / sum;
        *(unsigned*)(proj + (size_t)(b * SEQ + q) * PW + C_O + m * 128 + lane * 2) = pk2(o0 * inv, o1 * inv);
    }
}

__device__ __forceinline__ void run_phase(Frame& F, int ph) {
    bf16_t* wb = (bf16_t*)(F.ws + WS_W); bf16_t* u = (bf16_t*)(F.ws + WS_U); bf16_t* y = (bf16_t*)(F.ws + WS_Y);
    bf16_t* hid = (bf16_t*)(F.ws + WS_R0); bf16_t* proj = (bf16_t*)(F.ws + WS_R0);
    if (ph == PH_PROLOGUE) { ada_phase(F); convert_layer(F, 0); return; }
    if (ph == PH_ROW0) { rowpass_phase(F, 0, 0); return; }
    const int l = (ph - PH_LAYER0) / NPL, s = (ph - PH_LAYER0) % NPL;
    const int cid = (int)blockIdx.x;
    switch (s) {
    case S_UP1: case S_UP2: {
        typedef pg8::GemmT<D, D, D, 0, 0> GT; GT g{u, wb + (s == S_UP1 ? W_UP1 : W_UP2)}; pg8::StaticOrder S; S.init(M, 2 * DFF, F.G, cid);
        pg8::EpiSwiGLU E{hid}; pg8::gemm_phase<pg8::EpiSwiGLU, pg8::StaticOrder, GT, true, true>(F.lds + RING_OFF, g, S, E); break; }
    case S_DN1: case S_DN2: {
        typedef pg8::GemmT<DFF, DFF, DFF, 0, 0> GT; GT g{hid, wb + (s == S_DN1 ? W_DN1 : W_DN2)}; pg8::StaticOrder S; S.init(M, D, F.G, cid);
        typedef pg8::EpiStore<D, 0> ET; ET E{y}; pg8::gemm_phase<ET, pg8::StaticOrder, GT, true, true>(F.lds + RING_OFF, g, S, E); break; }
    case S_ROWA: rowpass_phase(F, l, 1); break;
    case S_WIN: {
        typedef pg8::GemmT<D, D, D, 0, 0> GT; GT g{u, wb + W_IN}; pg8::StaticOrder S; S.init(M, PW, F.G, cid);
        typedef pg8::EpiStore<PW, 1> ET; ET E{proj}; pg8::gemm_phase<ET, pg8::StaticOrder, GT, true, true>(F.lds + RING_OFF, g, S, E); break; }
    case S_DFIN: dfin_phase(F, l); break;
    case S_GLU: {
        typedef pg8::GemmT<PW, 512, 512, 0, 0> GT; GT g{proj + C_YS5PRE, wb + W_GLU}; pg8::StaticOrder S; S.init(M, 1024, F.G, cid);
        pg8::EpiGLU E{proj, F.in[26] + l * 1024}; pg8::gemm_phase<pg8::EpiGLU, pg8::StaticOrder, GT, true, true>(F.lds + RING_OFF, g, S, E); break; }
    case S_BRANCH: {
        typedef pg8::GemmT<PW, 512, 512, 512 * 2, 1024 * 512 * 2> GT; GT g{proj + C_YGLA, wb + W_BR}; pg8::StaticOrder S; S.init(M, D, F.G, cid, 3);
        pg8::EpiBranch E{proj}; pg8::gemm_phase<pg8::EpiBranch, pg8::StaticOrder, GT, true, true>(F.lds + RING_OFF, g, S, E); break; }
    case S_WOUT: {
        typedef pg8::GemmT<PW, D, D, 0, 0> GT; GT g{proj + C_MERGED, wb + W_OUT}; pg8::StaticOrder S; S.init(M, D, F.G, cid);
        typedef pg8::EpiStore<D, 0> ET; ET E{y}; pg8::gemm_phase<ET, pg8::StaticOrder, GT, true, true>(F.lds + RING_OFF, g, S, E); break; }
    case S_ROWB: rowpass_phase(F, l, 2); break;
    case S_ROWC: rowpass_phase(F, l, 3); if (l + 1 < DEPTH) convert_layer(F, l + 1); break;
    case S_GLA: gla_naive_phase(F, l); break;
    case S_S5: s5_naive_phase(F, l); break;
    case S_ATTN: attn_naive_phase(F); break;
    default: break;
    }
}

__global__ void __launch_bounds__(NWAVES * 64, 2) mk_fwd(Args args) {
    extern __shared__ __attribute__((aligned(16))) unsigned char lds[];
    Frame F;
    F.lds = (LAS unsigned char*)lds;
    F.tid = threadIdx.x; F.lane = F.tid & 63; F.wave = __builtin_amdgcn_readfirstlane(F.tid >> 6);
    F.G = gridDim.x; { const int bx = blockIdx.x; F.vcu = (F.G % 8 == 0) ? (bx % 8) * (F.G / 8) + bx / 8 : bx; }
    F.in = args.in; F.out = args.out; F.ws = args.ws;
    for (int u = F.tid; u < (LDS_BYTES - LDSCTL_OFF) / 4; u += NWAVES * 64) ((LAS unsigned*)(F.lds + LDSCTL_OFF))[u] = 0u;
    __syncthreads();
    XcdBarrier bar; bar.bar = (unsigned*)(args.ws + WS_CTL) + CW_BAR; bar.x = 0; bar.st = nullptr;
    const bool multi = (args.ph_hi - args.ph_lo) > 1;
    if (multi) bar = xcd_barrier_post((unsigned*)(args.ws + WS_CTL) + CW_BAR, (volatile LAS unsigned*)(F.lds + MISC_OFF) + 8);
    for (int ph = args.ph_lo; ph < args.ph_hi; ++ph) {
        int t_ = threadIdx.x; asm volatile("" : "+v"(t_));
        F.tid = t_; F.lane = t_ & 63; F.wave = __builtin_amdgcn_readfirstlane(t_ >> 6);
        run_phase(F, ph);
        if (ph + 1 < args.ph_hi) xcd_barrier(bar);
    }
}

extern "C" void kernel_launch(void* const* d_in, const int* in_sizes, int n_in, void* d_out, int out_size, void* d_ws, size_t ws_size, hipStream_t stream) {
    static int grid = 0;
    if (grid == 0) {
        if (n_in != 29 || in_sizes[0] != M * D || out_size != M * D || ws_size < WS_END) {
            fprintf(stderr, "kernel_launch: unexpected shapes/workspace: n_in %d in0 %d out %d ws %zu (need %zu)\n", n_in, n_in > 0 ? in_sizes[0] : -1, out_size, ws_size, (size_t)WS_END); grid = -1; return; }
        int dev = 0, cus = 0;
        if (hipGetDevice(&dev) != hipSuccess || hipDeviceGetAttribute(&cus, hipDeviceAttributeMultiprocessorCount, dev) != hipSuccess) { grid = -1; return; }
        if (hipFuncSetAttribute((const void*)mk_fwd, hipFuncAttributeMaxDynamicSharedMemorySize, LDS_BYTES) != hipSuccess) { fprintf(stderr, "kernel_launch: hipFuncSetAttribute failed\n"); grid = -1; return; }
        grid = cus;
    }
    if (grid < 0) return;
    Args a{};
    for (int i = 0; i < 29; ++i) a.in[i] = (const float*)d_in[i];
    a.out = (float*)d_out; a.ws = (unsigned char*)d_ws;
    if (hipMemsetAsync((char*)d_ws + WS_CTL, 0, CTL_ZERO_BYTES, stream) != hipSuccess) { fprintf(stderr, "kernel_launch: memset failed\n"); return; }
    a.ph_lo = 0; a.ph_hi = N_PHASES;
    hipLaunchKernelGGL(mk_fwd, dim3(grid), dim3(NWAVES * 64), LDS_BYTES, stream, a);
}
```

```cpp
#include <hip/hip_runtime.h>
#include <cstdio>
#include <cstdint>
#include <cmath>

constexpr int D = 1024, BATCH = 8, SEQ = 2048, DEPTH = 2, M = BATCH * SEQ;
constexpr int DFF = 2816, INW = 6672, PW = 6912;
constexpr int ADA = 9 * D;
constexpr float EPS = 1e-6f;
constexpr float LOG2E = 1.4426950408889634f;
constexpr float QSCALE = 0.125f * LOG2E;
constexpr int C_GV = 0, C_DQ = 512, C_DK = 1024, C_DV = 1536, C_GQ = 2048, C_GK = 2304, C_GR = 2560, C_SU = 3072, C_GATE = 3584, C_GA = 6656;
constexpr int C_O = C_GQ;
constexpr int C_YGLA = C_GV, C_YDIFF = C_DQ, C_YS5 = C_DK, C_YS5PRE = C_SU, C_MERGED = C_GQ;

typedef unsigned short bf16_t;
typedef short bf16x8 __attribute__((ext_vector_type(8)));
typedef float f32x4 __attribute__((ext_vector_type(4)));
typedef unsigned u32x4 __attribute__((ext_vector_type(4)));
__device__ __forceinline__ float bf2f(bf16_t v) { return __uint_as_float(((unsigned)v) << 16); }
__device__ __forceinline__ bf16_t f2bf(float f) { unsigned u = __float_as_uint(f); return (bf16_t)((u + 0x7fffu + ((u >> 16) & 1u)) >> 16); }
__device__ __forceinline__ unsigned pk2(float lo, float hi) { return (unsigned)f2bf(lo) | ((unsigned)f2bf(hi) << 16); }
__device__ __forceinline__ float blo(unsigned w) { return __uint_as_float(w << 16); }
__device__ __forceinline__ float bhi(unsigned w) { return __uint_as_float(w & 0xffff0000u); }
__device__ __forceinline__ float sigmoidf_(float x) { return 1.f / (1.f + __expf(-x)); }
__device__ __forceinline__ float siluf_(float x) { return x / (1.f + __expf(-x)); }
__device__ __forceinline__ float wave_sum(float v) {
#pragma unroll
    for (int o = 1; o < 64; o <<= 1) v += __shfl_xor(v, o);
    return v;
}
__device__ __forceinline__ float wave_max(float v) {
#pragma unroll
    for (int o = 1; o < 64; o <<= 1) v = fmaxf(v, __shfl_xor(v, o));
    return v;
}
__device__ __forceinline__ int ref2my(int c) {
    if (c < 256) return C_GQ + c;
    if (c < 512) return C_GK + (c - 256);
    if (c < 1024) return C_GV + (c - 512);
    if (c < 1536) return C_GR + (c - 1024);
    if (c < 1552) return C_GA + (c - 1536);
    if (c < 2064) return C_DQ + (c - 1552);
    if (c < 2576) return C_DK + (c - 2064);
    if (c < 3088) return C_DV + (c - 2576);
    if (c < 3600) return C_SU + (c - 3088);
    return C_GATE + (c - 3600);
}
__device__ __forceinline__ int my2ref(int c) {
    if (c < C_DQ) return 512 + c;
    if (c < C_DK) return 1552 + (c - C_DQ);
    if (c < C_DV) return 2064 + (c - C_DK);
    if (c < C_GQ) return 2576 + (c - C_DV);
    if (c < C_GK) return c - C_GQ;
    if (c < C_GR) return 256 + (c - C_GK);
    if (c < C_SU) return 1024 + (c - C_GR);
    if (c < C_GATE) return 3088 + (c - C_SU);
    if (c < C_GA) return 3600 + (c - C_GATE);
    if (c < C_GA + 16) return 1536 + (c - C_GA);
    return -1;
}
__device__ const unsigned char T5B[128] = {0, 1, 2, 3, 4, 5, 6, 7, 8, 9, 10, 11, 12, 13, 14, 15, 16, 16, 16, 17, 17, 18, 18, 18, 19, 19, 19, 20, 20, 20, 20, 21, 21, 21, 21, 22, 22, 22, 22, 22, 23, 23, 23, 23, 23, 23, 24, 24, 24, 24, 24, 24, 25, 25, 25, 25, 25, 25, 25, 26, 26, 26, 26, 26, 26, 26, 26, 27, 27, 27, 27, 27, 27, 27, 27, 27, 27, 28, 28, 28, 28, 28, 28, 28, 28, 28, 28, 29, 29, 29, 29, 29, 29, 29, 29, 29, 29, 29, 29, 30, 30, 30, 30, 30, 30, 30, 30, 30, 30, 30, 30, 30, 30, 31, 31, 31, 31, 31, 31, 31, 31, 31, 31, 31, 31, 31, 31, 31};

constexpr size_t MiB = 1u << 20;
constexpr size_t WS_CTL = 0, CTL_ZERO_BYTES = 1 * MiB, WS_ADA = 1 * MiB, WS_S5ST = 2 * MiB, WS_W = 6 * MiB, WS_U = 59 * MiB, WS_GLA = 91 * MiB, WS_R0 = 123 * MiB, WS_END = 339 * MiB;
constexpr size_t WS_Y = WS_GLA;
constexpr size_t W_UP1 = 0, W_DN1 = W_UP1 + (size_t)2 * DFF * D, W_UP2 = W_DN1 + (size_t)D * DFF, W_DN2 = W_UP2 + (size_t)2 * DFF * D, W_IN = W_DN2 + (size_t)D * DFF,
                 W_GLU = W_IN + (size_t)PW * D, W_BR = W_GLU + (size_t)1024 * 512, W_OUT = W_BR + (size_t)3 * 1024 * 512, W_END = W_OUT + (size_t)D * D;
static_assert(W_END * 2 <= 53 * MiB, "weights fit");

__device__ __forceinline__ void rowpass_row(int row, int lane, const float* h_in, float* h_out, const bf16_t* y, const float* gpost, const float* gate, float coef,
                                            const float* gpre, const float* shift, const float* scale, bf16_t* u) {
    const int b = row / SEQ;
    f32x4 hv[4];
#pragma unroll
    for (int j = 0; j < 4; ++j) hv[j] = *(const f32x4*)(h_in + (size_t)row * D + j * 256 + lane * 4);
    if (y) {
        float yv[4][4]; float ss = 0.f;
#pragma unroll
        for (int j = 0; j < 4; ++j) {
            const uint2 raw = *(const uint2*)(y + (size_t)row * D + j * 256 + lane * 4);
            yv[j][0] = blo(raw.x); yv[j][1] = bhi(raw.x); yv[j][2] = blo(raw.y); yv[j][3] = bhi(raw.y);
#pragma unroll
            for (int i = 0; i < 4; ++i) ss += yv[j][i] * yv[j][i];
        }
        const float r = rsqrtf(wave_sum(ss) * (1.f / D) + EPS);
#pragma unroll
        for (int j = 0; j < 4; ++j) {
            const int c0 = j * 256 + lane * 4;
            const f32x4 gp = *(const f32x4*)(gpost + c0), gt = *(const f32x4*)(gate + (size_t)b * ADA + c0);
#pragma unroll
            for (int i = 0; i < 4; ++i) hv[j][i] += coef * gt[i] * (yv[j][i] * r * gp[i]);
        }
    }
    if (y || h_in != h_out) {
#pragma unroll
        for (int j = 0; j < 4; ++j) *(f32x4*)(h_out + (size_t)row * D + j * 256 + lane * 4) = hv[j];
    }
    if (u) {
        float ss = 0.f;
#pragma unroll
        for (int j = 0; j < 4; ++j)
#pragma unroll
            for (int i = 0; i < 4; ++i) ss += hv[j][i] * hv[j][i];
        const float r = rsqrtf(wave_sum(ss) * (1.f / D) + EPS);
#pragma unroll
        for (int j = 0; j < 4; ++j) {
            const int c0 = j * 256 + lane * 4;
            const f32x4 g = *(const f32x4*)(gpre + c0), sh = *(const f32x4*)(shift + (size_t)b * ADA + c0), sc = *(const f32x4*)(scale + (size_t)b * ADA + c0);
            float o[4];
#pragma unroll
            for (int i = 0; i < 4; ++i) o[i] = hv[j][i] * r * g[i] * (1.f + sc[i]) + sh[i];
            uint2 w; w.x = pk2(o[0], o[1]); w.y = pk2(o[2], o[3]);
            *(uint2*)(u + (size_t)row * D + c0) = w;
        }
    }
}

__global__ __launch_bounds__(256) void k_gla_naive(bf16_t* proj, const float* w_alpha, const float* b_alpha, const float* norm_g) {
    const int b = blockIdx.x >> 2, h = blockIdx.x & 3, t = threadIdx.x, lane = t & 63, e = t & 127, half = t >> 7;
    __shared__ float sa[64], sq[64], sk[64], part[2][128], red[2];
    float S[32];
#pragma unroll
    for (int i = 0; i < 32; ++i) S[i] = 0.f;
    float wa[16]; float ba = 0.f;
#pragma unroll
    for (int j = 0; j < 16; ++j) wa[j] = 0.f;
    if (t < 64) { for (int j = 0; j < 16; ++j) wa[j] = w_alpha[j * 256 + h * 64 + t]; ba = b_alpha[h * 64 + t]; }
    const float ng = norm_g[h * 128 + e];
    for (int s = 0; s < SEQ; ++s) {
        bf16_t* row = proj + (size_t)(b * SEQ + s) * PW;
        if (t < 64) {
            float z = ba;
#pragma unroll
            for (int j = 0; j < 16; ++j) z += bf2f(row[C_GA + j]) * wa[j];
            const float ls = fminf(z, 0.f) - log1pf(__expf(-fabsf(z)));
            sa[t] = __expf(ls * (1.f / 16.f)); sq[t] = bf2f(row[C_GQ + h * 64 + t]); sk[t] = bf2f(row[C_GK + h * 64 + t]);
        }
        const float v = bf2f(row[C_GV + h * 128 + e]);
        const float rr = bf2f(row[C_GR + h * 128 + e]);
        __syncthreads();
        float p = 0.f;
#pragma unroll
        for (int i = 0; i < 32; ++i) { const int d = half * 32 + i; S[i] = sa[d] * S[i] + sk[d] * v; p += sq[d] * S[i]; }
        part[half][e] = p;
        __syncthreads();
        float o = 0.f;
        if (t < 128) { o = part[0][e] + part[1][e]; const float ss = wave_sum(o * o); if (lane == 0) red[t >> 6] = ss; }
        __syncthreads();
        if (t < 128) { const float r = rsqrtf((red[0] + red[1]) * (1.f / 128.f) + EPS); row[C_YGLA + h * 128 + e] = f2bf(o * r * ng * siluf_(rr)); }
        __syncthreads();
    }
}

__global__ __launch_bounds__(64) void k_s5_naive(bf16_t* proj, const float* lam_re, const float* lam_im, const float* log_step, const float* b_re, const float* b_im,
                                                 const float* c_re, const float* c_im, const float* d_skip) {
    const int b = blockIdx.x >> 5, g = blockIdx.x & 31, p = threadIdx.x;
    const float lr = lam_re[g * 64 + p], li = lam_im[g * 64 + p], dt = expf(log_step[g]);
    const float mag = expf(lr * dt), ar = mag * cosf(li * dt), ai = mag * sinf(li * dt);
    const float nr = ar - 1.f, ni = ai, den = lr * lr + li * li, fre = (nr * lr + ni * li) / den, fim = (ni * lr - nr * li) / den;
    float bbr[16], bbi[16], cr[16], ci[16];
#pragma unroll
    for (int h = 0; h < 16; ++h) { const float br = b_re[(g * 64 + p) * 16 + h], bi = b_im[(g * 64 + p) * 16 + h]; bbr[h] = fre * br - fim * bi; bbi[h] = fre * bi + fim * br;
        cr[h] = c_re[(g * 16 + h) * 64 + p]; ci[h] = c_im[(g * 16 + h) * 64 + p]; }
    const float dsk = (p < 16) ? d_skip[g * 16 + p] : 0.f;
    float xr = 0.f, xi = 0.f;
    for (int s = 0; s < SEQ; ++s) {
        bf16_t* row = proj + (size_t)(b * SEQ + s) * PW + C_SU + g * 16;
        float u[16];
#pragma unroll
        for (int h = 0; h < 16; ++h) u[h] = bf2f(row[h]);
        float bur = 0.f, bui = 0.f;
#pragma unroll
        for (int h = 0; h < 16; ++h) { bur += bbr[h] * u[h]; bui += bbi[h] * u[h]; }
        const float nxr = ar * xr - ai * xi + bur, nxi = ar * xi + ai * xr + bui; xr = nxr; xi = nxi;
        float yn = 0.f;
#pragma unroll
        for (int n = 0; n < 16; ++n) { const float v = wave_sum(cr[n] * xr - ci[n] * xi); if (p == n) yn = v + dsk * u[n]; }
        if (p < 16) { const float x3 = yn * yn * yn; const float gl = 0.5f * yn * (1.f + tanhf(0.7978845608028654f * (yn + 0.044715f * x3))); row[p] = f2bf(gl); }
    }
}

__global__ __launch_bounds__(256) void k_attn_naive(bf16_t* proj, const float* rel_bias) {
    __shared__ float sc[4][SEQ];
    __shared__ float sq[4][64];
    const int w = threadIdx.x >> 6, lane = threadIdx.x & 63;
    const int gw = blockIdx.x * 4 + w;
    const int q = gw % SEQ, m = (gw / SEQ) % 8, b = gw / (SEQ * 8);
    const bf16_t* base = proj + (size_t)b * SEQ * PW;
    sq[w][lane] = bf2f(base[(size_t)q * PW + C_DQ + m * 64 + lane]);
    __syncthreads();
    float mx = -INFINITY;
    for (int s0 = 0; s0 <= q; s0 += 64) {
        const int s = s0 + lane;
        float v = -INFINITY;
        if (s <= q) {
            const bf16_t* kr = base + (size_t)s * PW + C_DK + m * 64; float a = 0.f;
            for (int d = 0; d < 64; ++d) a += sq[w][d] * bf2f(kr[d]);
            const int dist = q - s; const int bk = T5B[dist < 127 ? dist : 127];
            v = a + rel_bias[bk * 8 + m] * LOG2E;
        }
        sc[w][s] = v; mx = fmaxf(mx, v);
    }
    mx = wave_max(mx);
    float sum = 0.f;
    for (int s0 = 0; s0 <= q; s0 += 64) { const int s = s0 + lane; if (s <= q) { const float pz = exp2f(sc[w][s] - mx); sc[w][s] = pz; sum += pz; } }
    sum = wave_sum(sum);
    __syncthreads();
    const int hh = m >> 1; float o0 = 0.f, o1 = 0.f;
    for (int s = 0; s <= q; ++s) { const float pz = sc[w][s]; const unsigned vv = *(const unsigned*)(base + (size_t)s * PW + C_DV + hh * 128 + lane * 2);
        o0 += pz * blo(vv); o1 += pz * bhi(vv); }
    __syncthreads();
    const float inv = 1.f / sum;
    bf16_t* orow = proj + (size_t)(b * SEQ + q) * PW + C_O + m * 128 + lane * 2;
    *(unsigned*)orow = pk2(o0 * inv, o1 * inv);
}

__device__ __forceinline__ void diff_fin_row(bf16_t* r, int lane, float lam, const float* norm_g, float lam_init) {
#pragma unroll
    for (int h = 0; h < 4; ++h) {
        const unsigned a = *(const unsigned*)(r + C_O + (2 * h) * 128 + lane * 2), c = *(const unsigned*)(r + C_O + (2 * h + 1) * 128 + lane * 2);
        const float o0 = blo(a) - lam * blo(c), o1 = bhi(a) - lam * bhi(c);
        const float rs = rsqrtf(wave_sum(o0 * o0 + o1 * o1) * (1.f / 128.f) + EPS) * (1.f - lam_init);
        const float g0 = norm_g[h * 128 + lane * 2], g1 = norm_g[h * 128 + lane * 2 + 1];
        *(unsigned*)(r + C_YDIFF + h * 128 + lane * 2) = pk2(o0 * rs * g0, o1 * rs * g1);
    }
}
__global__ __launch_bounds__(256) void k_diff_fin(bf16_t* proj, const float* lamv, const float* norm_g, float lam_init) {
    const int lane = threadIdx.x & 63, row = blockIdx.x * 4 + (threadIdx.x >> 6);
    const float lam = __expf(wave_sum(lamv[lane] * lamv[64 + lane])) - __expf(wave_sum(lamv[128 + lane] * lamv[192 + lane])) + lam_init;
    diff_fin_row(proj + (size_t)row * PW, lane, lam, norm_g, lam_init);
}

namespace pg8 {
#define PG8_LAS __attribute__((address_space(3)))
constexpr int BM = 256, BK = 64, HALF = 128, HTB = HALF * BK * 2  , STAGE_BYTES = 8 * HTB, NXCD = 8, WGM = 8;

__host__ __device__ __forceinline__ int lds_byte(int r, int c) { const int st = (r >> 4) * 2 + (c >> 5), rr = r & 15, cc = c & 31, ob = rr * 64 + cc * 2; return st * 1024 + (ob ^ (((ob >> 9) & 1) << 5)); }
__host__ __device__ __forceinline__ void stage_rc(int b, int& R, int& C) { const int st = b / 1024, sb = b % 1024, swz = sb ^ (((sb >> 9) & 1) << 5); R = (st >> 1) * 16 + swz / 64; C = (st & 1) * 32 + (swz % 64) / 2; }
__host__ __device__ __forceinline__ int perm32(int rho) { const int n = rho >> 4, i = rho & 15; return 8 * (i >> 2) + 4 * n + (i & 3); }

struct Unit { int pm, pn, z; };
template <int LDA, int LDB, int KK, int ZA, int ZB> struct GemmT { const bf16_t* A; const bf16_t* Bt; static constexpr int lda = LDA, ldb = LDB, K = KK; static constexpr size_t zA = ZA, zB = ZB; };

struct StaticOrder {
    int nM, nN, nwg, G, c, nZ;
    __host__ __device__ void init(int M_, int N_, int G_, int c_, int nZ_ = 1) { nM = M_ / BM; nN = N_ / BM; nwg = nM * nN; G = G_; c = c_; nZ = nZ_; }
    __host__ __device__ bool next(int i, Unit& u) const {
        const long L = (long)(i / nZ) * G + c; if (L >= nwg) return false;
        int wgid = (int)L; { const int q = nwg / NXCD, r = nwg % NXCD, xcd = wgid % NXCD, off = wgid / NXCD; wgid = (xcd < r ? xcd * (q + 1) : r * (q + 1) + (xcd - r) * q) + off; }
        const int nig = WGM * nN, gid = wgid / nig, fm = gid * WGM, gsz = (nM - fm) < WGM ? (nM - fm) : WGM;
        u.pm = fm + ((wgid % nig) % gsz); u.pn = (wgid % nig) / gsz; u.z = i % nZ; return true;
    }
    __device__ __forceinline__ void a_ready(const Unit&) const {}
    __device__ __forceinline__ void done(const Unit&) const {}
};
__device__ __forceinline__ unsigned cvt_pk_bf16(float lo, float hi) { unsigned r; asm volatile("v_cvt_pk_bf16_f32 %0, %1, %2" : "=v"(r) : "v"(lo), "v"(hi)); return r; }

__device__ __forceinline__ u32x4 pack8(const f32x4 v0, const f32x4 v1) { u32x4 w; w.x = cvt_pk_bf16(v0[0], v0[1]); w.y = cvt_pk_bf16(v0[2], v0[3]); w.z = cvt_pk_bf16(v1[0], v1[1]); w.w = cvt_pk_bf16(v1[2], v1[3]); return w; }
__device__ __forceinline__ float fsig(float x) { return __builtin_amdgcn_rcpf(1.f + __expf(-x)); }
template <int ldc, int mode> struct EpiStore {
    static constexpr bool PERM = true, AFTER_DRAIN = false;
    bf16_t* O;
    __device__ __forceinline__ void operator()(const f32x4 (&acc)[2][2][4][2], const Unit& u, int wr, int wc, int fr, int fq) const {
        float sc = 1.f; if (mode == 1) { if (u.pn == 2 || u.pn == 3) sc = QSCALE; else if (u.pn == 8) sc = 0.125f; }
        const int row0 = u.pm * BM + wr * 64 + fr, col0 = u.pn * BM + wc * 32 + 8 * fq;
#pragma unroll
        for (int ai = 0; ai < 2; ++ai)
#pragma unroll
            for (int m = 0; m < 4; ++m) { bf16_t* rowp = O + (size_t)(row0 + ai * HALF + m * 16) * ldc + col0;
#pragma unroll
                for (int bj = 0; bj < 2; ++bj) *(u32x4*)(rowp + bj * HALF) = pack8(acc[ai][bj][m][0] * sc, acc[ai][bj][m][1] * sc); }
    }
};
struct EpiSwiGLU {
    static constexpr bool PERM = true, AFTER_DRAIN = false;
    bf16_t* H;
    __device__ __forceinline__ void operator()(const f32x4 (&acc)[2][2][4][2], const Unit& u, int wr, int wc, int fr, int fq) const {
        const int row0 = u.pm * BM + wr * 64 + fr, col0 = u.pn * HALF + wc * 32 + 8 * fq;
#pragma unroll
        for (int ai = 0; ai < 2; ++ai)
#pragma unroll
            for (int m = 0; m < 4; ++m) { f32x4 o[2];
#pragma unroll
                for (int n = 0; n < 2; ++n)
#pragma unroll
                    for (int j = 0; j < 4; ++j) { const float g = acc[ai][0][m][n][j]; o[n][j] = g * fsig(g) * acc[ai][1][m][n][j]; }
                *(u32x4*)(H + (size_t)(row0 + ai * HALF + m * 16) * DFF + col0) = pack8(o[0], o[1]); }
    }
};
struct EpiGLU {
    static constexpr bool PERM = true, AFTER_DRAIN = false;
    bf16_t* P; const float* bias;
    __device__ __forceinline__ void operator()(const f32x4 (&acc)[2][2][4][2], const Unit& u, int wr, int wc, int fr, int fq) const {
        const int row0 = u.pm * BM + wr * 64 + fr, col0 = u.pn * HALF + wc * 32 + 8 * fq;
        f32x4 bv[2], bg[2];
#pragma unroll
        for (int n = 0; n < 2; ++n) { bv[n] = *(const f32x4*)(bias + col0 + 4 * n); bg[n] = *(const f32x4*)(bias + 512 + col0 + 4 * n); }
#pragma unroll
        for (int ai = 0; ai < 2; ++ai)
#pragma unroll
            for (int m = 0; m < 4; ++m) { f32x4 o[2];
#pragma unroll
                for (int n = 0; n < 2; ++n)
#pragma unroll
                    for (int j = 0; j < 4; ++j) o[n][j] = (acc[ai][0][m][n][j] + bv[n][j]) * fsig(acc[ai][1][m][n][j] + bg[n][j]);
                *(u32x4*)(P + (size_t)(row0 + ai * HALF + m * 16) * PW + C_YS5 + col0) = pack8(o[0], o[1]); }
    }
};
struct EpiBranch {
    static constexpr bool PERM = true, AFTER_DRAIN = false;
    bf16_t* P;
    __device__ __forceinline__ void operator()(const f32x4 (&acc)[2][2][4][2], const Unit& u, int wr, int wc, int fr, int fq) const {
        const int row0 = u.pm * BM + wr * 64 + fr, col0 = u.pn * BM + wc * 32 + 8 * fq;
#pragma unroll
        for (int ai = 0; ai < 2; ++ai)
#pragma unroll
            for (int m = 0; m < 4; ++m) { bf16_t* rowp = P + (size_t)(row0 + ai * HALF + m * 16) * PW;
#pragma unroll
                for (int bj = 0; bj < 2; ++bj) { const int col = col0 + bj * HALF;
                    const u32x4 gw = *(const u32x4*)(rowp + C_GATE + u.z * D + col);
                    u32x4 pw = (u32x4){0u, 0u, 0u, 0u}; if (u.z > 0) pw = *(const u32x4*)(rowp + C_MERGED + col);
                    f32x4 o[2];
#pragma unroll
                    for (int n = 0; n < 2; ++n) { const unsigned g0 = gw[2 * n], g1 = gw[2 * n + 1], p0 = pw[2 * n], p1 = pw[2 * n + 1];
                        o[n][0] = blo(p0) + fsig(blo(g0)) * acc[ai][bj][m][n][0]; o[n][1] = bhi(p0) + fsig(bhi(g0)) * acc[ai][bj][m][n][1];
                        o[n][2] = blo(p1) + fsig(blo(g1)) * acc[ai][bj][m][n][2]; o[n][3] = bhi(p1) + fsig(bhi(g1)) * acc[ai][bj][m][n][3]; }
                    *(u32x4*)(rowp + C_MERGED + col) = pack8(o[0], o[1]); } }
    }
};

template <class Epi, class Sched, class GemmX, bool ALIGN_EPI = false, bool SP2 = false>
__device__ __forceinline__ void gemm_phase(PG8_LAS unsigned char* lds, const GemmX g, const Sched& S, const Epi& E) {
    int tid_ = threadIdx.x; asm volatile("" : "+v"(tid_));
    const int tid = tid_, wid = __builtin_amdgcn_readfirstlane(tid >> 6), lane = tid & 63, wr = wid >> 2, wc = wid & 3, fr = lane & 15, fq = lane >> 4;
    const int K = g.K, nt = K / BK;
    unsigned voffA[2], voffB[2];
#pragma unroll
    for (int i = 0; i < 2; ++i) { int R, C; stage_rc(tid * 16 + i * 8192, R, C); const int Rb = Epi::PERM ? ((R & ~31) + perm32(R & 31)) : R;
        voffA[i] = (unsigned)(R * g.lda + C) * 2u; voffB[i] = (unsigned)(Rb * g.ldb + C) * 2u; }
    const size_t kstep = (size_t)(BK * 2);
    const size_t hstepA = (size_t)HALF * g.lda * 2, hstepB = (size_t)HALF * g.ldb * 2;
    const size_t tstepA = 2 * hstepA, tstepB = 2 * hstepB;
    const unsigned ldsw = (unsigned)wid * 1024u;
    const int aoff = lds_byte(wr * 64 + fr, fq * 8), boff = lds_byte(wc * 32 + fr, fq * 8);
#define PG8_SA(b, h) (((b) * 2 + (h)) * HTB)
#define PG8_SB(b, h) ((4 + (b) * 2 + (h)) * HTB)
#define PG8_STAGE(bufoff, gbase, voff) do { _Pragma("unroll") for (int _i = 0; _i < 2; ++_i) \
        __builtin_amdgcn_global_load_lds((const unsigned*)((const char*)(gbase) + (voff)[_i]), (PG8_LAS unsigned*)(lds + (bufoff) + ldsw + _i * 8192), 16, 0, 0); } while (0)
#define PG8_LDA(dst, b, h) do { _Pragma("unroll") for (int m = 0; m < 4; ++m) _Pragma("unroll") for (int k = 0; k < 2; ++k) dst[m][k] = *(const PG8_LAS bf16x8*)(lds + PG8_SA(b, h) + aoff + m * 2048 + k * 1024); } while (0)
#define PG8_LDB(dst, b, h) do { _Pragma("unroll") for (int n = 0; n < 2; ++n) _Pragma("unroll") for (int k = 0; k < 2; ++k) dst[n][k] = *(const PG8_LAS bf16x8*)(lds + PG8_SB(b, h) + boff + n * 2048 + k * 1024); } while (0)
#define PG8_MMA(ai, bj, At, Bt) do { __builtin_amdgcn_s_setprio(1); _Pragma("unroll") for (int m = 0; m < 4; ++m) _Pragma("unroll") for (int n = 0; n < 2; ++n) _Pragma("unroll") for (int k = 0; k < 2; ++k) \
        acc[ai][bj][m][n] = __builtin_amdgcn_mfma_f32_16x16x32_bf16(Bt[n][k], At[m][k], acc[ai][bj][m][n], 0, 0, 0); __builtin_amdgcn_s_setprio(0); } while (0)
#define PG8_WAIT_V(n) asm volatile("s_waitcnt vmcnt(" #n ")" ::: "memory")
#define PG8_WAIT_L(n) asm volatile("s_waitcnt lgkmcnt(" #n ")" ::: "memory")
#define PG8_BAR __builtin_amdgcn_s_barrier()
#define PG8_SCHED __builtin_amdgcn_sched_barrier(0)
    Unit cur, nxt; int ui = 0;
    if (!S.next(0, cur)) return;
    f32x4 acc[2][2][4][2];
#pragma unroll
    for (int a = 0; a < 2; ++a)
#pragma unroll
        for (int b = 0; b < 2; ++b)
#pragma unroll
            for (int m = 0; m < 4; ++m)
#pragma unroll
                for (int n = 0; n < 2; ++n) acc[a][b][m][n] = (f32x4){0.f, 0.f, 0.f, 0.f};
    bf16x8 At[4][2], B0[2][2], B1[2][2];
    const char* cA = (const char*)g.A + (size_t)cur.pm * tstepA + (size_t)cur.z * g.zA; const char* cB = (const char*)g.Bt + (size_t)cur.pn * tstepB + (size_t)cur.z * g.zB;
    S.a_ready(cur);
    if constexpr (SP2) {
        PG8_STAGE(PG8_SB(0, 0), cB, voffB); PG8_STAGE(PG8_SB(0, 1), cB + hstepB, voffB); PG8_STAGE(PG8_SA(0, 0), cA, voffA); PG8_STAGE(PG8_SA(0, 1), cA + hstepA, voffA);
        if (wr == 1) PG8_BAR;
        PG8_WAIT_V(2); PG8_BAR;
        PG8_STAGE(PG8_SB(1, 0), cB + kstep, voffB); PG8_STAGE(PG8_SA(1, 0), cA + kstep, voffA); PG8_STAGE(PG8_SB(1, 1), cB + hstepB + kstep, voffB);
        PG8_WAIT_V(6); PG8_BAR;
    } else {
        PG8_STAGE(PG8_SB(0, 0), cB, voffB); PG8_STAGE(PG8_SA(0, 0), cA, voffA); PG8_STAGE(PG8_SB(0, 1), cB + hstepB, voffB); PG8_STAGE(PG8_SA(0, 1), cA + hstepA, voffA);
        if (wr == 1) PG8_BAR;
        PG8_WAIT_V(4); PG8_BAR;
        PG8_STAGE(PG8_SB(1, 0), cB + kstep, voffB); PG8_STAGE(PG8_SA(1, 0), cA + kstep, voffA); PG8_STAGE(PG8_SB(1, 1), cB + hstepB + kstep, voffB);
        PG8_WAIT_V(6); PG8_BAR;
    }
    for (;;) {
        const bool has_next = S.next(ui + 1, nxt);
        const char* nA = has_next ? (const char*)g.A + (size_t)nxt.pm * tstepA + (size_t)nxt.z * g.zA : cA; const char* nB = has_next ? (const char*)g.Bt + (size_t)nxt.pn * tstepB + (size_t)nxt.z * g.zB : cB;
        for (int t = 0; t < nt; t += 2) {
            const bool last = (t == nt - 2);
            const char* a1 = cA + (size_t)(t + 1) * kstep;
            const char* a2 = last ? nA : cA + (size_t)(t + 2) * kstep; const char* b2 = last ? nB : cB + (size_t)(t + 2) * kstep;
            const char* a3 = a2 + kstep; const char* b3 = b2 + kstep;
            if (last && has_next) S.a_ready(nxt);
            if constexpr (SP2) {
            PG8_LDB(B0, 0, 0); PG8_LDB(B1, 0, 1); PG8_SCHED; PG8_LDA(At, 0, 0); PG8_STAGE(PG8_SA(1, 1), a1 + hstepA, voffA);
            PG8_WAIT_V(8); PG8_WAIT_L(0); PG8_BAR; PG8_MMA(0, 0, At, B0); PG8_MMA(0, 1, At, B1); PG8_BAR; PG8_SCHED;
            PG8_LDA(At, 0, 1); PG8_STAGE(PG8_SB(0, 0), b2, voffB); PG8_STAGE(PG8_SB(0, 1), b2 + hstepB, voffB); PG8_STAGE(PG8_SA(0, 0), a2, voffA);
            PG8_WAIT_V(8); PG8_WAIT_L(0); PG8_BAR; PG8_MMA(1, 0, At, B0); PG8_MMA(1, 1, At, B1); PG8_BAR; PG8_SCHED;
            PG8_LDB(B0, 1, 0); PG8_LDB(B1, 1, 1); PG8_SCHED; PG8_LDA(At, 1, 0); PG8_STAGE(PG8_SA(0, 1), a2 + hstepA, voffA);
            PG8_WAIT_V(8); PG8_WAIT_L(0); PG8_BAR; PG8_MMA(0, 0, At, B0); PG8_MMA(0, 1, At, B1); PG8_BAR; PG8_SCHED;
            PG8_LDA(At, 1, 1); PG8_STAGE(PG8_SB(1, 0), b3, voffB); PG8_STAGE(PG8_SB(1, 1), b3 + hstepB, voffB); PG8_STAGE(PG8_SA(1, 0), a3, voffA);
            PG8_WAIT_V(8); PG8_WAIT_L(0); PG8_BAR; PG8_MMA(1, 0, At, B0); PG8_MMA(1, 1, At, B1); PG8_BAR; PG8_SCHED;
            } else {
            PG8_LDB(B0, 0, 0); PG8_SCHED; PG8_LDA(At, 0, 0); PG8_STAGE(PG8_SA(1, 1), a1 + hstepA, voffA);
            PG8_WAIT_L(8); PG8_BAR; PG8_WAIT_L(0); PG8_MMA(0, 0, At, B0); PG8_BAR; PG8_SCHED;
            PG8_LDB(B1, 0, 1); PG8_STAGE(PG8_SB(0, 0), b2, voffB);
            PG8_BAR; PG8_WAIT_L(0); PG8_MMA(0, 1, At, B1); PG8_BAR;
            PG8_LDA(At, 0, 1); PG8_STAGE(PG8_SA(0, 0), a2, voffA);
            PG8_BAR; PG8_WAIT_L(0); PG8_MMA(1, 0, At, B0); PG8_BAR; PG8_SCHED;
            PG8_STAGE(PG8_SB(0, 1), b2 + hstepB, voffB);
            PG8_WAIT_V(6); PG8_BAR; PG8_MMA(1, 1, At, B1); PG8_BAR;
            PG8_LDB(B0, 1, 0); PG8_SCHED; PG8_LDA(At, 1, 0); PG8_STAGE(PG8_SA(0, 1), a2 + hstepA, voffA);
            PG8_WAIT_L(8); PG8_BAR; PG8_WAIT_L(0); PG8_MMA(0, 0, At, B0); PG8_BAR; PG8_SCHED;
            PG8_LDB(B1, 1, 1); PG8_STAGE(PG8_SB(1, 0), b3, voffB);
            PG8_BAR; PG8_WAIT_L(0); PG8_MMA(0, 1, At, B1); PG8_BAR;
            PG8_LDA(At, 1, 1); PG8_STAGE(PG8_SA(1, 0), a3, voffA);
            PG8_BAR; PG8_WAIT_L(0); PG8_MMA(1, 0, At, B0); PG8_BAR; PG8_SCHED;
            PG8_STAGE(PG8_SB(1, 1), b3 + hstepB, voffB);
            PG8_WAIT_V(6); PG8_BAR; PG8_MMA(1, 1, At, B1); PG8_BAR;
            }
        }
        if constexpr (ALIGN_EPI) { if (wr == 0) PG8_BAR; }
        if constexpr (!Epi::AFTER_DRAIN) { E(acc, cur, wr, wc, fr, fq); S.done(cur); }
        if (!has_next) break;
#pragma unroll
        for (int a = 0; a < 2; ++a)
#pragma unroll
            for (int b = 0; b < 2; ++b)
#pragma unroll
                for (int m = 0; m < 4; ++m)
#pragma unroll
                    for (int n = 0; n < 2; ++n) acc[a][b][m][n] = (f32x4){0.f, 0.f, 0.f, 0.f};
        cur = nxt; cA = nA; cB = nB; ++ui;
        if constexpr (ALIGN_EPI) { if (wr == 1) PG8_BAR; }
    }
    PG8_WAIT_V(0);
    if constexpr (!ALIGN_EPI) { if (wr == 0) PG8_BAR; }
    PG8_BAR;
    if constexpr (Epi::AFTER_DRAIN) { E.fused(acc, cur, wr, wc, fr, fq, lds, wid, lane); S.done(cur); }
#undef PG8_SA
#undef PG8_SB
#undef PG8_STAGE
#undef PG8_LDA
#undef PG8_LDB
#undef PG8_MMA
#undef PG8_WAIT_V
#undef PG8_WAIT_L
#undef PG8_BAR
#undef PG8_SCHED
}
}

namespace attn_body {
using bf16=unsigned short;
using bf16x8=__attribute__((ext_vector_type(8)))short;
using s16x4=__attribute__((ext_vector_type(4)))short;
using f32x16=__attribute__((ext_vector_type(16)))float;
using u32x4=__attribute__((ext_vector_type(4)))unsigned;
constexpr int NMAP=8,SEQ=2048,D=64,DM=::PW;
constexpr int NW=8,QBLK=32,QB=QBLK*NW,KVBLK=64,NQB=SEQ/QB;

__device__ __forceinline__ int crow(int r,int hi){return (r&3)+8*(r>>2)+4*hi;}
#define SBAR() __builtin_amdgcn_sched_barrier(0)
__device__ __forceinline__ void cmask(f32x16&p0,f32x16&p1,int jb,int qrel,int hi){
  const float NEG=-INFINITY; int kb=64*jb+4*hi;
  #pragma unroll
  for(int r=0;r<16;++r){int kv=kb+(r&3)+8*(r>>2); if(kv>qrel)p0[r]=NEG; if(kv+32>qrel)p1[r]=NEG;}
}

typedef __attribute__((address_space(3))) const float* lds_cfptr;
__device__ __forceinline__ void addbias(f32x16&p0,f32x16&p1,int jb,int qrel,int hi,lds_cfptr tab){
  const int base=qrel-64*jb-4*hi;
  #pragma unroll
  for(int r=0;r<16;++r){const int d0=base-((r&3)+8*(r>>2)); const int i0=d0<0?0:(d0>127?127:d0); const int d1=d0-32; const int i1=d1<0?0:(d1>127?127:d1); p0[r]+=tab[i0]; p1[r]+=tab[i1];}
}
constexpr int NSLOT=3, SLOTB=8192;
constexpr int LDS_K=0, LDS_V=NSLOT*SLOTB, LDS_WS=2*NSLOT*SLOTB, LDS_OST=LDS_WS+NW*64*4, LDS_TAB=LDS_OST+NW*4096, LDS_BYTES=LDS_TAB+512;
constexpr float C2=0.125f*1.4426950408889634f;
__device__ __forceinline__ void glds16(const void*gsrc,unsigned lds_dst){unsigned keep;
  asm volatile("s_mov_b32 %0, m0\n\ts_mov_b32 m0, %2\n\ts_nop 0\n\tglobal_load_lds_dwordx4 %1, off\n\ts_mov_b32 m0, %0":"=&s"(keep):"v"(gsrc),"s"(lds_dst):"memory");}
__device__ __forceinline__ float max3f(float a,float b,float c){float r;asm("v_max3_f32 %0, %1, %2, %3":"=v"(r):"v"(a),"v"(b),"v"(c));return r;}
__device__ __forceinline__ float max2f(float a,float b){float r;asm("v_max_f32_e32 %0, %1, %2":"=v"(r):"v"(a),"v"(b));return r;}
__device__ __forceinline__ float fadd_s(float a,float b){float r;asm("v_add_f32_e32 %0, %1, %2":"=v"(r):"v"(a),"v"(b));return r;}
__device__ __forceinline__ float fsub_s(float a,float b){float r;asm("v_sub_f32_e32 %0, %1, %2":"=v"(r):"v"(a),"v"(b));return r;}
typedef float f32x2_t __attribute__((ext_vector_type(2))); typedef __bf16 bf16x2_t __attribute__((ext_vector_type(2)));
__device__ __forceinline__ unsigned cvtpk_s(float lo,float hi){f32x2_t v={lo,hi};bf16x2_t b=__builtin_convertvector(v,bf16x2_t);return __builtin_bit_cast(unsigned,b);}
#define WAIT_BAR(N) asm volatile("s_waitcnt vmcnt(" #N ") lgkmcnt(0)\n\ts_barrier":::"memory")

__device__ __forceinline__ void qkt(f32x16&p0,f32x16&p1,const char*Kslot,const bf16x8*qr,const f32x16&negm,int r32,int hi){
  const char*kb=Kslot+hi*1024+r32*16;
  #pragma unroll
  for(int d0=0;d0<4;++d0){
    const bf16x8 b0=*reinterpret_cast<const bf16x8*>(kb+d0*2048);
    const bf16x8 b1=*reinterpret_cast<const bf16x8*>(kb+d0*2048+512);
    if(d0==0){p0=__builtin_amdgcn_mfma_f32_32x32x16_bf16(b0,qr[0],negm,0,0,0);p1=__builtin_amdgcn_mfma_f32_32x32x16_bf16(b1,qr[0],negm,0,0,0);}
    else{p0=__builtin_amdgcn_mfma_f32_32x32x16_bf16(b0,qr[d0],p0,0,0,0);p1=__builtin_amdgcn_mfma_f32_32x32x16_bf16(b1,qr[d0],p1,0,0,0);}}
}
typedef __attribute__((address_space(3))) const char* lds_cptr;
typedef short v4i16_t __attribute__((ext_vector_type(4)));
__device__ __forceinline__ void kload8(bf16x8*kf,lds_cptr kp){
  kf[0]=*(const __attribute__((address_space(3))) bf16x8*)(kp);      kf[1]=*(const __attribute__((address_space(3))) bf16x8*)(kp+512);
  kf[2]=*(const __attribute__((address_space(3))) bf16x8*)(kp+2048); kf[3]=*(const __attribute__((address_space(3))) bf16x8*)(kp+2560);
  kf[4]=*(const __attribute__((address_space(3))) bf16x8*)(kp+4096); kf[5]=*(const __attribute__((address_space(3))) bf16x8*)(kp+4608);
  kf[6]=*(const __attribute__((address_space(3))) bf16x8*)(kp+6144); kf[7]=*(const __attribute__((address_space(3))) bf16x8*)(kp+6656);
}
__device__ __forceinline__ void kload2(bf16x8*kf,lds_cptr kp,int j){ kf[2*j]=*(const __attribute__((address_space(3))) bf16x8*)(kp+j*2048); kf[2*j+1]=*(const __attribute__((address_space(3))) bf16x8*)(kp+j*2048+512); }
__device__ __forceinline__ s16x4 vtr(lds_cptr p){ return __builtin_bit_cast(s16x4,__builtin_amdgcn_ds_read_tr16_b64_v4i16((__attribute__((address_space(3))) v4i16_t*)p)); }
__device__ __forceinline__ float rowmax(const f32x16&p0,const f32x16&p1){
  float a=max3f(p0[0],p0[1],p1[0]),b=max3f(p0[2],p0[3],p1[1]);a=max3f(a,p1[2],p1[3]);
  #pragma unroll
  for(int r=4;r<16;r+=4){a=max3f(a,p0[r],p0[r+1]);b=max3f(b,p0[r+2],p0[r+3]);a=max3f(a,p1[r],p1[r+1]);b=max3f(b,p1[r+2],p1[r+3]);}
  const float m=max2f(a,b);
  auto rr=__builtin_amdgcn_permlane32_swap(__float_as_uint(m),__float_as_uint(m),false,false);
  return max2f(__uint_as_float(rr[0]),__uint_as_float(rr[1]));
}
__device__ __forceinline__ void pv(f32x16*o,int vb,bf16x8 pa0,bf16x8 pa1,bf16x8 pa2,bf16x8 pa3){
  #pragma unroll
  for(int d0=0;d0<2;++d0){s16x4 lo[4],hi[4];
    #pragma unroll
    for(int ks=0;ks<4;++ks){
      asm volatile("ds_read_b64_tr_b16 %0,%1 offset:%c2":"=&v"(lo[ks]):"v"(vb),"i"(d0*4096+ks*1024):"memory");
      asm volatile("ds_read_b64_tr_b16 %0,%1 offset:%c2":"=&v"(hi[ks]):"v"(vb),"i"(d0*4096+ks*1024+512):"memory");}
    asm volatile("s_waitcnt lgkmcnt(0)":::"memory");SBAR();
    #define PK(k) (bf16x8){lo[k][0],lo[k][1],lo[k][2],lo[k][3],hi[k][0],hi[k][1],hi[k][2],hi[k][3]}
    o[d0]=__builtin_amdgcn_mfma_f32_32x32x16_bf16(pa0,PK(0),o[d0],0,0,0);
    o[d0]=__builtin_amdgcn_mfma_f32_32x32x16_bf16(pa1,PK(1),o[d0],0,0,0);
    o[d0]=__builtin_amdgcn_mfma_f32_32x32x16_bf16(pa2,PK(2),o[d0],0,0,0);
    o[d0]=__builtin_amdgcn_mfma_f32_32x32x16_bf16(pa3,PK(3),o[d0],0,0,0);
    #undef PK
  }
}

#ifndef ATTN_STORE16
#define ATTN_STORE16(p,v) (*(u32x4*)(p)=(v))
#endif
template<int THRL> __device__ __forceinline__ void attn_unit(int b,int m,int vh,int qb,const bf16*P,const float*rel_bias,char*shm){
  const bf16*Q=P+::C_DQ+m*64; const bf16*K=P+::C_DK+m*64; const bf16*V=P+::C_DV+(m>>1)*128+vh*64; bf16*O=(bf16*)P+::C_O+m*128+vh*64;
  int tid_=threadIdx.x; asm volatile("":"+v"(tid_));
  const int tid=tid_,lane=tid&63,r32=lane&31,hi=lane>>5; const int wid=__builtin_amdgcn_readfirstlane(tid>>6);
  const long rowbase=(long)b*SEQ; const int q0=qb*QB;
  const bf16*Qw=Q+(rowbase+q0+wid*QBLK)*DM;
  const bf16*Kh=K+rowbase*DM,*Vh=V+rowbase*DM;
  const unsigned lds0=(unsigned)(uintptr_t)shm;
  float*wsf=(float*)(shm+LDS_WS)+wid*64;
  const bf16*ksrc=Kh+(long)lane*DM+wid*8;
  const bf16*vsrc=Vh+(long)(16*(wid&3)+(lane>>2))*DM+(wid>>2)*32+(lane&3)*8;
  const unsigned kdst=lds0+LDS_K+wid*1024, vdst=lds0+LDS_V+wid*1024;
  #define DMA_K(t,slot) glds16(ksrc+(long)(t)*KVBLK*DM,(unsigned)__builtin_amdgcn_readfirstlane(kdst+(slot)))
  #define DMA_V(t,slot) glds16(vsrc+(long)(t)*KVBLK*DM,(unsigned)__builtin_amdgcn_readfirstlane(vdst+(slot)))
  const int vb0=(int)(lds0+LDS_V)+((lane>>4)&1)*32+(lane&3)*8+(4*hi+((lane&15)>>2))*64;
  const char*Kbase=shm+LDS_K; bf16x8 kf[8];
  const lds_cptr shm3=(lds_cptr)shm; const lds_cptr kp0=shm3+LDS_K+hi*1024+r32*16; const lds_cptr vp0=shm3+LDS_V+((lane>>4)&1)*32+(lane&3)*8+(4*hi+((lane&15)>>2))*64;
  const int NT=(q0+QB)/KVBLK;
  { __attribute__((address_space(3))) float* tabw=(__attribute__((address_space(3))) float*)((lds_cptr)shm+LDS_TAB);
    if(tid<128){ const float bv=(rel_bias[(int)::T5B[tid]*8+m]-rel_bias[31*8+m])*1.4426950408889634f; tabw[tid]=bv; }
    asm volatile("s_waitcnt vmcnt(0) lgkmcnt(0)":::"memory"); }
  const lds_cfptr tab=(lds_cfptr)((lds_cptr)shm+LDS_TAB);
  DMA_K(0,0);DMA_V(0,0);DMA_K(1,SLOTB);
  bf16x8 qr[4];
  #pragma unroll
  for(int d0=0;d0<4;++d0)qr[d0]=*reinterpret_cast<const bf16x8*>(&Qw[(long)r32*DM+d0*16+hi*8]);
  float mhat=0.f,l_reg=0.f;f32x16 o[2];o[0]=f32x16{};o[1]=f32x16{};f32x16 negm=f32x16{};asm volatile("":"+v"(negm));
  const int qrel=wid*QBLK+r32;
  #define CMASK(P0,P1,t) do{int jb_=(t)-(NT-4); if(jb_>=-2)addbias(P0,P1,jb_,qrel,hi,tab); if(jb_>=0)cmask(P0,P1,jb_,qrel,hi);}while(0)
  bool resc=false;
  #define START(P0,P1) do{ const float rm=rowmax(P0,P1); resc=false; \
    { const float dl=rm; mhat=fadd_s(mhat,dl); \
      _Pragma("unroll") for(int r=0;r<16;++r){P0[r]=fsub_s(P0[r],dl);P1[r]=fsub_s(P1[r],dl);} \
      _Pragma("unroll") for(int r=0;r<16;++r)negm[r]=-mhat; asm volatile("":"+v"(negm)); } \
    _Pragma("unroll") for(int r=0;r<16;++r)P0[r]=__builtin_amdgcn_exp2f(P0[r]); }while(0)
  #define RESC() do{ if(resc){ asm volatile("s_waitcnt lgkmcnt(0)":::"memory"); \
      _Pragma("unroll") for(int d_=0;d_<2;++d_) _Pragma("unroll") for(int r=0;r<16;++r)o[d_][r]*=wsf[crow(r,hi)]; } }while(0)
  f32x16 pA0,pA1,pB0,pB1;
  int sl_prev=0,sl_cur=0,sl_next=SLOTB;
  #define ROT() do{sl_prev=sl_cur;sl_cur=sl_next;sl_next=(sl_next==(NSLOT-1)*SLOTB)?0:sl_next+SLOTB;}while(0)
  DMA_K(2,2*SLOTB);
  WAIT_BAR(3);
  qkt(pA0,pA1,Kbase,qr,negm,r32,hi);asm volatile("s_nop 15\n\ts_nop 7":"+v"(pA0),"+v"(pA1));CMASK(pA0,pA1,0);
  START(pA0,pA1);
  _Pragma("unroll") for(int r=0;r<16;++r)pA1[r]=__builtin_amdgcn_exp2f(pA1[r]);
  WAIT_BAR(0);
  DMA_K(3,0);DMA_V(1,SLOTB);
  ROT();
  kload8(kf,kp0+sl_cur);
  WAIT_BAR(2);
  s16x4 vlo[8],vhi[8]; u32x4 pw0,pw1,pw2,pw3;
  #define PKW(P,B) cvtpk_s(P[B],P[B+1])
  #define PAF(k) __builtin_bit_cast(bf16x8,pw##k)
  #define VFR(i) (bf16x8){vlo[i][0],vlo[i][1],vlo[i][2],vlo[i][3],vhi[i][0],vhi[i][1],vhi[i][2],vhi[i][3]}
  #define PIN(x) asm volatile("":"+v"(x))
  #define MX3(a,b,c) __builtin_fmaxf(__builtin_fmaxf((a),(b)),(c))
  #define GAPA(MF,A0,A1,A2,A3,W0,W1,PW) do{ MF; sacc+=A0; sacc+=A1; sacc+=A2; sacc+=A3; PIN(sacc); W0; W1; PIN(PW); SBAR(); }while(0)
  #define EX(v) __builtin_amdgcn_exp2f(v)
  #define GAPB(MF,X,B) do{ MF; X[B]=EX(X[B]); X[B+1]=EX(X[B+1]); X[B+2]=EX(X[B+2]); X[B+3]=EX(X[B+3]); PIN(X); SBAR(); }while(0)
  #define VRD(i) do{ vlo[i]=vtr(vp_+(((i)>>2)*4096+((i)&3)*1024)); vhi[i]=vtr(vp_+(((i)>>2)*4096+((i)&3)*1024+512)); }while(0)
  #define KRD(G,j) do{ if(G){ kload2(kf,kp0+sl_next,j); SBAR(); } }while(0)
  #define STEP(C0,C1,P0,P1,t,GK,GV,GL) do{ SBAR(); \
    const lds_cptr vp_=vp0+sl_prev; \
    VRD(0); SBAR(); float sacc=(P0[0]+P0[1]); \
    GAPA(C0=__builtin_amdgcn_mfma_f32_32x32x16_bf16(kf[0],qr[0],negm,0,0,0), P0[2],P0[3],P0[4],P0[5],     pw0[0]=PKW(P0,0), pw0[1]=PKW(P0,2), pw0); \
    VRD(4); SBAR(); GAPA(C1=__builtin_amdgcn_mfma_f32_32x32x16_bf16(kf[1],qr[0],negm,0,0,0), P0[6],P0[7],P0[8],P0[9],     pw0[2]=PKW(P0,4), pw0[3]=PKW(P0,6), pw0); \
    VRD(1); SBAR(); GAPA(C0=__builtin_amdgcn_mfma_f32_32x32x16_bf16(kf[2],qr[1],C0,0,0,0),   P0[10],P0[11],P0[12],P0[13], pw1[0]=PKW(P0,8), pw1[1]=PKW(P0,10), pw1); \
    VRD(5); SBAR(); GAPA(C1=__builtin_amdgcn_mfma_f32_32x32x16_bf16(kf[3],qr[1],C1,0,0,0),   P0[14],P0[15],P1[0],P1[1],   pw1[2]=PKW(P0,12),pw1[3]=PKW(P0,14), pw1); \
    VRD(2); SBAR(); GAPA(C0=__builtin_amdgcn_mfma_f32_32x32x16_bf16(kf[4],qr[2],C0,0,0,0),   P1[2],P1[3],P1[4],P1[5],     pw2[0]=PKW(P1,0), pw2[1]=PKW(P1,2), pw2); \
    VRD(6); SBAR(); GAPA(C1=__builtin_amdgcn_mfma_f32_32x32x16_bf16(kf[5],qr[2],C1,0,0,0),   P1[6],P1[7],P1[8],P1[9],     pw2[2]=PKW(P1,4), pw2[3]=PKW(P1,6), pw2); \
    VRD(3); SBAR(); GAPA(C0=__builtin_amdgcn_mfma_f32_32x32x16_bf16(kf[6],qr[3],C0,0,0,0),   P1[10],P1[11],P1[12],P1[13], pw3[0]=PKW(P1,8), pw3[1]=PKW(P1,10), pw3); \
    VRD(7); SBAR(); GAPA(C1=__builtin_amdgcn_mfma_f32_32x32x16_bf16(kf[7],qr[3],C1,0,0,0),   P1[14],P1[15],0.f,0.f,       pw3[2]=PKW(P1,12),pw3[3]=PKW(P1,14), pw3); \
    l_reg+=sacc; \
    if(GK){DMA_K((t)+3,sl_cur);} if(GV){DMA_V((t)+1,sl_next);} \
    CMASK(C0,C1,t); \
    { float a=MX3(C0[0],C0[1],C1[0]),b=MX3(C0[2],C0[3],C1[1]); a=MX3(a,C1[2],C1[3]); \
      _Pragma("unroll") for(int r=4;r<16;r+=4){a=MX3(a,C0[r],C0[r+1]);b=MX3(b,C0[r+2],C0[r+3]);a=MX3(a,C1[r],C1[r+1]);b=MX3(b,C1[r+2],C1[r+3]);} \
      float rm=__builtin_fmaxf(a,b); { auto rr=__builtin_amdgcn_permlane32_swap(__float_as_uint(rm),__float_as_uint(rm),false,false); rm=__builtin_fmaxf(__uint_as_float(rr[0]),__uint_as_float(rr[1])); } \
      resc=false; \
      if(__builtin_expect(__any(rm>(float)THRL),0)){ const float dl=__builtin_fmaxf(rm,0.f); mhat+=dl; \
        _Pragma("unroll") for(int r=0;r<16;++r){C0[r]-=dl;C1[r]-=dl;} \
        _Pragma("unroll") for(int r=0;r<16;++r)negm[r]=-mhat; asm volatile("":"+v"(negm)); \
        const float f=__builtin_amdgcn_exp2f(-dl); l_reg*=f; if(hi==0)wsf[r32]=f; resc=true; } } \
    SBAR(); \
    GAPB(o[0]=__builtin_amdgcn_mfma_f32_32x32x16_bf16(PAF(0),VFR(0),o[0],0,0,0), C0,0); \
    GAPB(o[1]=__builtin_amdgcn_mfma_f32_32x32x16_bf16(PAF(0),VFR(4),o[1],0,0,0), C0,4); \
    KRD(GL,0); GAPB(o[0]=__builtin_amdgcn_mfma_f32_32x32x16_bf16(PAF(1),VFR(1),o[0],0,0,0), C0,8); \
    KRD(GL,1); GAPB(o[1]=__builtin_amdgcn_mfma_f32_32x32x16_bf16(PAF(1),VFR(5),o[1],0,0,0), C0,12); \
    KRD(GL,2); GAPB(o[0]=__builtin_amdgcn_mfma_f32_32x32x16_bf16(PAF(2),VFR(2),o[0],0,0,0), C1,0); \
    KRD(GL,3); GAPB(o[1]=__builtin_amdgcn_mfma_f32_32x32x16_bf16(PAF(2),VFR(6),o[1],0,0,0), C1,4); \
    GAPB(o[0]=__builtin_amdgcn_mfma_f32_32x32x16_bf16(PAF(3),VFR(3),o[0],0,0,0), C1,8); \
    GAPB(o[1]=__builtin_amdgcn_mfma_f32_32x32x16_bf16(PAF(3),VFR(7),o[1],0,0,0), C1,12); \
    }while(0)
  int t=1;
  #undef CMASK
  #define CMASK(P0,P1,t) do{}while(0)
  for(;t+7<NT;t+=2){
    STEP(pB0,pB1,pA0,pA1,t,true,true,true);     WAIT_BAR(2); RESC(); ROT();
    STEP(pA0,pA1,pB0,pB1,t+1,true,true,true);   WAIT_BAR(2); RESC(); ROT();
  }
  #undef CMASK
  #define CMASK(P0,P1,t) do{int jb_=(t)-(NT-4); if(jb_>=-2)addbias(P0,P1,jb_,qrel,hi,tab); if(jb_>=0)cmask(P0,P1,jb_,qrel,hi);}while(0)
  #define ENDW(tt) do{ if((tt)+3<NT){WAIT_BAR(2);} else if((tt)+2<NT){WAIT_BAR(1);} else {WAIT_BAR(0);} }while(0)
  for(;t+1<NT;t+=2){
    STEP(pB0,pB1,pA0,pA1,t,(t+3<NT),(t+1<NT),(t+1<NT));       ENDW(t);   RESC(); ROT();
    STEP(pA0,pA1,pB0,pB1,t+1,(t+4<NT),(t+2<NT),(t+2<NT));     ENDW(t+1); RESC(); ROT();
  }
  STEP(pB0,pB1,pA0,pA1,NT-1,false,false,false); RESC();
  { float sacc=pB0[0]+pB0[1]; _Pragma("unroll") for(int r=2;r<16;++r)sacc+=pB0[r]; _Pragma("unroll") for(int r=0;r<16;++r)sacc+=pB1[r]; l_reg+=sacc;
    pw0=(u32x4){PKW(pB0,0),PKW(pB0,2),PKW(pB0,4),PKW(pB0,6)};pw1=(u32x4){PKW(pB0,8),PKW(pB0,10),PKW(pB0,12),PKW(pB0,14)};pw2=(u32x4){PKW(pB1,0),PKW(pB1,2),PKW(pB1,4),PKW(pB1,6)};pw3=(u32x4){PKW(pB1,8),PKW(pB1,10),PKW(pB1,12),PKW(pB1,14)};
    SBAR(); pv(o,vb0+sl_cur,PAF(0),PAF(1),PAF(2),PAF(3)); }
  #undef PKW
  #undef PAF
  #undef VFR
  #undef PIN
  #undef MX3
  #undef GAPA
  #undef GAPB
  #undef EX
  #undef VRD
  #undef KRD
  #undef STEP
  #undef ENDW
  {auto rr=__builtin_amdgcn_permlane32_swap(__float_as_uint(l_reg),__float_as_uint(l_reg),false,false);l_reg=__uint_as_float(rr[0])+__uint_as_float(rr[1]);}
  if(hi==0)wsf[32+r32]=l_reg;asm volatile("s_waitcnt lgkmcnt(0)":::"memory");
  float rli[16];
  #pragma unroll
  for(int r=0;r<16;++r)rli[r]=__builtin_amdgcn_rcpf(wsf[32+crow(r,hi)]);
  bf16*Ow=O+(rowbase+q0+wid*QBLK)*DM;
  { bf16*stg=(bf16*)(shm+LDS_OST)+wid*2048;
    #pragma unroll
    for(int r=0;r<16;++r){const int orow=crow(r,hi);
      #pragma unroll
      for(int d0=0;d0<2;++d0)stg[orow*64+d0*32+r32]=::f2bf(o[d0][r]*rli[r]);}
    asm volatile("s_waitcnt lgkmcnt(0)":::"memory");
    #pragma unroll
    for(int i=0;i<4;++i){const int row=i*8+(lane>>3),ch=lane&7; const u32x4 v=*(const u32x4*)(stg+row*64+ch*8); ATTN_STORE16(Ow+(long)row*DM+ch*8,v);} }
  asm volatile("s_waitcnt lgkmcnt(0)\n\ts_barrier":::"memory");
  #undef DMA_K
  #undef DMA_V
  #undef CMASK
  #undef START
  #undef RESC
  #undef ROT
}
constexpr int ATTN_LDS_BYTES=LDS_BYTES;
struct AttnUnit { int b, m, vh, qb; };
struct StaticOrder {
  int vcu, G;
  __device__ __forceinline__ StaticOrder(int grid,int v):vcu(v),G(grid){}
  __device__ __forceinline__ bool next(int i,AttnUnit&u)const{
    int combo,qb;
    if(G==256){ if(i>=4)return false; const int s=vcu&1; combo=vcu>>1; qb=(i==0)?7-s:(i==1)?4+s:(i==2)?3-s:s; }
    else { const int idx=i*G+vcu; if(idx>=1024)return false; combo=idx>>3; qb=idx&7; }
    u.vh=combo&1; u.m=(combo>>1)&7; u.b=combo>>4; u.qb=qb; return true; }
};
template<class Sched,int THRL=8> __device__ __forceinline__ void attn_phase(char*lds,const bf16*P,const float*rel_bias,const Sched&S){
  AttnUnit u;
  for(int i=0;S.next(i,u);++i){ attn_unit<THRL>(u.b,u.m,u.vh,u.qb,P,rel_bias,lds); }
}
#undef SBAR
#undef WAIT_BAR
}

#define GAS __attribute__((address_space(1)))
#define LAS __attribute__((address_space(3)))
typedef unsigned v4u __attribute__((ext_vector_type(4)));
typedef GAS unsigned gu32;
typedef GAS unsigned long long gu64;
#define RLX_AGENT __ATOMIC_RELAXED, __HIP_MEMORY_SCOPE_AGENT
#define LDS_WAIT() asm volatile("s_waitcnt lgkmcnt(0)" ::: "memory")
#define VM_WAIT() asm volatile("s_waitcnt vmcnt(0)" ::: "memory")

#define XB_TMO      128
#define XB_XCNT(j)  (256  + 64 * (j))
#define XB_XSUB(j)  (1280 + 64 * (j))
#define XB_XGEN(j)  (2304 + 64 * (j))
#define XB_TOP      3328
#define XB_TOPGEN   3392
#define XCD_BAR_WORDS 3456
#define XB_SPIN_CAP (1u << 18)

__device__ __forceinline__ unsigned xb_ld(unsigned* p)              { return __hip_atomic_load(p, __ATOMIC_RELAXED, __HIP_MEMORY_SCOPE_AGENT); }
__device__ __forceinline__ unsigned xb_add(unsigned* p, unsigned v) { return __hip_atomic_fetch_add(p, v, __ATOMIC_RELAXED, __HIP_MEMORY_SCOPE_AGENT); }
__device__ __forceinline__ unsigned xb_xcc_id() { return (unsigned)__builtin_amdgcn_s_getreg((3 << 11) | 20) & 0xFu; }
#define XB_SPIN(cond, bar) do { unsigned _sp = 0; while (cond) { __builtin_amdgcn_s_sleep(1); \
    if ((++_sp & 255u) == 0u) { if (xb_ld(&(bar)[XB_TMO])) break; if (_sp > XB_SPIN_CAP) { atomicAdd(&(bar)[XB_TMO], 1u); break; } } } } while (0)

struct XcdBarrier {
    unsigned* bar; unsigned x;
    volatile LAS unsigned* st;
};

__device__ __forceinline__ XcdBarrier xcd_barrier_post(unsigned* bar, volatile LAS unsigned* st) {
    XcdBarrier b; b.bar = bar; b.x = xb_xcc_id(); b.st = st;
    if (threadIdx.x == 0) (void)xb_add(&bar[XB_XCNT(b.x)], 1u);
    return b;
}
__device__ __forceinline__ void xcd_barrier_complete(unsigned* bar, unsigned x, unsigned& nloc, unsigned& nx) {
    const unsigned G = gridDim.x * gridDim.y * gridDim.z;
    unsigned sum, cnt, mine, sp = 0u;
    for (;;) {
        sum = 0u; cnt = 0u; mine = 0u;
#pragma unroll
        for (unsigned j = 0; j < 16; ++j) { const unsigned c = xb_ld(&bar[XB_XCNT(j)]); sum += c; cnt += (c > 0u) ? 1u : 0u; mine = (j == x) ? c : mine; }
        if (sum == G) break;
        __builtin_amdgcn_s_sleep(1);
        if ((++sp & 255u) == 0u) { if (xb_ld(&bar[XB_TMO])) break; if (sp > XB_SPIN_CAP) { atomicAdd(&bar[XB_TMO], 1u); break; } }
    }
    nloc = mine > 0u ? mine : 1u; nx = cnt > 0u ? cnt : 1u;
}

__device__ __forceinline__ void xcd_barrier(const XcdBarrier& b) {
    asm volatile("s_waitcnt vmcnt(0)" ::: "memory");
    __syncthreads();
    if (threadIdx.x == 0) {
        unsigned* bar = b.bar;
        __builtin_amdgcn_s_waitcnt(0);
        unsigned nloc = b.st[0], nx = b.st[1];
        if (nloc == 0u) { xcd_barrier_complete(bar, b.x, nloc, nx); b.st[0] = nloc; b.st[1] = nx; }
        const unsigned old = xb_add(&bar[XB_XSUB(b.x)], 1u);
        const unsigned gen = old / nloc;
        if (old + 1u == (gen + 1u) * nloc) {
            __builtin_amdgcn_fence(__ATOMIC_RELEASE, "agent");
            asm volatile("s_waitcnt vmcnt(0)" ::: "memory");
            const unsigned og = xb_add(&bar[XB_TOP], 1u);
            const unsigned tg = og / nx;
            if (og + 1u == (tg + 1u) * nx) xb_add(&bar[XB_TOPGEN], 1u);
            else XB_SPIN(xb_ld(&bar[XB_TOPGEN]) == tg, bar);
            __builtin_amdgcn_fence(__ATOMIC_ACQUIRE, "agent");
            xb_add(&bar[XB_XGEN(b.x)], 1u);
            asm volatile("s_waitcnt vmcnt(0)" ::: "memory");
        } else {
            XB_SPIN(xb_ld(&bar[XB_XGEN(b.x)]) == gen, bar);
            __builtin_amdgcn_fence(__ATOMIC_ACQUIRE, "agent");
            asm volatile("s_waitcnt vmcnt(0)" ::: "memory");
        }
    }
    __syncthreads();
}

constexpr int NWAVES = 8;
constexpr int RING_OFF = 0, RING_BYTES = 131072;
constexpr int LDSCTL_OFF = RING_BYTES, MISC_OFF = LDSCTL_OFF + 320;
constexpr int LDS_BYTES = 147456;
constexpr int CW_BAR = 4096;
constexpr int PH_PROLOGUE = 0, PH_ROW0 = 1, PH_LAYER0 = 2, NPL = 15;
enum { S_UP1 = 0, S_DN1, S_ROWA, S_WIN, S_GLA, S_S5, S_ATTN, S_DFIN, S_GLU, S_BRANCH, S_WOUT, S_ROWB, S_UP2, S_DN2, S_ROWC };
constexpr int N_PHASES = PH_LAYER0 + DEPTH * NPL;

struct Args { const float* in[29]; float* out; unsigned char* ws; int ph_lo, ph_hi; };
struct Frame {
    LAS unsigned char* lds; char* ldsg;
    int tid, lane, wave, vcu, G, z, cid;
    const float* const* in; float* out; unsigned char* ws;
};

template <int MAP> __device__ __forceinline__ int conv_src(int n) {
    if (MAP == 0) return n;
    if (MAP == 1) { const int t = n >> 8, r = n & 255; return r < 128 ? 128 * t + r : DFF + 128 * t + (r - 128); }
    if (MAP == 2) return my2ref(n);
    { const int t = n >> 8, r = n & 255; return r < 128 ? 128 * t + r : 512 + 128 * t + (r - 128); }
}
template <int MAP> __device__ __forceinline__ void conv_item(const float* W, int K, int N, int Np, bf16_t* WT, LAS float* scr, int item, int lane) {
    const int nblk = Np / 32, kb = item / nblk, nb = item % nblk, k0 = 64 * kb, n0 = 32 * nb;
    const int src = conv_src<MAP>(n0 + (lane & 31));
#pragma unroll 8
    for (int i = 0; i < 32; ++i) { const int kk = 2 * i + (lane >> 5); scr[kk * 33 + (lane & 31)] = (src >= 0) ? W[(size_t)(k0 + kk) * N + src] : 0.f; }
    LDS_WAIT(); asm volatile("" ::: "memory");
    const int c = lane & 7;
#pragma unroll
    for (int j = 0; j < 4; ++j) { const int n = (lane >> 3) + 8 * j; const LAS float* s = scr + (8 * c) * 33 + n;
        v4u o; o.x = pk2(s[0 * 33], s[1 * 33]); o.y = pk2(s[2 * 33], s[3 * 33]); o.z = pk2(s[4 * 33], s[5 * 33]); o.w = pk2(s[6 * 33], s[7 * 33]);
        *(GAS v4u*)(WT + (size_t)(n0 + n) * K + k0 + 8 * c) = o; }
    LDS_WAIT(); asm volatile("" ::: "memory");
}
__device__ __forceinline__ void convert_layer(Frame& F, int l) {
    LAS float* scr = (LAS float*)(F.lds + RING_OFF + F.wave * 16384);
    const int gw = F.vcu * NWAVES + F.wave, NGW = F.G * NWAVES;
    bf16_t* wb = (bf16_t*)(F.ws + WS_W);
    constexpr int I_UP = (D / 64) * (2 * DFF / 32), I_DN = (DFF / 64) * (D / 32), I_IN = (D / 64) * (PW / 32), I_GLU = (512 / 64) * (1024 / 32), I_BR = I_GLU, I_OUT = (D / 64) * (D / 32);
    constexpr int NITEMS = 2 * I_UP + 2 * I_DN + I_IN + I_GLU + 3 * I_BR + I_OUT;
    const float* f1u = F.in[F.z + 7] + (size_t)l * D * 2 * DFF; const float* f1d = F.in[F.z + 8] + (size_t)l * DFF * D;
    const float* f2u = F.in[F.z + 9] + (size_t)l * D * 2 * DFF; const float* f2d = F.in[F.z + 10] + (size_t)l * DFF * D;
    const float* win = F.in[F.z + 11] + (size_t)l * D * INW; const float* wglu = F.in[F.z + 25] + (size_t)l * 512 * 1024;
    const float* wbr = F.in[F.z + 27] + (size_t)l * 3 * 512 * D; const float* wout = F.in[F.z + 28] + (size_t)l * D * D;
    for (int it = gw; it < NITEMS; it += NGW) {
        int r = it;
        if (r < I_UP) { conv_item<1>(f1u, D, 2 * DFF, 2 * DFF, wb + W_UP1, scr, r, F.lane); continue; } r -= I_UP;
        if (r < I_DN) { conv_item<0>(f1d, DFF, D, D, wb + W_DN1, scr, r, F.lane); continue; } r -= I_DN;
        if (r < I_UP) { conv_item<1>(f2u, D, 2 * DFF, 2 * DFF, wb + W_UP2, scr, r, F.lane); continue; } r -= I_UP;
        if (r < I_DN) { conv_item<0>(f2d, DFF, D, D, wb + W_DN2, scr, r, F.lane); continue; } r -= I_DN;
        if (r < I_IN) { conv_item<2>(win, D, INW, PW, wb + W_IN, scr, r, F.lane); continue; } r -= I_IN;
        if (r < I_GLU) { conv_item<3>(wglu, 512, 1024, 1024, wb + W_GLU, scr, r, F.lane); continue; } r -= I_GLU;
        if (r < 3 * I_BR) { const int i = r / I_BR; conv_item<0>(wbr + (size_t)i * 512 * D, 512, D, D, wb + W_BR + (size_t)i * 1024 * 512, scr, r % I_BR, F.lane); continue; } r -= 3 * I_BR;
        conv_item<0>(wout, D, D, D, wb + W_OUT, scr, r, F.lane);
    }
}
__device__ __forceinline__ void ada_phase(Frame& F) {
    if (F.vcu < 2 * 72) {
        const int l = F.vcu / 72, cb = F.vcu % 72;
        LAS float* cond = (LAS float*)(F.lds + RING_OFF);
        LAS float* red = (LAS float*)(F.lds + RING_OFF + 32768);
        const float* c = F.in[F.z + 1];
        for (int i = F.tid; i < BATCH * D; i += NWAVES * 64) cond[i] = siluf_(c[i]);
        __syncthreads();
        float acc[BATCH][2];
#pragma unroll
        for (int b = 0; b < BATCH; ++b) { acc[b][0] = 0.f; acc[b][1] = 0.f; }
        const float* w = F.in[F.z + 3] + ((size_t)l * D + F.wave * 128) * ADA + cb * 128 + 2 * F.lane;
#pragma unroll 4
        for (int k = 0; k < 128; ++k) { const float2 wv = *(const float2*)(w + (size_t)k * ADA);
#pragma unroll
            for (int b = 0; b < BATCH; ++b) { const float cv = cond[b * D + F.wave * 128 + k]; acc[b][0] += cv * wv.x; acc[b][1] += cv * wv.y; } }
#pragma unroll
        for (int b = 0; b < BATCH; ++b) { red[(F.wave * 8 + b) * 128 + 2 * F.lane] = acc[b][0]; red[(F.wave * 8 + b) * 128 + 2 * F.lane + 1] = acc[b][1]; }
        __syncthreads();
        float* ada = (float*)(F.ws + WS_ADA);
        for (int o = F.tid; o < BATCH * 128; o += NWAVES * 64) { const int b = o >> 7, cc = o & 127; float s = F.in[F.z + 4][l * ADA + cb * 128 + cc];
#pragma unroll
            for (int w8 = 0; w8 < 8; ++w8) s += red[(w8 * 8 + b) * 128 + cc];
            ada[((size_t)l * BATCH + b) * ADA + cb * 128 + cc] = s; }
        __syncthreads();
    }
}
__device__ __forceinline__ void rowpass_phase(Frame& F, int l, int sub) {
    const int gw = F.vcu * NWAVES + F.wave, NGW = F.G * NWAVES;
    const float* ada = (const float*)(F.ws + WS_ADA); const float* adal = ada + (size_t)l * BATCH * ADA;
    const float* npre = F.in[F.z + 5] + l * 3 * D; const float* npost = F.in[F.z + 6] + l * 3 * D;
    bf16_t* u = (bf16_t*)(F.ws + WS_U); const bf16_t* y = (const bf16_t*)(F.ws + WS_Y);
    const float* h_in = F.out; const bf16_t* yy = y; const float* gpost = nullptr; const float* gate = nullptr; float coef = 0.f;
    const float* gpre = nullptr; const float* shift = nullptr; const float* scale = nullptr; bf16_t* uu = u;
    if (sub == 0) { h_in = F.in[F.z + 0]; yy = nullptr; gpre = npre; shift = adal; scale = adal + D; }
    else if (sub == 1) { gpost = npost; gate = adal + 2 * D; coef = 0.5f; gpre = npre + D; shift = adal + 3 * D; scale = adal + 4 * D; }
    else if (sub == 2) { gpost = npost + D; gate = adal + 5 * D; coef = 1.0f; gpre = npre + 2 * D; shift = adal + 6 * D; scale = adal + 7 * D; }
    else { gpost = npost + 2 * D; gate = adal + 8 * D; coef = 0.5f;
        if (l + 1 < DEPTH) { gpre = F.in[F.z + 5] + (l + 1) * 3 * D; shift = adal + (size_t)BATCH * ADA; scale = shift + D; } else uu = nullptr; }
    for (int row = gw; row < M; row += NGW) rowpass_row(row, F.lane, h_in, F.out, yy, gpost, gate, coef, gpre, shift, scale, uu);
}
__device__ __forceinline__ void dfin_phase(Frame& F, int l) {
    const int gw = F.vcu * NWAVES + F.wave, NGW = F.G * NWAVES;
    const float* lamv = F.in[F.z + 15] + l * 256; const float lam_init = 0.8f - 0.6f * __expf(-0.3f * (float)l);
    const float lam = __expf(wave_sum(lamv[F.lane] * lamv[64 + F.lane])) - __expf(wave_sum(lamv[128 + F.lane] * lamv[192 + F.lane])) + lam_init;
    bf16_t* proj = (bf16_t*)(F.ws + WS_R0);
    for (int row = gw; row < M; row += NGW) diff_fin_row(proj + (size_t)row * PW, F.lane, lam, F.in[F.z + 16] + l * 512, lam_init);
}


__device__ __forceinline__ void gla_naive_phase(Frame& F, int l) {
    if (F.vcu >= BATCH * 4) return;
    bf16_t* proj = (bf16_t*)(F.ws + WS_R0);
    const float* w_alpha = F.in[F.z + 12] + l * 16 * 256; const float* b_alpha = F.in[F.z + 13] + l * 256; const float* norm_g = F.in[F.z + 14] + l * 512;
    const int b = F.vcu >> 2, h = F.vcu & 3, t = F.tid, lane = t & 63, e = t & 127, half = (t >> 7) & 1; const bool act = t < 256;
    LAS float* sa = (LAS float*)(F.lds + RING_OFF); LAS float* sq = sa + 64; LAS float* sk = sq + 64; LAS float* part = sk + 64; LAS float* red = part + 256;
    float S[32];
#pragma unroll
    for (int i = 0; i < 32; ++i) S[i] = 0.f;
    float wa[16]; float ba = 0.f;
#pragma unroll
    for (int j = 0; j < 16; ++j) wa[j] = 0.f;
    if (t < 64) { for (int j = 0; j < 16; ++j) wa[j] = w_alpha[j * 256 + h * 64 + t]; ba = b_alpha[h * 64 + t]; }
    const float ng = norm_g[h * 128 + e];
    for (int s = 0; s < SEQ; ++s) {
        bf16_t* row = proj + (size_t)(b * SEQ + s) * PW;
        if (t < 64) {
            float z = ba;
#pragma unroll
            for (int j = 0; j < 16; ++j) z += bf2f(row[C_GA + j]) * wa[j];
            const float ls = fminf(z, 0.f) - log1pf(__expf(-fabsf(z)));
            sa[t] = __expf(ls * (1.f / 16.f)); sq[t] = bf2f(row[C_GQ + h * 64 + t]); sk[t] = bf2f(row[C_GK + h * 64 + t]);
        }
        const float v = bf2f(row[C_GV + h * 128 + e]);
        const float rr = bf2f(row[C_GR + h * 128 + e]);
        __syncthreads();
        if (act) { float p = 0.f;
#pragma unroll
            for (int i = 0; i < 32; ++i) { const int d = half * 32 + i; S[i] = sa[d] * S[i] + sk[d] * v; p += sq[d] * S[i]; }
            part[half * 128 + e] = p; }
        __syncthreads();
        float o = 0.f;
        if (t < 128) { o = part[e] + part[128 + e]; const float ss = wave_sum(o * o); if (lane == 0) red[t >> 6] = ss; }
        __syncthreads();
        if (t < 128) { const float r = rsqrtf((red[0] + red[1]) * (1.f / 128.f) + EPS); row[C_YGLA + h * 128 + e] = f2bf(o * r * ng * siluf_(rr)); }
        __syncthreads();
    }
}
__device__ __forceinline__ void s5_naive_phase(Frame& F, int l) {
    if (F.wave != 0) return;
    const float* lam_re = F.in[F.z + 17] + l * 2048; const float* lam_im = F.in[F.z + 18] + l * 2048; const float* log_step = F.in[F.z + 19] + l * 32;
    const float* b_re = F.in[F.z + 20] + l * 32768; const float* b_im = F.in[F.z + 21] + l * 32768; const float* c_re = F.in[F.z + 22] + l * 32768; const float* c_im = F.in[F.z + 23] + l * 32768; const float* d_skip = F.in[F.z + 24] + l * 512;
    bf16_t* proj = (bf16_t*)(F.ws + WS_R0);
    for (int item = F.vcu; item < BATCH * 32; item += F.G) {
        const int b = item >> 5, g = item & 31, p = F.lane;
        const float lr = lam_re[g * 64 + p], li = lam_im[g * 64 + p], dt = expf(log_step[g]);
        const float mag = expf(lr * dt), ar = mag * cosf(li * dt), ai = mag * sinf(li * dt);
        const float nr = ar - 1.f, ni = ai, den = lr * lr + li * li, fre = (nr * lr + ni * li) / den, fim = (ni * lr - nr * li) / den;
        float bbr[16], bbi[16], cr[16], ci[16];
#pragma unroll
        for (int h = 0; h < 16; ++h) { const float br = b_re[(g * 64 + p) * 16 + h], bi = b_im[(g * 64 + p) * 16 + h]; bbr[h] = fre * br - fim * bi; bbi[h] = fre * bi + fim * br;
            cr[h] = c_re[(g * 16 + h) * 64 + p]; ci[h] = c_im[(g * 16 + h) * 64 + p]; }
        const float dsk = (p < 16) ? d_skip[g * 16 + p] : 0.f;
        float xr = 0.f, xi = 0.f;
        for (int s = 0; s < SEQ; ++s) {
            bf16_t* row = proj + (size_t)(b * SEQ + s) * PW + C_SU + g * 16;
            float u[16];
#pragma unroll
            for (int h = 0; h < 16; ++h) u[h] = bf2f(row[h]);
            float bur = 0.f, bui = 0.f;
#pragma unroll
            for (int h = 0; h < 16; ++h) { bur += bbr[h] * u[h]; bui += bbi[h] * u[h]; }
            const float nxr = ar * xr - ai * xi + bur, nxi = ar * xi + ai * xr + bui; xr = nxr; xi = nxi;
            float yn = 0.f;
#pragma unroll
            for (int n = 0; n < 16; ++n) { const float v = wave_sum(cr[n] * xr - ci[n] * xi); if (p == n) yn = v + dsk * u[n]; }
            if (p < 16) { const float x3 = yn * yn * yn; const float gl = 0.5f * yn * (1.f + tanhf(0.7978845608028654f * (yn + 0.044715f * x3))); row[p] = f2bf(gl); }
        }
    }
}
__device__ __forceinline__ void attn_naive_phase(Frame& F) {
    bf16_t* proj = (bf16_t*)(F.ws + WS_R0); const float* rel_bias = F.in[F.z + 2];
    LAS float* sc = (LAS float*)(F.lds + RING_OFF + F.wave * 16384);
    LAS float* sq = sc + SEQ;
    const int gw0 = F.vcu * NWAVES + F.wave, NGW = F.G * NWAVES, lane = F.lane;
    for (int gw = gw0; gw < BATCH * 8 * SEQ; gw += NGW) {
        const int q = gw % SEQ, m = (gw / SEQ) % 8, b = gw / (SEQ * 8);
        const bf16_t* base = proj + (size_t)b * SEQ * PW;
        sq[lane] = bf2f(base[(size_t)q * PW + C_DQ + m * 64 + lane]);
        LDS_WAIT();
        float mx = -INFINITY;
        for (int s0 = 0; s0 <= q; s0 += 64) {
            const int s = s0 + lane; float v = -INFINITY;
            if (s <= q) { const bf16_t* kr = base + (size_t)s * PW + C_DK + m * 64; float a = 0.f;
                for (int d = 0; d < 64; ++d) a += sq[d] * bf2f(kr[d]);
                const int dist = q - s; const int bk = T5B[dist < 127 ? dist : 127]; v = a + rel_bias[bk * 8 + m] * LOG2E; }
            sc[s] = v; mx = fmaxf(mx, v);
        }
        mx = wave_max(mx);
        float sum = 0.f;
        for (int s0 = 0; s0 <= q; s0 += 64) { const int s = s0 + lane; if (s <= q) { const float pz = exp2f(sc[s] - mx); sc[s] = pz; sum += pz; } }
        sum = wave_sum(sum);
        LDS_WAIT();
        const int hh = m >> 1; float o0 = 0.f, o1 = 0.f;
        for (int s = 0; s <= q; ++s) { const float pz = sc[s]; const unsigned vv = *(const unsigned*)(base + (size_t)s * PW + C_DV + hh * 128 + lane * 2); o0 += pz * blo(vv); o1 += pz * bhi(vv); }
        LDS_WAIT();
        const float inv = 1.f / sum;
        *(unsigned*)(proj + (size_t)(b * SEQ + q) * PW + C_O + m * 128 + lane * 2) = pk2(o0 * inv, o1 * inv);
    }
}

__device__ __forceinline__ void run_phase(Frame& F, int ph) {
    bf16_t* wb = (bf16_t*)(F.ws + WS_W); bf16_t* u = (bf16_t*)(F.ws + WS_U); bf16_t* y = (bf16_t*)(F.ws + WS_Y);
    bf16_t* hid = (bf16_t*)(F.ws + WS_R0); bf16_t* proj = (bf16_t*)(F.ws + WS_R0);
    if (ph == PH_PROLOGUE) { ada_phase(F); convert_layer(F, 0); return; }
    if (ph == PH_ROW0) { rowpass_phase(F, 0, 0); return; }
    const int l = (ph - PH_LAYER0) / NPL, s = (ph - PH_LAYER0) % NPL;
    const int cid = F.cid;
    switch (s) {
    case S_UP1: case S_UP2: {
        typedef pg8::GemmT<D, D, D, 0, 0> GT; GT g{u, wb + (s == S_UP1 ? W_UP1 : W_UP2)}; pg8::StaticOrder S; S.init(M, 2 * DFF, F.G, cid);
        pg8::EpiSwiGLU E{hid}; pg8::gemm_phase<pg8::EpiSwiGLU, pg8::StaticOrder, GT, true, true>(F.lds + RING_OFF, g, S, E); break; }
    case S_DN1: case S_DN2: {
        typedef pg8::GemmT<DFF, DFF, DFF, 0, 0> GT; GT g{hid, wb + (s == S_DN1 ? W_DN1 : W_DN2)}; pg8::StaticOrder S; S.init(M, D, F.G, cid);
        typedef pg8::EpiStore<D, 0> ET; ET E{y}; pg8::gemm_phase<ET, pg8::StaticOrder, GT, true, true>(F.lds + RING_OFF, g, S, E); break; }
    case S_ROWA: rowpass_phase(F, l, 1); break;
    case S_WIN: {
        typedef pg8::GemmT<D, D, D, 0, 0> GT; GT g{u, wb + W_IN}; pg8::StaticOrder S; S.init(M, PW, F.G, cid);
        typedef pg8::EpiStore<PW, 1> ET; ET E{proj}; pg8::gemm_phase<ET, pg8::StaticOrder, GT, true, true>(F.lds + RING_OFF, g, S, E); break; }
    case S_DFIN: dfin_phase(F, l); break;
    case S_GLU: {
        typedef pg8::GemmT<PW, 512, 512, 0, 0> GT; GT g{proj + C_YS5PRE, wb + W_GLU}; pg8::StaticOrder S; S.init(M, 1024, F.G, cid);
        pg8::EpiGLU E{proj, F.in[F.z + 26] + l * 1024}; pg8::gemm_phase<pg8::EpiGLU, pg8::StaticOrder, GT, true, true>(F.lds + RING_OFF, g, S, E); break; }
    case S_BRANCH: {
        typedef pg8::GemmT<PW, 512, 512, 512 * 2, 1024 * 512 * 2> GT; GT g{proj + C_YGLA, wb + W_BR}; pg8::StaticOrder S; S.init(M, D, F.G, cid, 3);
        pg8::EpiBranch E{proj}; pg8::gemm_phase<pg8::EpiBranch, pg8::StaticOrder, GT, true, true>(F.lds + RING_OFF, g, S, E); break; }
    case S_WOUT: {
        typedef pg8::GemmT<PW, D, D, 0, 0> GT; GT g{proj + C_MERGED, wb + W_OUT}; pg8::StaticOrder S; S.init(M, D, F.G, cid);
        typedef pg8::EpiStore<D, 0> ET; ET E{y}; pg8::gemm_phase<ET, pg8::StaticOrder, GT, true, true>(F.lds + RING_OFF, g, S, E); break; }
    case S_ROWB: rowpass_phase(F, l, 2); break;
    case S_ROWC: rowpass_phase(F, l, 3); if (l + 1 < DEPTH) convert_layer(F, l + 1); break;
    case S_GLA: gla_naive_phase(F, l); break;
    case S_S5: s5_naive_phase(F, l); break;
    case S_ATTN: { const attn_body::StaticOrder S(F.G, F.vcu); attn_body::attn_phase<attn_body::StaticOrder>(F.ldsg + RING_OFF, (const attn_body::bf16*)proj, F.in[F.z + 2], S); break; }
    default: break;
    }
}

__device__ __forceinline__ const void* opaque_sptr(const void* p) {
    unsigned lo = (unsigned)(uintptr_t)p, hi = (unsigned)((uintptr_t)p >> 32); asm volatile("" : "+s"(lo), "+s"(hi)); return (const void*)(((uintptr_t)hi << 32) | lo);
}
__device__ __forceinline__ const void* opaque_ptr(const void* p) {
    unsigned lo = (unsigned)(uintptr_t)p, hi = (unsigned)((uintptr_t)p >> 32); asm volatile("" : "+v"(lo), "+v"(hi));
    lo = __builtin_amdgcn_readfirstlane(lo); hi = __builtin_amdgcn_readfirstlane(hi); return (const void*)(((uintptr_t)hi << 32) | lo);
}
__global__ void __launch_bounds__(NWAVES * 64, 2) mk_fwd(Args args) {
    extern __shared__ __attribute__((aligned(16))) unsigned char lds[];
    Frame F;
    F.lds = (LAS unsigned char*)lds; F.ldsg = (char*)lds;
    F.tid = threadIdx.x; F.lane = F.tid & 63; F.wave = __builtin_amdgcn_readfirstlane(F.tid >> 6);
    F.G = gridDim.x; int vcu0; { const int bx = blockIdx.x; vcu0 = (F.G % 8 == 0) ? (bx % 8) * (F.G / 8) + bx / 8 : bx; } F.vcu = vcu0; F.cid = blockIdx.x; F.z = 0;
    F.in = args.in; F.out = args.out; F.ws = args.ws;
    for (int u = F.tid; u < (LDS_BYTES - LDSCTL_OFF) / 4; u += NWAVES * 64) ((LAS unsigned*)(F.lds + LDSCTL_OFF))[u] = 0u;
    __syncthreads();
    XcdBarrier bar; bar.bar = (unsigned*)(args.ws + WS_CTL) + CW_BAR; bar.x = 0; bar.st = nullptr;
    const bool multi = (args.ph_hi - args.ph_lo) > 1;
    if (multi) bar = xcd_barrier_post((unsigned*)(args.ws + WS_CTL) + CW_BAR, (volatile LAS unsigned*)(F.lds + MISC_OFF) + 8);
    for (int ph = args.ph_lo; ph < args.ph_hi; ++ph) {
        int t_ = threadIdx.x; asm volatile("" : "+v"(t_));
        F.tid = t_; F.lane = t_ & 63; F.wave = __builtin_amdgcn_readfirstlane(t_ >> 6);
        { int z_ = 0, v_ = vcu0, g_ = (int)gridDim.x, c_ = (int)blockIdx.x; asm volatile("" : "+s"(z_), "+s"(v_), "+s"(g_), "+s"(c_));
          F.z = z_; F.vcu = v_; F.G = g_; F.cid = c_;
          F.ws = (unsigned char*)opaque_sptr(args.ws); F.out = (float*)opaque_sptr(args.out); }
        run_phase(F, ph);
        if (ph + 1 < args.ph_hi) { XcdBarrier b2 = bar; b2.bar = (unsigned*)opaque_sptr(bar.bar); { unsigned x_ = bar.x; asm volatile("" : "+s"(x_)); b2.x = x_; } xcd_barrier(b2); }
    }
}

extern "C" void kernel_launch(void* const* d_in, const int* in_sizes, int n_in, void* d_out, int out_size, void* d_ws, size_t ws_size, hipStream_t stream) {
    static int grid = 0;
    if (grid == 0) {
        if (n_in != 29 || in_sizes[0] != M * D || out_size != M * D || ws_size < WS_END) {
            fprintf(stderr, "kernel_launch: unexpected shapes/workspace: n_in %d in0 %d out %d ws %zu (need %zu)\n", n_in, n_in > 0 ? in_sizes[0] : -1, out_size, ws_size, (size_t)WS_END); grid = -1; return; }
        int dev = 0, cus = 0;
        if (hipGetDevice(&dev) != hipSuccess || hipDeviceGetAttribute(&cus, hipDeviceAttributeMultiprocessorCount, dev) != hipSuccess) { grid = -1; return; }
        if (hipFuncSetAttribute((const void*)mk_fwd, hipFuncAttributeMaxDynamicSharedMemorySize, LDS_BYTES) != hipSuccess) { fprintf(stderr, "kernel_launch: hipFuncSetAttribute failed\n"); grid = -1; return; }
        grid = cus;
    }
    if (grid < 0) return;
    Args a{};
    for (int i = 0; i < 29; ++i) a.in[i] = (const float*)d_in[i];
    a.out = (float*)d_out; a.ws = (unsigned char*)d_ws;
    if (hipMemsetAsync((char*)d_ws + WS_CTL, 0, CTL_ZERO_BYTES, stream) != hipSuccess) { fprintf(stderr, "kernel_launch: memset failed\n"); return; }
    a.ph_lo = 0; a.ph_hi = N_PHASES;
    hipLaunchKernelGGL(mk_fwd, dim3(grid), dim3(NWAVES * 64), LDS_BYTES, stream, a);
}
```

```cpp
#include <hip/hip_runtime.h>
#include <cstdio>
#include <cstdint>
#include <cmath>

constexpr int D = 1024, BATCH = 8, SEQ = 2048, DEPTH = 2, M = BATCH * SEQ;
constexpr int DFF = 2816, INW = 6672, PW = 6912;
constexpr int ADA = 9 * D;
constexpr float EPS = 1e-6f;
constexpr float LOG2E = 1.4426950408889634f;
constexpr float QSCALE = 0.125f * LOG2E;
constexpr int C_GV = 0, C_DQ = 512, C_DK = 1024, C_DV = 1536, C_GQ = 2048, C_GK = 2304, C_GR = 2560, C_SU = 3072, C_GATE = 3584, C_GA = 6656;
constexpr int C_O = C_GQ;
constexpr int C_YGLA = C_GV, C_YDIFF = C_DQ, C_YS5 = C_DK, C_YS5PRE = C_SU, C_MERGED = C_GQ;

typedef unsigned short bf16_t;
typedef short bf16x8 __attribute__((ext_vector_type(8)));
typedef float f32x4 __attribute__((ext_vector_type(4)));
typedef unsigned u32x4 __attribute__((ext_vector_type(4)));
__device__ __forceinline__ float bf2f(bf16_t v) { return __uint_as_float(((unsigned)v) << 16); }
__device__ __forceinline__ bf16_t f2bf(float f) { unsigned u = __float_as_uint(f); return (bf16_t)((u + 0x7fffu + ((u >> 16) & 1u)) >> 16); }
__device__ __forceinline__ unsigned pk2(float lo, float hi) { return (unsigned)f2bf(lo) | ((unsigned)f2bf(hi) << 16); }
__device__ __forceinline__ float blo(unsigned w) { return __uint_as_float(w << 16); }
__device__ __forceinline__ float bhi(unsigned w) { return __uint_as_float(w & 0xffff0000u); }
__device__ __forceinline__ float sigmoidf_(float x) { return 1.f / (1.f + __expf(-x)); }
__device__ __forceinline__ float siluf_(float x) { return x / (1.f + __expf(-x)); }
template <int MSK> __device__ __forceinline__ float swz_xor(float v) { return __int_as_float(__builtin_amdgcn_ds_swizzle(__float_as_int(v), 0x1F | (MSK << 10))); }
__device__ __forceinline__ float xor32_sum(float v) { auto rr = __builtin_amdgcn_permlane32_swap(__float_as_uint(v), __float_as_uint(v), false, false); return __uint_as_float(rr[0]) + __uint_as_float(rr[1]); }
__device__ __forceinline__ float wave_sum(float v) {
    v += swz_xor<1>(v); v += swz_xor<2>(v); v += swz_xor<4>(v); v += swz_xor<8>(v); v += swz_xor<16>(v);
    return xor32_sum(v);
}
__device__ __forceinline__ int ref2my(int c) {
    if (c < 256) return C_GQ + c;
    if (c < 512) return C_GK + (c - 256);
    if (c < 1024) return C_GV + (c - 512);
    if (c < 1536) return C_GR + (c - 1024);
    if (c < 1552) return C_GA + (c - 1536);
    if (c < 2064) return C_DQ + (c - 1552);
    if (c < 2576) return C_DK + (c - 2064);
    if (c < 3088) return C_DV + (c - 2576);
    if (c < 3600) return C_SU + (c - 3088);
    return C_GATE + (c - 3600);
}
__device__ __forceinline__ int my2ref(int c) {
    if (c < C_DQ) return 512 + c;
    if (c < C_DK) return 1552 + (c - C_DQ);
    if (c < C_DV) return 2064 + (c - C_DK);
    if (c < C_GQ) return 2576 + (c - C_DV);
    if (c < C_GK) return c - C_GQ;
    if (c < C_GR) return 256 + (c - C_GK);
    if (c < C_SU) return 1024 + (c - C_GR);
    if (c < C_GATE) return 3088 + (c - C_SU);
    if (c < C_GA) return 3600 + (c - C_GATE);
    if (c < C_GA + 16) return 1536 + (c - C_GA);
    return -1;
}
__device__ const unsigned char T5B[128] = {0, 1, 2, 3, 4, 5, 6, 7, 8, 9, 10, 11, 12, 13, 14, 15, 16, 16, 16, 17, 17, 18, 18, 18, 19, 19, 19, 20, 20, 20, 20, 21, 21, 21, 21, 22, 22, 22, 22, 22, 23, 23, 23, 23, 23, 23, 24, 24, 24, 24, 24, 24, 25, 25, 25, 25, 25, 25, 25, 26, 26, 26, 26, 26, 26, 26, 26, 27, 27, 27, 27, 27, 27, 27, 27, 27, 27, 28, 28, 28, 28, 28, 28, 28, 28, 28, 28, 29, 29, 29, 29, 29, 29, 29, 29, 29, 29, 29, 29, 30, 30, 30, 30, 30, 30, 30, 30, 30, 30, 30, 30, 30, 30, 31, 31, 31, 31, 31, 31, 31, 31, 31, 31, 31, 31, 31, 31, 31};

constexpr size_t MiB = 1u << 20;
constexpr size_t WS_CTL = 0, CTL_ZERO_BYTES = 1 * MiB, WS_ADA = 1 * MiB, WS_S5ST = 2 * MiB, WS_W = 6 * MiB, WS_U = 59 * MiB, WS_GLA = 91 * MiB, WS_R0 = 123 * MiB, WS_END = 339 * MiB;
constexpr size_t WS_Y = WS_GLA;
constexpr size_t W_UP1 = 0, W_DN1 = W_UP1 + (size_t)2 * DFF * D, W_UP2 = W_DN1 + (size_t)D * DFF, W_DN2 = W_UP2 + (size_t)2 * DFF * D, W_IN = W_DN2 + (size_t)D * DFF,
                 W_GLU = W_IN + (size_t)PW * D, W_BR = W_GLU + (size_t)1024 * 512, W_OUT = W_BR + (size_t)3 * 1024 * 512, W_END = W_OUT + (size_t)D * D;
static_assert(W_END * 2 <= 53 * MiB, "weights fit");

__device__ __forceinline__ void rowpass_row(int row, int lane, const float* h_in, float* h_out, const bf16_t* y, const float* gpost, const float* gate, float coef,
                                            const float* gpre, const float* shift, const float* scale, bf16_t* u) {
    const int b = row / SEQ;
    f32x4 hv[4];
#pragma unroll
    for (int j = 0; j < 4; ++j) hv[j] = *(const f32x4*)(h_in + (size_t)row * D + j * 256 + lane * 4);
    if (y) {
        float yv[4][4]; float ss = 0.f;
#pragma unroll
        for (int j = 0; j < 4; ++j) {
            const uint2 raw = *(const uint2*)(y + (size_t)row * D + j * 256 + lane * 4);
            yv[j][0] = blo(raw.x); yv[j][1] = bhi(raw.x); yv[j][2] = blo(raw.y); yv[j][3] = bhi(raw.y);
#pragma unroll
            for (int i = 0; i < 4; ++i) ss += yv[j][i] * yv[j][i];
        }
        const float r = rsqrtf(wave_sum(ss) * (1.f / D) + EPS);
#pragma unroll
        for (int j = 0; j < 4; ++j) {
            const int c0 = j * 256 + lane * 4;
            const f32x4 gp = *(const f32x4*)(gpost + c0), gt = *(const f32x4*)(gate + (size_t)b * ADA + c0);
#pragma unroll
            for (int i = 0; i < 4; ++i) hv[j][i] += coef * gt[i] * (yv[j][i] * r * gp[i]);
        }
    }
    if (y || h_in != h_out) {
#pragma unroll
        for (int j = 0; j < 4; ++j) *(f32x4*)(h_out + (size_t)row * D + j * 256 + lane * 4) = hv[j];
    }
    if (u) {
        float ss = 0.f;
#pragma unroll
        for (int j = 0; j < 4; ++j)
#pragma unroll
            for (int i = 0; i < 4; ++i) ss += hv[j][i] * hv[j][i];
        const float r = rsqrtf(wave_sum(ss) * (1.f / D) + EPS);
#pragma unroll
        for (int j = 0; j < 4; ++j) {
            const int c0 = j * 256 + lane * 4;
            const f32x4 g = *(const f32x4*)(gpre + c0), sh = *(const f32x4*)(shift + (size_t)b * ADA + c0), sc = *(const f32x4*)(scale + (size_t)b * ADA + c0);
            float o[4];
#pragma unroll
            for (int i = 0; i < 4; ++i) o[i] = hv[j][i] * r * g[i] * (1.f + sc[i]) + sh[i];
            uint2 w; w.x = pk2(o[0], o[1]); w.y = pk2(o[2], o[3]);
            *(uint2*)(u + (size_t)row * D + c0) = w;
        }
    }
}

__device__ __forceinline__ void diff_fin_row(bf16_t* r, int lane, float lam, const float* norm_g, float lam_init) {
#pragma unroll
    for (int h = 0; h < 4; ++h) {
        const unsigned a = *(const unsigned*)(r + C_O + (2 * h) * 128 + lane * 2), c = *(const unsigned*)(r + C_O + (2 * h + 1) * 128 + lane * 2);
        const float o0 = blo(a) - lam * blo(c), o1 = bhi(a) - lam * bhi(c);
        const float rs = rsqrtf(wave_sum(o0 * o0 + o1 * o1) * (1.f / 128.f) + EPS) * (1.f - lam_init);
        const float g0 = norm_g[h * 128 + lane * 2], g1 = norm_g[h * 128 + lane * 2 + 1];
        *(unsigned*)(r + C_YDIFF + h * 128 + lane * 2) = pk2(o0 * rs * g0, o1 * rs * g1);
    }
}

namespace pg8 {
#define PG8_LAS __attribute__((address_space(3)))
constexpr int BM = 256, BK = 64, HALF = 128, HTB = HALF * BK * 2  , STAGE_BYTES = 8 * HTB, NXCD = 8, WGM = 8;

__host__ __device__ __forceinline__ int lds_byte(int r, int c) { const int st = (r >> 4) * 2 + (c >> 5), rr = r & 15, cc = c & 31, ob = rr * 64 + cc * 2; return st * 1024 + (ob ^ (((ob >> 9) & 1) << 5)); }
__host__ __device__ __forceinline__ void stage_rc(int b, int& R, int& C) { const int st = b / 1024, sb = b % 1024, swz = sb ^ (((sb >> 9) & 1) << 5); R = (st >> 1) * 16 + swz / 64; C = (st & 1) * 32 + (swz % 64) / 2; }
__host__ __device__ __forceinline__ int perm32(int rho) { const int n = rho >> 4, i = rho & 15; return 8 * (i >> 2) + 4 * n + (i & 3); }

struct Unit { int pm, pn, z; };
template <int LDA, int LDB, int KK, int ZA, int ZB> struct GemmT { const bf16_t* A; const bf16_t* Bt; static constexpr int lda = LDA, ldb = LDB, K = KK; static constexpr size_t zA = ZA, zB = ZB; };

struct StaticOrder {
    int nM, nN, nwg, G, c, nZ;
    __host__ __device__ void init(int M_, int N_, int G_, int c_, int nZ_ = 1) { nM = M_ / BM; nN = N_ / BM; nwg = nM * nN; G = G_; c = c_; nZ = nZ_; }
    __host__ __device__ bool next(int i, Unit& u) const {
        const long L = (long)(i / nZ) * G + c; if (L >= nwg) return false;
        int wgid = (int)L; { const int q = nwg / NXCD, r = nwg % NXCD, xcd = wgid % NXCD, off = wgid / NXCD; wgid = (xcd < r ? xcd * (q + 1) : r * (q + 1) + (xcd - r) * q) + off; }
        const int nig = WGM * nN, gid = wgid / nig, fm = gid * WGM, gsz = (nM - fm) < WGM ? (nM - fm) : WGM;
        u.pm = fm + ((wgid % nig) % gsz); u.pn = (wgid % nig) / gsz; u.z = i % nZ; return true;
    }
    __device__ __forceinline__ void a_ready(const Unit&) const {}
    __device__ __forceinline__ void done(const Unit&) const {}
};
__device__ __forceinline__ unsigned cvt_pk_bf16(float lo, float hi) { unsigned r; asm volatile("v_cvt_pk_bf16_f32 %0, %1, %2" : "=v"(r) : "v"(lo), "v"(hi)); return r; }

__device__ __forceinline__ u32x4 pack8(const f32x4 v0, const f32x4 v1) { u32x4 w; w.x = cvt_pk_bf16(v0[0], v0[1]); w.y = cvt_pk_bf16(v0[2], v0[3]); w.z = cvt_pk_bf16(v1[0], v1[1]); w.w = cvt_pk_bf16(v1[2], v1[3]); return w; }
__device__ __forceinline__ float fsig(float x) { return __builtin_amdgcn_rcpf(1.f + __expf(-x)); }
template <int ldc, int mode> struct EpiStore {
    static constexpr bool PERM = true, AFTER_DRAIN = false;
    bf16_t* O;
    __device__ __forceinline__ void operator()(const f32x4 (&acc)[2][2][4][2], const Unit& u, int wr, int wc, int fr, int fq) const {
        float sc = 1.f; if (mode == 1) { if (u.pn == 2 || u.pn == 3) sc = QSCALE; else if (u.pn == 8) sc = 0.125f; }
        const int row0 = u.pm * BM + wr * 64 + fr, col0 = u.pn * BM + wc * 32 + 8 * fq;
#pragma unroll
        for (int ai = 0; ai < 2; ++ai)
#pragma unroll
            for (int m = 0; m < 4; ++m) { bf16_t* rowp = O + (size_t)(row0 + ai * HALF + m * 16) * ldc + col0;
#pragma unroll
                for (int bj = 0; bj < 2; ++bj) *(u32x4*)(rowp + bj * HALF) = pack8(acc[ai][bj][m][0] * sc, acc[ai][bj][m][1] * sc); }
    }
};
struct EpiSwiGLU {
    static constexpr bool PERM = true, AFTER_DRAIN = false;
    bf16_t* H;
    __device__ __forceinline__ void operator()(const f32x4 (&acc)[2][2][4][2], const Unit& u, int wr, int wc, int fr, int fq) const {
        const int row0 = u.pm * BM + wr * 64 + fr, col0 = u.pn * HALF + wc * 32 + 8 * fq;
#pragma unroll
        for (int ai = 0; ai < 2; ++ai)
#pragma unroll
            for (int m = 0; m < 4; ++m) { f32x4 o[2];
#pragma unroll
                for (int n = 0; n < 2; ++n)
#pragma unroll
                    for (int j = 0; j < 4; ++j) { const float g = acc[ai][0][m][n][j]; o[n][j] = g * fsig(g) * acc[ai][1][m][n][j]; }
                *(u32x4*)(H + (size_t)(row0 + ai * HALF + m * 16) * DFF + col0) = pack8(o[0], o[1]); }
    }
};
struct EpiGLU {
    static constexpr bool PERM = true, AFTER_DRAIN = false;
    bf16_t* P; const float* bias;
    __device__ __forceinline__ void operator()(const f32x4 (&acc)[2][2][4][2], const Unit& u, int wr, int wc, int fr, int fq) const {
        const int row0 = u.pm * BM + wr * 64 + fr, col0 = u.pn * HALF + wc * 32 + 8 * fq;
        f32x4 bv[2], bg[2];
#pragma unroll
        for (int n = 0; n < 2; ++n) { bv[n] = *(const f32x4*)(bias + col0 + 4 * n); bg[n] = *(const f32x4*)(bias + 512 + col0 + 4 * n); }
#pragma unroll
        for (int ai = 0; ai < 2; ++ai)
#pragma unroll
            for (int m = 0; m < 4; ++m) { f32x4 o[2];
#pragma unroll
                for (int n = 0; n < 2; ++n)
#pragma unroll
                    for (int j = 0; j < 4; ++j) o[n][j] = (acc[ai][0][m][n][j] + bv[n][j]) * fsig(acc[ai][1][m][n][j] + bg[n][j]);
                *(u32x4*)(P + (size_t)(row0 + ai * HALF + m * 16) * PW + C_YS5 + col0) = pack8(o[0], o[1]); }
    }
};
struct EpiBranch {
    static constexpr bool PERM = true, AFTER_DRAIN = false;
    bf16_t* P;
    __device__ __forceinline__ void operator()(const f32x4 (&acc)[2][2][4][2], const Unit& u, int wr, int wc, int fr, int fq) const {
        const int row0 = u.pm * BM + wr * 64 + fr, col0 = u.pn * BM + wc * 32 + 8 * fq;
#pragma unroll
        for (int ai = 0; ai < 2; ++ai)
#pragma unroll
            for (int m = 0; m < 4; ++m) { bf16_t* rowp = P + (size_t)(row0 + ai * HALF + m * 16) * PW;
#pragma unroll
                for (int bj = 0; bj < 2; ++bj) { const int col = col0 + bj * HALF;
                    const u32x4 gw = *(const u32x4*)(rowp + C_GATE + u.z * D + col);
                    u32x4 pw = (u32x4){0u, 0u, 0u, 0u}; if (u.z > 0) pw = *(const u32x4*)(rowp + C_MERGED + col);
                    f32x4 o[2];
#pragma unroll
                    for (int n = 0; n < 2; ++n) { const unsigned g0 = gw[2 * n], g1 = gw[2 * n + 1], p0 = pw[2 * n], p1 = pw[2 * n + 1];
                        o[n][0] = blo(p0) + fsig(blo(g0)) * acc[ai][bj][m][n][0]; o[n][1] = bhi(p0) + fsig(bhi(g0)) * acc[ai][bj][m][n][1];
                        o[n][2] = blo(p1) + fsig(blo(g1)) * acc[ai][bj][m][n][2]; o[n][3] = bhi(p1) + fsig(bhi(g1)) * acc[ai][bj][m][n][3]; }
                    *(u32x4*)(rowp + C_MERGED + col) = pack8(o[0], o[1]); } }
    }
};

template <class Epi, class Sched, class GemmX, bool ALIGN_EPI = false, bool SP2 = false>
__device__ __forceinline__ void gemm_phase(PG8_LAS unsigned char* lds, const GemmX g, const Sched& S, const Epi& E) {
    int tid_ = threadIdx.x; asm volatile("" : "+v"(tid_));
    const int tid = tid_, wid = __builtin_amdgcn_readfirstlane(tid >> 6), lane = tid & 63, wr = wid >> 2, wc = wid & 3, fr = lane & 15, fq = lane >> 4;
    const int K = g.K, nt = K / BK;
    unsigned voffA[2], voffB[2];
#pragma unroll
    for (int i = 0; i < 2; ++i) { int R, C; stage_rc(tid * 16 + i * 8192, R, C); const int Rb = Epi::PERM ? ((R & ~31) + perm32(R & 31)) : R;
        voffA[i] = (unsigned)(R * g.lda + C) * 2u; voffB[i] = (unsigned)(Rb * g.ldb + C) * 2u; }
    const size_t kstep = (size_t)(BK * 2);
    const size_t hstepA = (size_t)HALF * g.lda * 2, hstepB = (size_t)HALF * g.ldb * 2;
    const size_t tstepA = 2 * hstepA, tstepB = 2 * hstepB;
    const unsigned ldsw = (unsigned)wid * 1024u;
    const int aoff = lds_byte(wr * 64 + fr, fq * 8), boff = lds_byte(wc * 32 + fr, fq * 8);
#define PG8_SA(b, h) (((b) * 2 + (h)) * HTB)
#define PG8_SB(b, h) ((4 + (b) * 2 + (h)) * HTB)
#define PG8_STAGE(bufoff, gbase, voff) do { _Pragma("unroll") for (int _i = 0; _i < 2; ++_i) \
        __builtin_amdgcn_global_load_lds((const unsigned*)((const char*)(gbase) + (voff)[_i]), (PG8_LAS unsigned*)(lds + (bufoff) + ldsw + _i * 8192), 16, 0, 0); } while (0)
#define PG8_LDA(dst, b, h) do { _Pragma("unroll") for (int m = 0; m < 4; ++m) _Pragma("unroll") for (int k = 0; k < 2; ++k) dst[m][k] = *(const PG8_LAS bf16x8*)(lds + PG8_SA(b, h) + aoff + m * 2048 + k * 1024); } while (0)
#define PG8_LDB(dst, b, h) do { _Pragma("unroll") for (int n = 0; n < 2; ++n) _Pragma("unroll") for (int k = 0; k < 2; ++k) dst[n][k] = *(const PG8_LAS bf16x8*)(lds + PG8_SB(b, h) + boff + n * 2048 + k * 1024); } while (0)
#define PG8_MMA(ai, bj, At, Bt) do { __builtin_amdgcn_s_setprio(1); _Pragma("unroll") for (int m = 0; m < 4; ++m) _Pragma("unroll") for (int n = 0; n < 2; ++n) _Pragma("unroll") for (int k = 0; k < 2; ++k) \
        acc[ai][bj][m][n] = __builtin_amdgcn_mfma_f32_16x16x32_bf16(Bt[n][k], At[m][k], acc[ai][bj][m][n], 0, 0, 0); __builtin_amdgcn_s_setprio(0); } while (0)
#define PG8_WAIT_V(n) asm volatile("s_waitcnt vmcnt(" #n ")" ::: "memory")
#define PG8_WAIT_L(n) asm volatile("s_waitcnt lgkmcnt(" #n ")" ::: "memory")
#define PG8_BAR __builtin_amdgcn_s_barrier()
#define PG8_SCHED __builtin_amdgcn_sched_barrier(0)
    Unit cur, nxt; int ui = 0;
    if (!S.next(0, cur)) return;
    f32x4 acc[2][2][4][2];
#pragma unroll
    for (int a = 0; a < 2; ++a)
#pragma unroll
        for (int b = 0; b < 2; ++b)
#pragma unroll
            for (int m = 0; m < 4; ++m)
#pragma unroll
                for (int n = 0; n < 2; ++n) acc[a][b][m][n] = (f32x4){0.f, 0.f, 0.f, 0.f};
    bf16x8 At[4][2], B0[2][2], B1[2][2];
    const char* cA = (const char*)g.A + (size_t)cur.pm * tstepA + (size_t)cur.z * g.zA; const char* cB = (const char*)g.Bt + (size_t)cur.pn * tstepB + (size_t)cur.z * g.zB;
    S.a_ready(cur);
    if constexpr (SP2) {
        PG8_STAGE(PG8_SB(0, 0), cB, voffB); PG8_STAGE(PG8_SB(0, 1), cB + hstepB, voffB); PG8_STAGE(PG8_SA(0, 0), cA, voffA); PG8_STAGE(PG8_SA(0, 1), cA + hstepA, voffA);
        if (wr == 1) PG8_BAR;
        PG8_WAIT_V(2); PG8_BAR;
        PG8_STAGE(PG8_SB(1, 0), cB + kstep, voffB); PG8_STAGE(PG8_SA(1, 0), cA + kstep, voffA); PG8_STAGE(PG8_SB(1, 1), cB + hstepB + kstep, voffB);
        PG8_WAIT_V(6); PG8_BAR;
    } else {
        PG8_STAGE(PG8_SB(0, 0), cB, voffB); PG8_STAGE(PG8_SA(0, 0), cA, voffA); PG8_STAGE(PG8_SB(0, 1), cB + hstepB, voffB); PG8_STAGE(PG8_SA(0, 1), cA + hstepA, voffA);
        if (wr == 1) PG8_BAR;
        PG8_WAIT_V(4); PG8_BAR;
        PG8_STAGE(PG8_SB(1, 0), cB + kstep, voffB); PG8_STAGE(PG8_SA(1, 0), cA + kstep, voffA); PG8_STAGE(PG8_SB(1, 1), cB + hstepB + kstep, voffB);
        PG8_WAIT_V(6); PG8_BAR;
    }
    for (;;) {
        const bool has_next = S.next(ui + 1, nxt);
        const char* nA = has_next ? (const char*)g.A + (size_t)nxt.pm * tstepA + (size_t)nxt.z * g.zA : cA; const char* nB = has_next ? (const char*)g.Bt + (size_t)nxt.pn * tstepB + (size_t)nxt.z * g.zB : cB;
        for (int t = 0; t < nt; t += 2) {
            const bool last = (t == nt - 2);
            const char* a1 = cA + (size_t)(t + 1) * kstep;
            const char* a2 = last ? nA : cA + (size_t)(t + 2) * kstep; const char* b2 = last ? nB : cB + (size_t)(t + 2) * kstep;
            const char* a3 = a2 + kstep; const char* b3 = b2 + kstep;
            if (last && has_next) S.a_ready(nxt);
            if constexpr (SP2) {
            PG8_LDB(B0, 0, 0); PG8_LDB(B1, 0, 1); PG8_SCHED; PG8_LDA(At, 0, 0); PG8_STAGE(PG8_SA(1, 1), a1 + hstepA, voffA);
            PG8_WAIT_V(8); PG8_WAIT_L(0); PG8_BAR; PG8_MMA(0, 0, At, B0); PG8_MMA(0, 1, At, B1); PG8_BAR; PG8_SCHED;
            PG8_LDA(At, 0, 1); PG8_STAGE(PG8_SB(0, 0), b2, voffB); PG8_STAGE(PG8_SB(0, 1), b2 + hstepB, voffB); PG8_STAGE(PG8_SA(0, 0), a2, voffA);
            PG8_WAIT_V(8); PG8_WAIT_L(0); PG8_BAR; PG8_MMA(1, 0, At, B0); PG8_MMA(1, 1, At, B1); PG8_BAR; PG8_SCHED;
            PG8_LDB(B0, 1, 0); PG8_LDB(B1, 1, 1); PG8_SCHED; PG8_LDA(At, 1, 0); PG8_STAGE(PG8_SA(0, 1), a2 + hstepA, voffA);
            PG8_WAIT_V(8); PG8_WAIT_L(0); PG8_BAR; PG8_MMA(0, 0, At, B0); PG8_MMA(0, 1, At, B1); PG8_BAR; PG8_SCHED;
            PG8_LDA(At, 1, 1); PG8_STAGE(PG8_SB(1, 0), b3, voffB); PG8_STAGE(PG8_SB(1, 1), b3 + hstepB, voffB); PG8_STAGE(PG8_SA(1, 0), a3, voffA);
            PG8_WAIT_V(8); PG8_WAIT_L(0); PG8_BAR; PG8_MMA(1, 0, At, B0); PG8_MMA(1, 1, At, B1); PG8_BAR; PG8_SCHED;
            } else {
            PG8_LDB(B0, 0, 0); PG8_SCHED; PG8_LDA(At, 0, 0); PG8_STAGE(PG8_SA(1, 1), a1 + hstepA, voffA);
            PG8_WAIT_L(8); PG8_BAR; PG8_WAIT_L(0); PG8_MMA(0, 0, At, B0); PG8_BAR; PG8_SCHED;
            PG8_LDB(B1, 0, 1); PG8_STAGE(PG8_SB(0, 0), b2, voffB);
            PG8_BAR; PG8_WAIT_L(0); PG8_MMA(0, 1, At, B1); PG8_BAR;
            PG8_LDA(At, 0, 1); PG8_STAGE(PG8_SA(0, 0), a2, voffA);
            PG8_BAR; PG8_WAIT_L(0); PG8_MMA(1, 0, At, B0); PG8_BAR; PG8_SCHED;
            PG8_STAGE(PG8_SB(0, 1), b2 + hstepB, voffB);
            PG8_WAIT_V(6); PG8_BAR; PG8_MMA(1, 1, At, B1); PG8_BAR;
            PG8_LDB(B0, 1, 0); PG8_SCHED; PG8_LDA(At, 1, 0); PG8_STAGE(PG8_SA(0, 1), a2 + hstepA, voffA);
            PG8_WAIT_L(8); PG8_BAR; PG8_WAIT_L(0); PG8_MMA(0, 0, At, B0); PG8_BAR; PG8_SCHED;
            PG8_LDB(B1, 1, 1); PG8_STAGE(PG8_SB(1, 0), b3, voffB);
            PG8_BAR; PG8_WAIT_L(0); PG8_MMA(0, 1, At, B1); PG8_BAR;
            PG8_LDA(At, 1, 1); PG8_STAGE(PG8_SA(1, 0), a3, voffA);
            PG8_BAR; PG8_WAIT_L(0); PG8_MMA(1, 0, At, B0); PG8_BAR; PG8_SCHED;
            PG8_STAGE(PG8_SB(1, 1), b3 + hstepB, voffB);
            PG8_WAIT_V(6); PG8_BAR; PG8_MMA(1, 1, At, B1); PG8_BAR;
            }
        }
        if constexpr (ALIGN_EPI) { if (wr == 0) PG8_BAR; }
        if constexpr (!Epi::AFTER_DRAIN) { E(acc, cur, wr, wc, fr, fq); S.done(cur); }
        if (!has_next) break;
#pragma unroll
        for (int a = 0; a < 2; ++a)
#pragma unroll
            for (int b = 0; b < 2; ++b)
#pragma unroll
                for (int m = 0; m < 4; ++m)
#pragma unroll
                    for (int n = 0; n < 2; ++n) acc[a][b][m][n] = (f32x4){0.f, 0.f, 0.f, 0.f};
        cur = nxt; cA = nA; cB = nB; ++ui;
        if constexpr (ALIGN_EPI) { if (wr == 1) PG8_BAR; }
    }
    PG8_WAIT_V(0);
    if constexpr (!ALIGN_EPI) { if (wr == 0) PG8_BAR; }
    PG8_BAR;
    if constexpr (Epi::AFTER_DRAIN) { E.fused(acc, cur, wr, wc, fr, fq, lds, wid, lane); S.done(cur); }
#undef PG8_SA
#undef PG8_SB
#undef PG8_STAGE
#undef PG8_LDA
#undef PG8_LDB
#undef PG8_MMA
#undef PG8_WAIT_V
#undef PG8_WAIT_L
#undef PG8_BAR
#undef PG8_SCHED
}
}

namespace attn_body {
using bf16=unsigned short;
using bf16x8=__attribute__((ext_vector_type(8)))short;
using s16x4=__attribute__((ext_vector_type(4)))short;
using f32x16=__attribute__((ext_vector_type(16)))float;
using u32x4=__attribute__((ext_vector_type(4)))unsigned;
constexpr int NMAP=8,SEQ=2048,D=64,DM=::PW;
constexpr int NW=8,QBLK=32,QB=QBLK*NW,KVBLK=64,NQB=SEQ/QB;

__device__ __forceinline__ int crow(int r,int hi){return (r&3)+8*(r>>2)+4*hi;}
#define SBAR() __builtin_amdgcn_sched_barrier(0)
__device__ __forceinline__ void cmask(f32x16&p0,f32x16&p1,int jb,int qrel,int hi){
  const float NEG=-INFINITY; int kb=64*jb+4*hi;
  #pragma unroll
  for(int r=0;r<16;++r){int kv=kb+(r&3)+8*(r>>2); if(kv>qrel)p0[r]=NEG; if(kv+32>qrel)p1[r]=NEG;}
}

typedef __attribute__((address_space(3))) const float* lds_cfptr;
__device__ __forceinline__ void addbias(f32x16&p0,f32x16&p1,int jb,int qrel,int hi,lds_cfptr tab){
  const int base=qrel-64*jb-4*hi;
  #pragma unroll
  for(int r=0;r<16;++r){const int d0=base-((r&3)+8*(r>>2)); const int i0=d0<0?0:(d0>127?127:d0); const int d1=d0-32; const int i1=d1<0?0:(d1>127?127:d1); p0[r]+=tab[i0]; p1[r]+=tab[i1];}
}
constexpr int NSLOT=3, SLOTB=8192;
constexpr int LDS_K=0, LDS_V=NSLOT*SLOTB, LDS_WS=2*NSLOT*SLOTB, LDS_OST=LDS_WS+NW*64*4, LDS_TAB=LDS_OST+NW*4096, LDS_BYTES=LDS_TAB+512;
constexpr float C2=0.125f*1.4426950408889634f;
__device__ __forceinline__ void glds16(const void*gsrc,unsigned lds_dst){unsigned keep;
  asm volatile("s_mov_b32 %0, m0\n\ts_mov_b32 m0, %2\n\ts_nop 0\n\tglobal_load_lds_dwordx4 %1, off\n\ts_mov_b32 m0, %0":"=&s"(keep):"v"(gsrc),"s"(lds_dst):"memory");}
__device__ __forceinline__ float max3f(float a,float b,float c){float r;asm("v_max3_f32 %0, %1, %2, %3":"=v"(r):"v"(a),"v"(b),"v"(c));return r;}
__device__ __forceinline__ float max2f(float a,float b){float r;asm("v_max_f32_e32 %0, %1, %2":"=v"(r):"v"(a),"v"(b));return r;}
__device__ __forceinline__ float fadd_s(float a,float b){float r;asm("v_add_f32_e32 %0, %1, %2":"=v"(r):"v"(a),"v"(b));return r;}
__device__ __forceinline__ float fsub_s(float a,float b){float r;asm("v_sub_f32_e32 %0, %1, %2":"=v"(r):"v"(a),"v"(b));return r;}
typedef float f32x2_t __attribute__((ext_vector_type(2))); typedef __bf16 bf16x2_t __attribute__((ext_vector_type(2)));
__device__ __forceinline__ unsigned cvtpk_s(float lo,float hi){f32x2_t v={lo,hi};bf16x2_t b=__builtin_convertvector(v,bf16x2_t);return __builtin_bit_cast(unsigned,b);}
#define WAIT_BAR(N) asm volatile("s_waitcnt vmcnt(" #N ") lgkmcnt(0)\n\ts_barrier":::"memory")

__device__ __forceinline__ void qkt(f32x16&p0,f32x16&p1,const char*Kslot,const bf16x8*qr,const f32x16&negm,int r32,int hi){
  const char*kb=Kslot+hi*1024+r32*16;
  #pragma unroll
  for(int d0=0;d0<4;++d0){
    const bf16x8 b0=*reinterpret_cast<const bf16x8*>(kb+d0*2048);
    const bf16x8 b1=*reinterpret_cast<const bf16x8*>(kb+d0*2048+512);
    if(d0==0){p0=__builtin_amdgcn_mfma_f32_32x32x16_bf16(b0,qr[0],negm,0,0,0);p1=__builtin_amdgcn_mfma_f32_32x32x16_bf16(b1,qr[0],negm,0,0,0);}
    else{p0=__builtin_amdgcn_mfma_f32_32x32x16_bf16(b0,qr[d0],p0,0,0,0);p1=__builtin_amdgcn_mfma_f32_32x32x16_bf16(b1,qr[d0],p1,0,0,0);}}
}
typedef __attribute__((address_space(3))) const char* lds_cptr;
typedef short v4i16_t __attribute__((ext_vector_type(4)));
__device__ __forceinline__ void kload8(bf16x8*kf,lds_cptr kp){
  kf[0]=*(const __attribute__((address_space(3))) bf16x8*)(kp);      kf[1]=*(const __attribute__((address_space(3))) bf16x8*)(kp+512);
  kf[2]=*(const __attribute__((address_space(3))) bf16x8*)(kp+2048); kf[3]=*(const __attribute__((address_space(3))) bf16x8*)(kp+2560);
  kf[4]=*(const __attribute__((address_space(3))) bf16x8*)(kp+4096); kf[5]=*(const __attribute__((address_space(3))) bf16x8*)(kp+4608);
  kf[6]=*(const __attribute__((address_space(3))) bf16x8*)(kp+6144); kf[7]=*(const __attribute__((address_space(3))) bf16x8*)(kp+6656);
}
__device__ __forceinline__ void kload2(bf16x8*kf,lds_cptr kp,int j){ kf[2*j]=*(const __attribute__((address_space(3))) bf16x8*)(kp+j*2048); kf[2*j+1]=*(const __attribute__((address_space(3))) bf16x8*)(kp+j*2048+512); }
__device__ __forceinline__ s16x4 vtr(lds_cptr p){ return __builtin_bit_cast(s16x4,__builtin_amdgcn_ds_read_tr16_b64_v4i16((__attribute__((address_space(3))) v4i16_t*)p)); }
__device__ __forceinline__ float rowmax(const f32x16&p0,const f32x16&p1){
  float a=max3f(p0[0],p0[1],p1[0]),b=max3f(p0[2],p0[3],p1[1]);a=max3f(a,p1[2],p1[3]);
  #pragma unroll
  for(int r=4;r<16;r+=4){a=max3f(a,p0[r],p0[r+1]);b=max3f(b,p0[r+2],p0[r+3]);a=max3f(a,p1[r],p1[r+1]);b=max3f(b,p1[r+2],p1[r+3]);}
  const float m=max2f(a,b);
  auto rr=__builtin_amdgcn_permlane32_swap(__float_as_uint(m),__float_as_uint(m),false,false);
  return max2f(__uint_as_float(rr[0]),__uint_as_float(rr[1]));
}
__device__ __forceinline__ void pv(f32x16*o,int vb,bf16x8 pa0,bf16x8 pa1,bf16x8 pa2,bf16x8 pa3){
  #pragma unroll
  for(int d0=0;d0<2;++d0){s16x4 lo[4],hi[4];
    #pragma unroll
    for(int ks=0;ks<4;++ks){
      asm volatile("ds_read_b64_tr_b16 %0,%1 offset:%c2":"=&v"(lo[ks]):"v"(vb),"i"(d0*4096+ks*1024):"memory");
      asm volatile("ds_read_b64_tr_b16 %0,%1 offset:%c2":"=&v"(hi[ks]):"v"(vb),"i"(d0*4096+ks*1024+512):"memory");}
    asm volatile("s_waitcnt lgkmcnt(0)":::"memory");SBAR();
    #define PK(k) (bf16x8){lo[k][0],lo[k][1],lo[k][2],lo[k][3],hi[k][0],hi[k][1],hi[k][2],hi[k][3]}
    o[d0]=__builtin_amdgcn_mfma_f32_32x32x16_bf16(pa0,PK(0),o[d0],0,0,0);
    o[d0]=__builtin_amdgcn_mfma_f32_32x32x16_bf16(pa1,PK(1),o[d0],0,0,0);
    o[d0]=__builtin_amdgcn_mfma_f32_32x32x16_bf16(pa2,PK(2),o[d0],0,0,0);
    o[d0]=__builtin_amdgcn_mfma_f32_32x32x16_bf16(pa3,PK(3),o[d0],0,0,0);
    #undef PK
  }
}

#ifndef ATTN_STORE16
#define ATTN_STORE16(p,v) (*(u32x4*)(p)=(v))
#endif
template<int THRL> __device__ __forceinline__ void attn_unit(int b,int m,int vh,int qb,const bf16*P,const float*rel_bias,char*shm){
  const bf16*Q=P+::C_DQ+m*64; const bf16*K=P+::C_DK+m*64; const bf16*V=P+::C_DV+(m>>1)*128+vh*64; bf16*O=(bf16*)P+::C_O+m*128+vh*64;
  int tid_=threadIdx.x; asm volatile("":"+v"(tid_));
  const int tid=tid_,lane=tid&63,r32=lane&31,hi=lane>>5; const int wid=__builtin_amdgcn_readfirstlane(tid>>6);
  const long rowbase=(long)b*SEQ; const int q0=qb*QB;
  const bf16*Qw=Q+(rowbase+q0+wid*QBLK)*DM;
  const bf16*Kh=K+rowbase*DM,*Vh=V+rowbase*DM;
  const unsigned lds0=(unsigned)(uintptr_t)shm;
  float*wsf=(float*)(shm+LDS_WS)+wid*64;
  const bf16*ksrc=Kh+(long)lane*DM+wid*8;
  const bf16*vsrc=Vh+(long)(16*(wid&3)+(lane>>2))*DM+(wid>>2)*32+(lane&3)*8;
  const unsigned kdst=lds0+LDS_K+wid*1024, vdst=lds0+LDS_V+wid*1024;
  #define DMA_K(t,slot) glds16(ksrc+(long)(t)*KVBLK*DM,(unsigned)__builtin_amdgcn_readfirstlane(kdst+(slot)))
  #define DMA_V(t,slot) glds16(vsrc+(long)(t)*KVBLK*DM,(unsigned)__builtin_amdgcn_readfirstlane(vdst+(slot)))
  const int vb0=(int)(lds0+LDS_V)+((lane>>4)&1)*32+(lane&3)*8+(4*hi+((lane&15)>>2))*64;
  const char*Kbase=shm+LDS_K; bf16x8 kf[8];
  const lds_cptr shm3=(lds_cptr)shm; const lds_cptr kp0=shm3+LDS_K+hi*1024+r32*16; const lds_cptr vp0=shm3+LDS_V+((lane>>4)&1)*32+(lane&3)*8+(4*hi+((lane&15)>>2))*64;
  const int NT=(q0+QB)/KVBLK;
  { __attribute__((address_space(3))) float* tabw=(__attribute__((address_space(3))) float*)((lds_cptr)shm+LDS_TAB);
    if(tid<128){ const float bv=(rel_bias[(int)::T5B[tid]*8+m]-rel_bias[31*8+m])*1.4426950408889634f; tabw[tid]=bv; }
    asm volatile("s_waitcnt vmcnt(0) lgkmcnt(0)":::"memory"); }
  const lds_cfptr tab=(lds_cfptr)((lds_cptr)shm+LDS_TAB);
  DMA_K(0,0);DMA_V(0,0);DMA_K(1,SLOTB);
  bf16x8 qr[4];
  #pragma unroll
  for(int d0=0;d0<4;++d0)qr[d0]=*reinterpret_cast<const bf16x8*>(&Qw[(long)r32*DM+d0*16+hi*8]);
  float mhat=0.f,l_reg=0.f;f32x16 o[2];o[0]=f32x16{};o[1]=f32x16{};f32x16 negm=f32x16{};asm volatile("":"+v"(negm));
  const int qrel=wid*QBLK+r32;
  #define CMASK(P0,P1,t) do{int jb_=(t)-(NT-4); if(jb_>=-2)addbias(P0,P1,jb_,qrel,hi,tab); if(jb_>=0)cmask(P0,P1,jb_,qrel,hi);}while(0)
  bool resc=false;
  #define START(P0,P1) do{ const float rm=rowmax(P0,P1); resc=false; \
    { const float dl=rm; mhat=fadd_s(mhat,dl); \
      _Pragma("unroll") for(int r=0;r<16;++r){P0[r]=fsub_s(P0[r],dl);P1[r]=fsub_s(P1[r],dl);} \
      _Pragma("unroll") for(int r=0;r<16;++r)negm[r]=-mhat; asm volatile("":"+v"(negm)); } \
    _Pragma("unroll") for(int r=0;r<16;++r)P0[r]=__builtin_amdgcn_exp2f(P0[r]); }while(0)
  #define RESC() do{ if(resc){ asm volatile("s_waitcnt lgkmcnt(0)":::"memory"); \
      _Pragma("unroll") for(int d_=0;d_<2;++d_) _Pragma("unroll") for(int r=0;r<16;++r)o[d_][r]*=wsf[crow(r,hi)]; } }while(0)
  f32x16 pA0,pA1,pB0,pB1;
  int sl_prev=0,sl_cur=0,sl_next=SLOTB;
  #define ROT() do{sl_prev=sl_cur;sl_cur=sl_next;sl_next=(sl_next==(NSLOT-1)*SLOTB)?0:sl_next+SLOTB;}while(0)
  DMA_K(2,2*SLOTB);
  WAIT_BAR(3);
  qkt(pA0,pA1,Kbase,qr,negm,r32,hi);asm volatile("s_nop 15\n\ts_nop 7":"+v"(pA0),"+v"(pA1));CMASK(pA0,pA1,0);
  START(pA0,pA1);
  _Pragma("unroll") for(int r=0;r<16;++r)pA1[r]=__builtin_amdgcn_exp2f(pA1[r]);
  WAIT_BAR(0);
  DMA_K(3,0);DMA_V(1,SLOTB);
  ROT();
  kload8(kf,kp0+sl_cur);
  WAIT_BAR(2);
  s16x4 vlo[8],vhi[8]; u32x4 pw0,pw1,pw2,pw3;
  #define PKW(P,B) cvtpk_s(P[B],P[B+1])
  #define PAF(k) __builtin_bit_cast(bf16x8,pw##k)
  #define VFR(i) (bf16x8){vlo[i][0],vlo[i][1],vlo[i][2],vlo[i][3],vhi[i][0],vhi[i][1],vhi[i][2],vhi[i][3]}
  #define PIN(x) asm volatile("":"+v"(x))
  #define MX3(a,b,c) __builtin_fmaxf(__builtin_fmaxf((a),(b)),(c))
  #define GAPA(MF,A0,A1,A2,A3,W0,W1,PW) do{ MF; sacc+=A0; sacc+=A1; sacc+=A2; sacc+=A3; PIN(sacc); W0; W1; PIN(PW); SBAR(); }while(0)
  #define EX(v) __builtin_amdgcn_exp2f(v)
  #define GAPB(MF,X,B) do{ MF; X[B]=EX(X[B]); X[B+1]=EX(X[B+1]); X[B+2]=EX(X[B+2]); X[B+3]=EX(X[B+3]); PIN(X); SBAR(); }while(0)
  #define VRD(i) do{ vlo[i]=vtr(vp_+(((i)>>2)*4096+((i)&3)*1024)); vhi[i]=vtr(vp_+(((i)>>2)*4096+((i)&3)*1024+512)); }while(0)
  #define KRD(G,j) do{ if(G){ kload2(kf,kp0+sl_next,j); SBAR(); } }while(0)
  #define STEP(C0,C1,P0,P1,t,GK,GV,GL) do{ SBAR(); \
    const lds_cptr vp_=vp0+sl_prev; \
    VRD(0); SBAR(); float sacc=(P0[0]+P0[1]); \
    GAPA(C0=__builtin_amdgcn_mfma_f32_32x32x16_bf16(kf[0],qr[0],negm,0,0,0), P0[2],P0[3],P0[4],P0[5],     pw0[0]=PKW(P0,0), pw0[1]=PKW(P0,2), pw0); \
    VRD(4); SBAR(); GAPA(C1=__builtin_amdgcn_mfma_f32_32x32x16_bf16(kf[1],qr[0],negm,0,0,0), P0[6],P0[7],P0[8],P0[9],     pw0[2]=PKW(P0,4), pw0[3]=PKW(P0,6), pw0); \
    VRD(1); SBAR(); GAPA(C0=__builtin_amdgcn_mfma_f32_32x32x16_bf16(kf[2],qr[1],C0,0,0,0),   P0[10],P0[11],P0[12],P0[13], pw1[0]=PKW(P0,8), pw1[1]=PKW(P0,10), pw1); \
    VRD(5); SBAR(); GAPA(C1=__builtin_amdgcn_mfma_f32_32x32x16_bf16(kf[3],qr[1],C1,0,0,0),   P0[14],P0[15],P1[0],P1[1],   pw1[2]=PKW(P0,12),pw1[3]=PKW(P0,14), pw1); \
    VRD(2); SBAR(); GAPA(C0=__builtin_amdgcn_mfma_f32_32x32x16_bf16(kf[4],qr[2],C0,0,0,0),   P1[2],P1[3],P1[4],P1[5],     pw2[0]=PKW(P1,0), pw2[1]=PKW(P1,2), pw2); \
    VRD(6); SBAR(); GAPA(C1=__builtin_amdgcn_mfma_f32_32x32x16_bf16(kf[5],qr[2],C1,0,0,0),   P1[6],P1[7],P1[8],P1[9],     pw2[2]=PKW(P1,4), pw2[3]=PKW(P1,6), pw2); \
    VRD(3); SBAR(); GAPA(C0=__builtin_amdgcn_mfma_f32_32x32x16_bf16(kf[6],qr[3],C0,0,0,0),   P1[10],P1[11],P1[12],P1[13], pw3[0]=PKW(P1,8), pw3[1]=PKW(P1,10), pw3); \
    VRD(7); SBAR(); GAPA(C1=__builtin_amdgcn_mfma_f32_32x32x16_bf16(kf[7],qr[3],C1,0,0,0),   P1[14],P1[15],0.f,0.f,       pw3[2]=PKW(P1,12),pw3[3]=PKW(P1,14), pw3); \
    l_reg+=sacc; \
    if(GK){DMA_K((t)+3,sl_cur);} if(GV){DMA_V((t)+1,sl_next);} \
    CMASK(C0,C1,t); \
    { float a=MX3(C0[0],C0[1],C1[0]),b=MX3(C0[2],C0[3],C1[1]); a=MX3(a,C1[2],C1[3]); \
      _Pragma("unroll") for(int r=4;r<16;r+=4){a=MX3(a,C0[r],C0[r+1]);b=MX3(b,C0[r+2],C0[r+3]);a=MX3(a,C1[r],C1[r+1]);b=MX3(b,C1[r+2],C1[r+3]);} \
      float rm=__builtin_fmaxf(a,b); { auto rr=__builtin_amdgcn_permlane32_swap(__float_as_uint(rm),__float_as_uint(rm),false,false); rm=__builtin_fmaxf(__uint_as_float(rr[0]),__uint_as_float(rr[1])); } \
      resc=false; \
      if(__builtin_expect(__any(rm>(float)THRL),0)){ const float dl=__builtin_fmaxf(rm,0.f); mhat+=dl; \
        _Pragma("unroll") for(int r=0;r<16;++r){C0[r]-=dl;C1[r]-=dl;} \
        _Pragma("unroll") for(int r=0;r<16;++r)negm[r]=-mhat; asm volatile("":"+v"(negm)); \
        const float f=__builtin_amdgcn_exp2f(-dl); l_reg*=f; if(hi==0)wsf[r32]=f; resc=true; } } \
    SBAR(); \
    GAPB(o[0]=__builtin_amdgcn_mfma_f32_32x32x16_bf16(PAF(0),VFR(0),o[0],0,0,0), C0,0); \
    GAPB(o[1]=__builtin_amdgcn_mfma_f32_32x32x16_bf16(PAF(0),VFR(4),o[1],0,0,0), C0,4); \
    KRD(GL,0); GAPB(o[0]=__builtin_amdgcn_mfma_f32_32x32x16_bf16(PAF(1),VFR(1),o[0],0,0,0), C0,8); \
    KRD(GL,1); GAPB(o[1]=__builtin_amdgcn_mfma_f32_32x32x16_bf16(PAF(1),VFR(5),o[1],0,0,0), C0,12); \
    KRD(GL,2); GAPB(o[0]=__builtin_amdgcn_mfma_f32_32x32x16_bf16(PAF(2),VFR(2),o[0],0,0,0), C1,0); \
    KRD(GL,3); GAPB(o[1]=__builtin_amdgcn_mfma_f32_32x32x16_bf16(PAF(2),VFR(6),o[1],0,0,0), C1,4); \
    GAPB(o[0]=__builtin_amdgcn_mfma_f32_32x32x16_bf16(PAF(3),VFR(3),o[0],0,0,0), C1,8); \
    GAPB(o[1]=__builtin_amdgcn_mfma_f32_32x32x16_bf16(PAF(3),VFR(7),o[1],0,0,0), C1,12); \
    }while(0)
  int t=1;
  #undef CMASK
  #define CMASK(P0,P1,t) do{}while(0)
  for(;t+7<NT;t+=2){
    STEP(pB0,pB1,pA0,pA1,t,true,true,true);     WAIT_BAR(2); RESC(); ROT();
    STEP(pA0,pA1,pB0,pB1,t+1,true,true,true);   WAIT_BAR(2); RESC(); ROT();
  }
  #undef CMASK
  #define CMASK(P0,P1,t) do{int jb_=(t)-(NT-4); if(jb_>=-2)addbias(P0,P1,jb_,qrel,hi,tab); if(jb_>=0)cmask(P0,P1,jb_,qrel,hi);}while(0)
  #define ENDW(tt) do{ if((tt)+3<NT){WAIT_BAR(2);} else if((tt)+2<NT){WAIT_BAR(1);} else {WAIT_BAR(0);} }while(0)
  for(;t+1<NT;t+=2){
    STEP(pB0,pB1,pA0,pA1,t,(t+3<NT),(t+1<NT),(t+1<NT));       ENDW(t);   RESC(); ROT();
    STEP(pA0,pA1,pB0,pB1,t+1,(t+4<NT),(t+2<NT),(t+2<NT));     ENDW(t+1); RESC(); ROT();
  }
  STEP(pB0,pB1,pA0,pA1,NT-1,false,false,false); RESC();
  { float sacc=pB0[0]+pB0[1]; _Pragma("unroll") for(int r=2;r<16;++r)sacc+=pB0[r]; _Pragma("unroll") for(int r=0;r<16;++r)sacc+=pB1[r]; l_reg+=sacc;
    pw0=(u32x4){PKW(pB0,0),PKW(pB0,2),PKW(pB0,4),PKW(pB0,6)};pw1=(u32x4){PKW(pB0,8),PKW(pB0,10),PKW(pB0,12),PKW(pB0,14)};pw2=(u32x4){PKW(pB1,0),PKW(pB1,2),PKW(pB1,4),PKW(pB1,6)};pw3=(u32x4){PKW(pB1,8),PKW(pB1,10),PKW(pB1,12),PKW(pB1,14)};
    SBAR(); pv(o,vb0+sl_cur,PAF(0),PAF(1),PAF(2),PAF(3)); }
  #undef PKW
  #undef PAF
  #undef VFR
  #undef PIN
  #undef MX3
  #undef GAPA
  #undef GAPB
  #undef EX
  #undef VRD
  #undef KRD
  #undef STEP
  #undef ENDW
  {auto rr=__builtin_amdgcn_permlane32_swap(__float_as_uint(l_reg),__float_as_uint(l_reg),false,false);l_reg=__uint_as_float(rr[0])+__uint_as_float(rr[1]);}
  if(hi==0)wsf[32+r32]=l_reg;asm volatile("s_waitcnt lgkmcnt(0)":::"memory");
  float rli[16];
  #pragma unroll
  for(int r=0;r<16;++r)rli[r]=__builtin_amdgcn_rcpf(wsf[32+crow(r,hi)]);
  bf16*Ow=O+(rowbase+q0+wid*QBLK)*DM;
  { bf16*stg=(bf16*)(shm+LDS_OST)+wid*2048;
    #pragma unroll
    for(int r=0;r<16;++r){const int orow=crow(r,hi);
      #pragma unroll
      for(int d0=0;d0<2;++d0)stg[orow*64+d0*32+r32]=::f2bf(o[d0][r]*rli[r]);}
    asm volatile("s_waitcnt lgkmcnt(0)":::"memory");
    #pragma unroll
    for(int i=0;i<4;++i){const int row=i*8+(lane>>3),ch=lane&7; const u32x4 v=*(const u32x4*)(stg+row*64+ch*8); ATTN_STORE16(Ow+(long)row*DM+ch*8,v);} }
  asm volatile("s_waitcnt lgkmcnt(0)\n\ts_barrier":::"memory");
  #undef DMA_K
  #undef DMA_V
  #undef CMASK
  #undef START
  #undef RESC
  #undef ROT
}
constexpr int ATTN_LDS_BYTES=LDS_BYTES;
struct AttnUnit { int b, m, vh, qb; };
struct StaticOrder {
  int vcu, G;
  __device__ __forceinline__ StaticOrder(int grid,int v):vcu(v),G(grid){}
  __device__ __forceinline__ bool next(int i,AttnUnit&u)const{
    int combo,qb;
    if(G==256){ if(i>=4)return false; const int s=vcu&1; combo=vcu>>1; qb=(i==0)?7-s:(i==1)?4+s:(i==2)?3-s:s; }
    else { const int idx=i*G+vcu; if(idx>=1024)return false; combo=idx>>3; qb=idx&7; }
    u.vh=combo&1; u.m=(combo>>1)&7; u.b=combo>>4; u.qb=qb; return true; }
};
template<class Sched,int THRL=8> __device__ __forceinline__ void attn_phase(char*lds,const bf16*P,const float*rel_bias,const Sched&S){
  AttnUnit u;
  for(int i=0;S.next(i,u);++i){ attn_unit<THRL>(u.b,u.m,u.vh,u.qb,P,rel_bias,lds); }
}
#undef SBAR
#undef WAIT_BAR
}

#define GAS __attribute__((address_space(1)))
#define LAS __attribute__((address_space(3)))
typedef unsigned v4u __attribute__((ext_vector_type(4)));
typedef GAS unsigned gu32;
typedef GAS unsigned long long gu64;
#define RLX_AGENT __ATOMIC_RELAXED, __HIP_MEMORY_SCOPE_AGENT
#define LDS_WAIT() asm volatile("s_waitcnt lgkmcnt(0)" ::: "memory")
#define VM_WAIT() asm volatile("s_waitcnt vmcnt(0)" ::: "memory")

#define XB_TMO      128
#define XB_XCNT(j)  (256  + 64 * (j))
#define XB_XSUB(j)  (1280 + 64 * (j))
#define XB_XGEN(j)  (2304 + 64 * (j))
#define XB_TOP      3328
#define XB_TOPGEN   3392
#define XCD_BAR_WORDS 3456
#define XB_SPIN_CAP (1u << 18)

__device__ __forceinline__ unsigned xb_ld(unsigned* p)              { return __hip_atomic_load(p, __ATOMIC_RELAXED, __HIP_MEMORY_SCOPE_AGENT); }
__device__ __forceinline__ unsigned xb_add(unsigned* p, unsigned v) { return __hip_atomic_fetch_add(p, v, __ATOMIC_RELAXED, __HIP_MEMORY_SCOPE_AGENT); }
__device__ __forceinline__ unsigned xb_xcc_id() { return (unsigned)__builtin_amdgcn_s_getreg((3 << 11) | 20) & 0xFu; }
#define XB_SPIN(cond, bar) do { unsigned _sp = 0; while (cond) { __builtin_amdgcn_s_sleep(1); \
    if ((++_sp & 255u) == 0u) { if (xb_ld(&(bar)[XB_TMO])) break; if (_sp > XB_SPIN_CAP) { atomicAdd(&(bar)[XB_TMO], 1u); break; } } } } while (0)

struct XcdBarrier {
    unsigned* bar; unsigned x;
    volatile LAS unsigned* st;
};

__device__ __forceinline__ XcdBarrier xcd_barrier_post(unsigned* bar, volatile LAS unsigned* st) {
    XcdBarrier b; b.bar = bar; b.x = xb_xcc_id(); b.st = st;
    if (threadIdx.x == 0) (void)xb_add(&bar[XB_XCNT(b.x)], 1u);
    return b;
}
__device__ __forceinline__ void xcd_barrier_complete(unsigned* bar, unsigned x, unsigned& nloc, unsigned& nx) {
    const unsigned G = gridDim.x * gridDim.y * gridDim.z;
    unsigned sum, cnt, mine, sp = 0u;
    for (;;) {
        sum = 0u; cnt = 0u; mine = 0u;
#pragma unroll
        for (unsigned j = 0; j < 16; ++j) { const unsigned c = xb_ld(&bar[XB_XCNT(j)]); sum += c; cnt += (c > 0u) ? 1u : 0u; mine = (j == x) ? c : mine; }
        if (sum == G) break;
        __builtin_amdgcn_s_sleep(1);
        if ((++sp & 255u) == 0u) { if (xb_ld(&bar[XB_TMO])) break; if (sp > XB_SPIN_CAP) { atomicAdd(&bar[XB_TMO], 1u); break; } }
    }
    nloc = mine > 0u ? mine : 1u; nx = cnt > 0u ? cnt : 1u;
}

__device__ __forceinline__ void xcd_barrier(const XcdBarrier& b) {
    asm volatile("s_waitcnt vmcnt(0)" ::: "memory");
    __syncthreads();
    if (threadIdx.x == 0) {
        unsigned* bar = b.bar;
        __builtin_amdgcn_s_waitcnt(0);
        unsigned nloc = b.st[0], nx = b.st[1];
        if (nloc == 0u) { xcd_barrier_complete(bar, b.x, nloc, nx); b.st[0] = nloc; b.st[1] = nx; }
        const unsigned old = xb_add(&bar[XB_XSUB(b.x)], 1u);
        const unsigned gen = old / nloc;
        if (old + 1u == (gen + 1u) * nloc) {
            __builtin_amdgcn_fence(__ATOMIC_RELEASE, "agent");
            asm volatile("s_waitcnt vmcnt(0)" ::: "memory");
            const unsigned og = xb_add(&bar[XB_TOP], 1u);
            const unsigned tg = og / nx;
            if (og + 1u == (tg + 1u) * nx) xb_add(&bar[XB_TOPGEN], 1u);
            else XB_SPIN(xb_ld(&bar[XB_TOPGEN]) == tg, bar);
            __builtin_amdgcn_fence(__ATOMIC_ACQUIRE, "agent");
            xb_add(&bar[XB_XGEN(b.x)], 1u);
            asm volatile("s_waitcnt vmcnt(0)" ::: "memory");
        } else {
            XB_SPIN(xb_ld(&bar[XB_XGEN(b.x)]) == gen, bar);
            __builtin_amdgcn_fence(__ATOMIC_ACQUIRE, "agent");
            asm volatile("s_waitcnt vmcnt(0)" ::: "memory");
        }
    }
    __syncthreads();
}
#define FAST_GLA 1
#define FAST_S5 0

constexpr int NWAVES = 8;
constexpr int RING_OFF = 0, RING_BYTES = 131072;
constexpr int LDSCTL_OFF = RING_BYTES, MISC_OFF = LDSCTL_OFF + 320;
constexpr int LDS_BYTES = 147456;
constexpr int CW_BAR = 4096;
constexpr int PH_PROLOGUE = 0, PH_ROW0 = 1, PH_LAYER0 = 2, NPL = 16;
enum { S_UP1 = 0, S_DN1, S_ROWA, S_WIN, S_MIX1, S_MIX2, S_MIX3, S_ATTN, S_DFIN, S_GLU, S_BRANCH, S_WOUT, S_ROWB, S_UP2, S_DN2, S_ROWC };
constexpr int N_PHASES = PH_LAYER0 + DEPTH * NPL;

struct Args { const float* in[29]; float* out; unsigned char* ws; int ph_lo, ph_hi; };
struct Frame {
    LAS unsigned char* lds; char* ldsg;
    int tid, lane, wave, vcu, G, z, cid;
    const float* const* in; float* out; unsigned char* ws;
};

template <int MAP> __device__ __forceinline__ int conv_src(int n) {
    if (MAP == 0) return n;
    if (MAP == 1) { const int t = n >> 8, r = n & 255; return r < 128 ? 128 * t + r : DFF + 128 * t + (r - 128); }
    if (MAP == 2) return my2ref(n);
    { const int t = n >> 8, r = n & 255; return r < 128 ? 128 * t + r : 512 + 128 * t + (r - 128); }
}
template <int MAP> __device__ __forceinline__ void conv_item(const float* W, int K, int N, int Np, bf16_t* WT, LAS float* scr, int item, int lane) {
    const int nblk = Np / 32, kb = item / nblk, nb = item % nblk, k0 = 64 * kb, n0 = 32 * nb;
    const int src = conv_src<MAP>(n0 + (lane & 31));
#pragma unroll 8
    for (int i = 0; i < 32; ++i) { const int kk = 2 * i + (lane >> 5); scr[kk * 33 + (lane & 31)] = (src >= 0) ? W[(size_t)(k0 + kk) * N + src] : 0.f; }
    LDS_WAIT(); asm volatile("" ::: "memory");
    const int c = lane & 7;
#pragma unroll
    for (int j = 0; j < 4; ++j) { const int n = (lane >> 3) + 8 * j; const LAS float* s = scr + (8 * c) * 33 + n;
        v4u o; o.x = pk2(s[0 * 33], s[1 * 33]); o.y = pk2(s[2 * 33], s[3 * 33]); o.z = pk2(s[4 * 33], s[5 * 33]); o.w = pk2(s[6 * 33], s[7 * 33]);
        *(GAS v4u*)(WT + (size_t)(n0 + n) * K + k0 + 8 * c) = o; }
    LDS_WAIT(); asm volatile("" ::: "memory");
}
__device__ __forceinline__ void convert_layer(Frame& F, int l) {
    LAS float* scr = (LAS float*)(F.lds + RING_OFF + F.wave * 16384);
    const int gw = F.vcu * NWAVES + F.wave, NGW = F.G * NWAVES;
    bf16_t* wb = (bf16_t*)(F.ws + WS_W);
    constexpr int I_UP = (D / 64) * (2 * DFF / 32), I_DN = (DFF / 64) * (D / 32), I_IN = (D / 64) * (PW / 32), I_GLU = (512 / 64) * (1024 / 32), I_BR = I_GLU, I_OUT = (D / 64) * (D / 32);
    constexpr int NITEMS = 2 * I_UP + 2 * I_DN + I_IN + I_GLU + 3 * I_BR + I_OUT;
    const float* f1u = F.in[F.z + 7] + (size_t)l * D * 2 * DFF; const float* f1d = F.in[F.z + 8] + (size_t)l * DFF * D;
    const float* f2u = F.in[F.z + 9] + (size_t)l * D * 2 * DFF; const float* f2d = F.in[F.z + 10] + (size_t)l * DFF * D;
    const float* win = F.in[F.z + 11] + (size_t)l * D * INW; const float* wglu = F.in[F.z + 25] + (size_t)l * 512 * 1024;
    const float* wbr = F.in[F.z + 27] + (size_t)l * 3 * 512 * D; const float* wout = F.in[F.z + 28] + (size_t)l * D * D;
    for (int it = gw; it < NITEMS; it += NGW) {
        int r = it;
        if (r < I_UP) { conv_item<1>(f1u, D, 2 * DFF, 2 * DFF, wb + W_UP1, scr, r, F.lane); continue; } r -= I_UP;
        if (r < I_DN) { conv_item<0>(f1d, DFF, D, D, wb + W_DN1, scr, r, F.lane); continue; } r -= I_DN;
        if (r < I_UP) { conv_item<1>(f2u, D, 2 * DFF, 2 * DFF, wb + W_UP2, scr, r, F.lane); continue; } r -= I_UP;
        if (r < I_DN) { conv_item<0>(f2d, DFF, D, D, wb + W_DN2, scr, r, F.lane); continue; } r -= I_DN;
        if (r < I_IN) { conv_item<2>(win, D, INW, PW, wb + W_IN, scr, r, F.lane); continue; } r -= I_IN;
        if (r < I_GLU) { conv_item<3>(wglu, 512, 1024, 1024, wb + W_GLU, scr, r, F.lane); continue; } r -= I_GLU;
        if (r < 3 * I_BR) { const int i = r / I_BR; conv_item<0>(wbr + (size_t)i * 512 * D, 512, D, D, wb + W_BR + (size_t)i * 1024 * 512, scr, r % I_BR, F.lane); continue; } r -= 3 * I_BR;
        conv_item<0>(wout, D, D, D, wb + W_OUT, scr, r, F.lane);
    }
}
__device__ __forceinline__ void ada_phase(Frame& F) {
    if (F.vcu < 2 * 72) {
        const int l = F.vcu / 72, cb = F.vcu % 72;
        LAS float* cond = (LAS float*)(F.lds + RING_OFF);
        LAS float* red = (LAS float*)(F.lds + RING_OFF + 32768);
        const float* c = F.in[F.z + 1];
        for (int i = F.tid; i < BATCH * D; i += NWAVES * 64) cond[i] = siluf_(c[i]);
        __syncthreads();
        float acc[BATCH][2];
#pragma unroll
        for (int b = 0; b < BATCH; ++b) { acc[b][0] = 0.f; acc[b][1] = 0.f; }
        const float* w = F.in[F.z + 3] + ((size_t)l * D + F.wave * 128) * ADA + cb * 128 + 2 * F.lane;
#pragma unroll 4
        for (int k = 0; k < 128; ++k) { const float2 wv = *(const float2*)(w + (size_t)k * ADA);
#pragma unroll
            for (int b = 0; b < BATCH; ++b) { const float cv = cond[b * D + F.wave * 128 + k]; acc[b][0] += cv * wv.x; acc[b][1] += cv * wv.y; } }
#pragma unroll
        for (int b = 0; b < BATCH; ++b) { red[(F.wave * 8 + b) * 128 + 2 * F.lane] = acc[b][0]; red[(F.wave * 8 + b) * 128 + 2 * F.lane + 1] = acc[b][1]; }
        __syncthreads();
        float* ada = (float*)(F.ws + WS_ADA);
        for (int o = F.tid; o < BATCH * 128; o += NWAVES * 64) { const int b = o >> 7, cc = o & 127; float s = F.in[F.z + 4][l * ADA + cb * 128 + cc];
#pragma unroll
            for (int w8 = 0; w8 < 8; ++w8) s += red[(w8 * 8 + b) * 128 + cc];
            ada[((size_t)l * BATCH + b) * ADA + cb * 128 + cc] = s; }
        __syncthreads();
    }
}
__device__ __forceinline__ void rowpass_phase(Frame& F, int l, int sub) {
    const int gw = F.vcu * NWAVES + F.wave, NGW = F.G * NWAVES;
    const float* ada = (const float*)(F.ws + WS_ADA); const float* adal = ada + (size_t)l * BATCH * ADA;
    const float* npre = F.in[F.z + 5] + l * 3 * D; const float* npost = F.in[F.z + 6] + l * 3 * D;
    bf16_t* u = (bf16_t*)(F.ws + WS_U); const bf16_t* y = (const bf16_t*)(F.ws + WS_Y);
    const float* h_in = F.out; const bf16_t* yy = y; const float* gpost = nullptr; const float* gate = nullptr; float coef = 0.f;
    const float* gpre = nullptr; const float* shift = nullptr; const float* scale = nullptr; bf16_t* uu = u;
    if (sub == 0) { h_in = F.in[F.z + 0]; yy = nullptr; gpre = npre; shift = adal; scale = adal + D; }
    else if (sub == 1) { gpost = npost; gate = adal + 2 * D; coef = 0.5f; gpre = npre + D; shift = adal + 3 * D; scale = adal + 4 * D; }
    else if (sub == 2) { gpost = npost + D; gate = adal + 5 * D; coef = 1.0f; gpre = npre + 2 * D; shift = adal + 6 * D; scale = adal + 7 * D; }
    else { gpost = npost + 2 * D; gate = adal + 8 * D; coef = 0.5f;
        if (l + 1 < DEPTH) { gpre = F.in[F.z + 5] + (l + 1) * 3 * D; shift = adal + (size_t)BATCH * ADA; scale = shift + D; } else uu = nullptr; }
    for (int row = gw; row < M; row += NGW) rowpass_row(row, F.lane, h_in, F.out, yy, gpost, gate, coef, gpre, shift, scale, uu);
}
__device__ __forceinline__ void dfin_phase(Frame& F, int l) {
    const int gw = F.vcu * NWAVES + F.wave, NGW = F.G * NWAVES;
    const float* lamv = F.in[F.z + 15] + l * 256; const float lam_init = 0.8f - 0.6f * __expf(-0.3f * (float)l);
    const float lam = __expf(wave_sum(lamv[F.lane] * lamv[64 + F.lane])) - __expf(wave_sum(lamv[128 + F.lane] * lamv[192 + F.lane])) + lam_init;
    bf16_t* proj = (bf16_t*)(F.ws + WS_R0);
    for (int row = gw; row < M; row += NGW) diff_fin_row(proj + (size_t)row * PW, F.lane, lam, F.in[F.z + 16] + l * 512, lam_init);
}


constexpr size_t WS_S5TAB = WS_ADA + 640 * 1024;
constexpr size_t S5T_AB = 0, S5T_A64 = 16384, S5T_BB = 32768, S5T_CC = S5T_BB + 131072, S5T_END = S5T_CC + 131072;
static_assert(WS_S5TAB + S5T_END <= WS_S5ST, "S5 tables fit");
constexpr size_t WS_DECAY = WS_CTL + 512 * 1024;
constexpr size_t WS_SPT = WS_U, WS_OI = WS_U + 16 * MiB;
typedef float f32x2v __attribute__((ext_vector_type(2)));
#define MFMA16(a, b, c) __builtin_amdgcn_mfma_f32_16x16x32_bf16((a), (b), (c), 0, 0, 0)

__device__ __forceinline__ void s5_tables(Frame& F, int l) {
    const int gw = F.vcu * NWAVES + F.wave;
    if (gw >= 32) return;
    const int g = gw, p = F.lane;
    const float* lam_re = F.in[F.z + 17] + l * 2048; const float* lam_im = F.in[F.z + 18] + l * 2048; const float* log_step = F.in[F.z + 19] + l * 32;
    const float* b_re = F.in[F.z + 20] + l * 32768; const float* b_im = F.in[F.z + 21] + l * 32768; const float* c_re = F.in[F.z + 22] + l * 32768; const float* c_im = F.in[F.z + 23] + l * 32768;
    unsigned char* tb = F.ws + WS_S5TAB;
    const float lr = lam_re[g * 64 + p], li = lam_im[g * 64 + p], dt = expf(log_step[g]);
    const float mag = expf(lr * dt), ar = mag * cosf(li * dt), ai = mag * sinf(li * dt);
    const float nr = ar - 1.f, ni = ai, den = lr * lr + li * li, fre = (nr * lr + ni * li) / den, fim = (ni * lr - nr * li) / den;
    ((f32x2v*)(tb + S5T_AB))[g * 64 + p] = (f32x2v){ar, ai};
    float pr = ar, pi = ai;
#pragma unroll
    for (int i = 0; i < 6; ++i) { const float nr2 = pr * pr - pi * pi, ni2 = 2.f * pr * pi; pr = nr2; pi = ni2; }
    ((f32x2v*)(tb + S5T_A64))[g * 64 + p] = (f32x2v){pr, pi};
    bf16_t* BB = (bf16_t*)(tb + S5T_BB) + (size_t)g * 128 * 16; bf16_t* CC = (bf16_t*)(tb + S5T_CC) + (size_t)g * 16 * 128;
#pragma unroll
    for (int h = 0; h < 16; ++h) { const float br = b_re[(g * 64 + p) * 16 + h], bi = b_im[(g * 64 + p) * 16 + h];
        BB[(2 * p) * 16 + h] = f2bf(fre * br - fim * bi); BB[(2 * p + 1) * 16 + h] = f2bf(fre * bi + fim * br);
        CC[h * 128 + 2 * p] = f2bf(c_re[(g * 16 + h) * 64 + p]); CC[h * 128 + 2 * p + 1] = f2bf(-c_im[(g * 16 + h) * 64 + p]); }
}
template <bool OUT> __device__ __forceinline__ void s5_item(Frame& F, int l, int item, LAS unsigned char* wl) {
    int lane_ = F.lane; asm volatile("" : "+v"(lane_));
    const int lane = lane_, fr = lane & 15, fq = lane >> 4;
    const int b = item >> 10, g = (item >> 5) & 31, c = item & 31;
    const unsigned char* tb = F.ws + WS_S5TAB;
    bf16_t* proj = (bf16_t*)(F.ws + WS_R0);
    f32x2v* ST = (f32x2v*)(F.ws + WS_S5ST);
    const f32x2v ab = ((const f32x2v*)(tb + S5T_AB))[g * 64 + lane];
    const float ar = ab.x, ai = ab.y;
    const bf16x8 zero8 = (bf16x8){0, 0, 0, 0, 0, 0, 0, 0};
    bf16x8 bfrag[8];
#pragma unroll
    for (int ct = 0; ct < 8; ++ct) bfrag[ct] = (fq < 2) ? *(const bf16x8*)((const bf16_t*)(tb + S5T_BB) + ((size_t)(g * 128 + 16 * ct + fr) * 16 + 8 * fq)) : zero8;
    bf16x8 cfrag[4]; float dsk = 0.f;
    if (OUT) {
#pragma unroll
        for (int s = 0; s < 4; ++s) cfrag[s] = *(const bf16x8*)((const bf16_t*)(tb + S5T_CC) + ((size_t)(g * 16 + fr) * 128 + 32 * s + 8 * fq));
        dsk = (F.in[F.z + 24] + l * 512)[g * 16 + fr];
    }
    float xr = 0.f, xi = 0.f;
    if (OUT) { const f32x2v x0 = ST[(size_t)item * 64 + lane]; xr = x0.x; xi = x0.y; }
    LAS float* buL = (LAS float*)wl;
    LAS unsigned char* XL = wl + 16 * 132 * 4;
    const size_t row0 = (size_t)b * SEQ + 64 * c;
#pragma unroll 1
    for (int w = 0; w < 4; ++w) {
        bf16_t* urow = proj + (row0 + 16 * w) * PW + C_SU + 16 * g;
        const bf16x8 a = (fq < 2) ? *(const bf16x8*)(urow + (size_t)fr * PW + 8 * fq) : zero8;
#pragma unroll
        for (int ct = 0; ct < 8; ++ct) { const f32x4 acc = MFMA16(a, bfrag[ct], ((f32x4){0.f, 0.f, 0.f, 0.f}));
#pragma unroll
            for (int j = 0; j < 4; ++j) buL[(4 * fq + j) * 132 + 16 * ct + fr] = acc[j]; }
        LDS_WAIT(); asm volatile("" ::: "memory");
        f32x2v bu[16];
#pragma unroll
        for (int t = 0; t < 16; ++t) bu[t] = *(const LAS f32x2v*)(buL + t * 132 + 2 * lane);
        LDS_WAIT(); asm volatile("" ::: "memory");
#pragma unroll
        for (int t = 0; t < 16; ++t) { const float nxr = ar * xr - ai * xi + bu[t].x, nxi = ar * xi + ai * xr + bu[t].y; xr = nxr; xi = nxi;
            if (OUT) *(LAS unsigned*)(XL + (t * 136 + 2 * lane) * 2) = pk2(xr, xi); }
        if (OUT) {
            LDS_WAIT(); asm volatile("" ::: "memory");
            f32x4 y = (f32x4){0.f, 0.f, 0.f, 0.f};
#pragma unroll
            for (int s = 0; s < 4; ++s) { const bf16x8 xa = *(const LAS bf16x8*)(XL + (fr * 136 + 32 * s + 8 * fq) * 2); y = MFMA16(xa, cfrag[s], y); }
#pragma unroll
            for (int j = 0; j < 4; ++j) { bf16_t* up = urow + (size_t)(4 * fq + j) * PW + fr; const float yn = y[j] + dsk * bf2f(*up);
                const float x3 = yn * yn * yn; *up = f2bf(0.5f * yn * (1.f + tanhf(0.7978845608028654f * (yn + 0.044715f * x3)))); }
            LDS_WAIT(); asm volatile("" ::: "memory");
        }
    }
    if (!OUT) ST[(size_t)item * 64 + lane] = (f32x2v){xr, xi};
}
template <bool OUT> __device__ __forceinline__ void s5_pass(Frame& F, int l) {
    LAS unsigned char* wl = F.lds + RING_OFF + F.wave * 12800;
    const int gw = F.vcu * NWAVES + F.wave, NGW = F.G * NWAVES;
    for (int item = gw; item < BATCH * 32 * 32; item += NGW) s5_item<OUT>(F, l, item, wl);
}
__device__ __forceinline__ void s5_carry(Frame& F) {
    const int gw = F.vcu * NWAVES + F.wave, NGW = F.G * NWAVES;
    f32x2v* ST = (f32x2v*)(F.ws + WS_S5ST);
    for (int bg = gw; bg < BATCH * 32; bg += NGW) {
        const int g = bg & 31; const f32x2v a64 = ((const f32x2v*)(F.ws + WS_S5TAB + S5T_A64))[g * 64 + F.lane];
        f32x2v* st = ST + (size_t)bg * 32 * 64 + F.lane; f32x2v e[32];
#pragma unroll
        for (int c = 0; c < 32; ++c) e[c] = st[c * 64];
        float xr = 0.f, xi = 0.f; asm volatile("" : "+v"(xr), "+v"(xi));
#pragma unroll
        for (int c = 0; c < 32; ++c) { st[c * 64] = (f32x2v){xr, xi}; const float nxr = a64.x * xr - a64.y * xi + e[c].x, nxi = a64.x * xi + a64.y * xr + e[c].y; xr = nxr; xi = nxi; }
    }
}

constexpr int GL_QD = 0, GL_KD = 9216, GL_KRT = 18432, GL_VT = 27648, GL_ATT = 46080, GL_WAL = 55296, GL_END = GL_WAL + 17 * 64 * 4;
__device__ __forceinline__ void gla_pass1(Frame& F, int l) {
    bf16_t* proj = (bf16_t*)(F.ws + WS_R0);
    const float* w_alpha = F.in[F.z + 12] + l * 16 * 256; const float* b_alpha = F.in[F.z + 13] + l * 256;
    float* dST = (float*)(F.ws + WS_GLA); float* decay = (float*)(F.ws + WS_DECAY); unsigned* OI = (unsigned*)(F.ws + WS_OI);
    LAS unsigned char* L = F.lds + RING_OFF;
    LAS float* wal = (LAS float*)(L + GL_WAL);
    const int w = F.wave;
    for (int item = F.vcu; item < BATCH * 4 * 32; item += F.G) {
        int lane_ = F.lane; asm volatile("" : "+v"(lane_));
        const int lane = lane_, t = w * 64 + lane, fr = lane & 15, fq = lane >> 4;
        const int b = item >> 7, h = (item >> 5) & 3, n = item & 31;
        const size_t row0 = (size_t)b * SEQ + 64 * n;
        for (int i = t; i < 17 * 64; i += NWAVES * 64) wal[i] = (i < 1024) ? w_alpha[(i >> 6) * 256 + h * 64 + (i & 63)] : b_alpha[h * 64 + (i & 63)];
#pragma unroll
        for (int i = 0; i < 2; ++i) { const int id = t + 512 * i, s = id & 63, e0 = (id >> 6) * 8;
            const u32x4 vv = *(const u32x4*)(proj + (row0 + s) * PW + C_GV + h * 128 + e0);
#pragma unroll
            for (int k = 0; k < 4; ++k) { *(LAS bf16_t*)(L + GL_VT + ((e0 + 2 * k) * 72 + s) * 2) = (bf16_t)(vv[k] & 0xffffu); *(LAS bf16_t*)(L + GL_VT + ((e0 + 2 * k + 1) * 72 + s) * 2) = (bf16_t)(vv[k] >> 16); } }
        __syncthreads();
        {
            const int c = lane, d0 = 8 * w;
            const bf16_t* rowp = proj + (row0 + c) * PW;
            const u32x4 a0 = *(const u32x4*)(rowp + C_GA), a1 = *(const u32x4*)(rowp + C_GA + 8);
            float al[16];
#pragma unroll
            for (int k = 0; k < 4; ++k) { al[2 * k] = blo(a0[k]); al[2 * k + 1] = bhi(a0[k]); al[8 + 2 * k] = blo(a1[k]); al[8 + 2 * k + 1] = bhi(a1[k]); }
            float bb[8];
#pragma unroll
            for (int i = 0; i < 8; ++i) { float z = wal[1024 + d0 + i];
#pragma unroll
                for (int j = 0; j < 16; ++j) z += al[j] * wal[j * 64 + d0 + i];
                bb[i] = (fminf(z, 0.f) - log1pf(__expf(-fabsf(z)))) * (1.f / 16.f); }
#pragma unroll
            for (int i = 0; i < 8; ++i) {
#pragma unroll
                for (int o = 1; o < 64; o <<= 1) { const float up = __int_as_float(__builtin_amdgcn_ds_bpermute((lane - o) << 2, __float_as_int(bb[i]))); if (lane >= o) bb[i] += up; } }
            const u32x4 qv = *(const u32x4*)(rowp + C_GQ + h * 64 + d0), kv = *(const u32x4*)(rowp + C_GK + h * 64 + d0);
            float qd[8], kd[8], kr[8];
#pragma unroll
            for (int i = 0; i < 8; ++i) { const float bl = __int_as_float(__builtin_amdgcn_readlane(__float_as_int(bb[i]), 63)); const float q = (i & 1) ? bhi(qv[i >> 1]) : blo(qv[i >> 1]), k = (i & 1) ? bhi(kv[i >> 1]) : blo(kv[i >> 1]);
                qd[i] = q * __expf(bb[i]); kd[i] = k * __expf(-bb[i]); kr[i] = k * __expf(bl - bb[i]);
                if (lane == 63) decay[(size_t)item * 64 + d0 + i] = __expf(bl); }
            u32x4 qw, kw;
#pragma unroll
            for (int k = 0; k < 4; ++k) { qw[k] = pk2(qd[2 * k], qd[2 * k + 1]); kw[k] = pk2(kd[2 * k], kd[2 * k + 1]); }
            *(LAS u32x4*)(L + GL_QD + (c * 72 + d0) * 2) = qw; *(LAS u32x4*)(L + GL_KD + (c * 72 + d0) * 2) = kw;
            *(u32x4*)(proj + (row0 + c) * PW + C_GQ + h * 64 + d0) = qw;
#pragma unroll
            for (int i = 0; i < 8; ++i) *(LAS bf16_t*)(L + GL_KRT + ((d0 + i) * 72 + c) * 2) = f2bf(kr[i]);
        }
        __syncthreads();
        {
            const int ct = w >> 1;
#pragma unroll
            for (int si = 0; si < 2; ++si) { const int st = 2 * (w & 1) + si;
                f32x4 acc = (f32x4){0.f, 0.f, 0.f, 0.f};
                if (st <= ct) {
#pragma unroll
                    for (int ks = 0; ks < 2; ++ks) { const bf16x8 a = *(const LAS bf16x8*)(L + GL_QD + ((16 * ct + fr) * 72 + 32 * ks + 8 * fq) * 2), bq = *(const LAS bf16x8*)(L + GL_KD + ((16 * st + fr) * 72 + 32 * ks + 8 * fq) * 2);
                        acc = MFMA16(a, bq, acc); } }
#pragma unroll
                for (int j = 0; j < 4; ++j) { const int cc = 16 * ct + 4 * fq + j, ss = 16 * st + fr; *(LAS bf16_t*)(L + GL_ATT + (cc * 72 + ss) * 2) = f2bf(ss <= cc ? acc[j] : 0.f); } }
        }
        __syncthreads();
        {
            bf16x8 vf[2];
#pragma unroll
            for (int ks = 0; ks < 2; ++ks) vf[ks] = *(const LAS bf16x8*)(L + GL_VT + ((16 * w + fr) * 72 + 32 * ks + 8 * fq) * 2);
#pragma unroll
            for (int ct = 0; ct < 4; ++ct) { f32x4 acc = (f32x4){0.f, 0.f, 0.f, 0.f};
#pragma unroll
                for (int ks = 0; ks < 2; ++ks) { const bf16x8 a = *(const LAS bf16x8*)(L + GL_ATT + ((16 * ct + fr) * 72 + 32 * ks + 8 * fq) * 2); acc = MFMA16(a, vf[ks], acc); }
                uint2 o; o.x = pk2(acc[0], acc[1]); o.y = pk2(acc[2], acc[3]);
                *(uint2*)(OI + ((((size_t)item * 4 + ct) * 8 + w) * 64 + lane) * 2) = o; }
#pragma unroll
            for (int dt = 0; dt < 4; ++dt) { f32x4 acc = (f32x4){0.f, 0.f, 0.f, 0.f};
#pragma unroll
                for (int ks = 0; ks < 2; ++ks) { const bf16x8 bk = *(const LAS bf16x8*)(L + GL_KRT + ((16 * dt + fr) * 72 + 32 * ks + 8 * fq) * 2); acc = MFMA16(vf[ks], bk, acc); }
#pragma unroll
                for (int j = 0; j < 4; ++j) dST[((size_t)item * 128 + 16 * w + 4 * fq + j) * 64 + 16 * dt + fr] = acc[j]; }
        }
        __syncthreads();
    }
}
__device__ __forceinline__ void gla_pass2(Frame& F) {
    const float* dST = (const float*)(F.ws + WS_GLA); const float* decay = (const float*)(F.ws + WS_DECAY); unsigned* SPT = (unsigned*)(F.ws + WS_SPT);
    for (int idx = F.vcu * (NWAVES * 64) + F.tid; idx < 32 * 4096; idx += F.G * NWAVES * 64) {
        const int bh = idx >> 12, j = idx & 4095, e = j >> 5, d2 = (j & 31) * 2;
        float sx = 0.f, sy = 0.f;
#pragma unroll 1
        for (int n0 = 0; n0 < 32; n0 += 8) {
            f32x2v dv[8], dc[8];
#pragma unroll
            for (int k = 0; k < 8; ++k) { const size_t item = (size_t)bh * 32 + n0 + k; dv[k] = *(const f32x2v*)(dST + (item * 128 + e) * 64 + d2); dc[k] = *(const f32x2v*)(decay + item * 64 + d2); }
#pragma unroll
            for (int k = 0; k < 8; ++k) { const size_t item = (size_t)bh * 32 + n0 + k; SPT[((item * 128 + e) * 64 + d2) >> 1] = pk2(sx, sy); sx = dc[k].x * sx + dv[k].x; sy = dc[k].y * sy + dv[k].y; }
        }
    }
}
__device__ __forceinline__ void gla_pass3(Frame& F, int l) {
    bf16_t* proj = (bf16_t*)(F.ws + WS_R0); const bf16_t* SPT = (const bf16_t*)(F.ws + WS_SPT); const unsigned* OI = (const unsigned*)(F.ws + WS_OI);
    const float* norm_g = F.in[F.z + 14] + l * 512;
    const int ct = F.wave & 3;
    for (int item = F.vcu * 2 + (F.wave >> 2); item < BATCH * 4 * 32; item += F.G * 2) {
        int lane_ = F.lane; asm volatile("" : "+v"(lane_));
        const int lane = lane_, fr = lane & 15, fq = lane >> 4;
        const int b = item >> 7, h = (item >> 5) & 3, n = item & 31;
        const size_t row0 = (size_t)b * SEQ + 64 * n + 16 * ct;
        bf16x8 qa[2];
#pragma unroll
        for (int ks = 0; ks < 2; ++ks) qa[ks] = *(const bf16x8*)(proj + (row0 + fr) * PW + C_GQ + h * 64 + 32 * ks + 8 * fq);
        f32x4 acc[8];
#pragma unroll
        for (int et = 0; et < 8; ++et) { const uint2 oi = *(const uint2*)(OI + ((((size_t)item * 4 + ct) * 8 + et) * 64 + lane) * 2);
            acc[et] = (f32x4){blo(oi.x), bhi(oi.x), blo(oi.y), bhi(oi.y)};
#pragma unroll
            for (int ks = 0; ks < 2; ++ks) { const bf16x8 sb = *(const bf16x8*)(SPT + ((size_t)item * 128 + 16 * et + fr) * 64 + 32 * ks + 8 * fq); acc[et] = MFMA16(qa[ks], sb, acc[et]); } }
        float ss[4];
#pragma unroll
        for (int j = 0; j < 4; ++j) { float s = 0.f;
#pragma unroll
            for (int et = 0; et < 8; ++et) s += acc[et][j] * acc[et][j];
            s += swz_xor<1>(s); s += swz_xor<2>(s); s += swz_xor<4>(s); s += swz_xor<8>(s);
            ss[j] = rsqrtf(s * (1.f / 128.f) + EPS); }
#pragma unroll
        for (int et = 0; et < 8; ++et) { const float ng = norm_g[h * 128 + 16 * et + fr];
#pragma unroll
            for (int j = 0; j < 4; ++j) { bf16_t* rp = proj + (row0 + 4 * fq + j) * PW + h * 128 + 16 * et + fr; const float rr = bf2f(rp[C_GR]);
                rp[C_YGLA] = f2bf(acc[et][j] * ss[j] * ng * siluf_(rr)); } }
    }
}

__device__ __forceinline__ void gla_naive_phase(Frame& F, int l) {
    if (F.vcu >= BATCH * 4) return;
    bf16_t* proj = (bf16_t*)(F.ws + WS_R0);
    const float* w_alpha = F.in[F.z + F.z + 12] + l * 16 * 256; const float* b_alpha = F.in[F.z + F.z + 13] + l * 256; const float* norm_g = F.in[F.z + F.z + 14] + l * 512;
    const int b = F.vcu >> 2, h = F.vcu & 3, t = F.tid, lane = t & 63, e = t & 127, half = (t >> 7) & 1; const bool act = t < 256;
    LAS float* sa = (LAS float*)(F.lds + RING_OFF); LAS float* sq = sa + 64; LAS float* sk = sq + 64; LAS float* part = sk + 64; LAS float* red = part + 256;
    float S[32];
#pragma unroll
    for (int i = 0; i < 32; ++i) S[i] = 0.f;
    float wa[16]; float ba = 0.f;
#pragma unroll
    for (int j = 0; j < 16; ++j) wa[j] = 0.f;
    if (t < 64) { for (int j = 0; j < 16; ++j) wa[j] = w_alpha[j * 256 + h * 64 + t]; ba = b_alpha[h * 64 + t]; }
    const float ng = norm_g[h * 128 + e];
    for (int s = 0; s < SEQ; ++s) {
        bf16_t* row = proj + (size_t)(b * SEQ + s) * PW;
        if (t < 64) {
            float z = ba;
#pragma unroll
            for (int j = 0; j < 16; ++j) z += bf2f(row[C_GA + j]) * wa[j];
            const float ls = fminf(z, 0.f) - log1pf(__expf(-fabsf(z)));
            sa[t] = __expf(ls * (1.f / 16.f)); sq[t] = bf2f(row[C_GQ + h * 64 + t]); sk[t] = bf2f(row[C_GK + h * 64 + t]);
        }
        const float v = bf2f(row[C_GV + h * 128 + e]);
        const float rr = bf2f(row[C_GR + h * 128 + e]);
        __syncthreads();
        if (act) { float p = 0.f;
#pragma unroll
            for (int i = 0; i < 32; ++i) { const int d = half * 32 + i; S[i] = sa[d] * S[i] + sk[d] * v; p += sq[d] * S[i]; }
            part[half * 128 + e] = p; }
        __syncthreads();
        float o = 0.f;
        if (t < 128) { o = part[e] + part[128 + e]; const float ss = wave_sum(o * o); if (lane == 0) red[t >> 6] = ss; }
        __syncthreads();
        if (t < 128) { const float r = rsqrtf((red[0] + red[1]) * (1.f / 128.f) + EPS); row[C_YGLA + h * 128 + e] = f2bf(o * r * ng * siluf_(rr)); }
        __syncthreads();
    }
}
__device__ __forceinline__ void s5_naive_phase(Frame& F, int l) {
    if (F.wave != 0) return;
    const float* lam_re = F.in[F.z + F.z + 17] + l * 2048; const float* lam_im = F.in[F.z + F.z + 18] + l * 2048; const float* log_step = F.in[F.z + F.z + 19] + l * 32;
    const float* b_re = F.in[F.z + F.z + 20] + l * 32768; const float* b_im = F.in[F.z + F.z + 21] + l * 32768; const float* c_re = F.in[F.z + F.z + 22] + l * 32768; const float* c_im = F.in[F.z + F.z + 23] + l * 32768; const float* d_skip = F.in[F.z + F.z + 24] + l * 512;
    bf16_t* proj = (bf16_t*)(F.ws + WS_R0);
    for (int item = F.vcu; item < BATCH * 32; item += F.G) {
        const int b = item >> 5, g = item & 31, p = F.lane;
        const float lr = lam_re[g * 64 + p], li = lam_im[g * 64 + p], dt = expf(log_step[g]);
        const float mag = expf(lr * dt), ar = mag * cosf(li * dt), ai = mag * sinf(li * dt);
        const float nr = ar - 1.f, ni = ai, den = lr * lr + li * li, fre = (nr * lr + ni * li) / den, fim = (ni * lr - nr * li) / den;
        float bbr[16], bbi[16], cr[16], ci[16];
#pragma unroll
        for (int h = 0; h < 16; ++h) { const float br = b_re[(g * 64 + p) * 16 + h], bi = b_im[(g * 64 + p) * 16 + h]; bbr[h] = fre * br - fim * bi; bbi[h] = fre * bi + fim * br;
            cr[h] = c_re[(g * 16 + h) * 64 + p]; ci[h] = c_im[(g * 16 + h) * 64 + p]; }
        const float dsk = (p < 16) ? d_skip[g * 16 + p] : 0.f;
        float xr = 0.f, xi = 0.f;
        for (int s = 0; s < SEQ; ++s) {
            bf16_t* row = proj + (size_t)(b * SEQ + s) * PW + C_SU + g * 16;
            float u[16];
#pragma unroll
            for (int h = 0; h < 16; ++h) u[h] = bf2f(row[h]);
            float bur = 0.f, bui = 0.f;
#pragma unroll
            for (int h = 0; h < 16; ++h) { bur += bbr[h] * u[h]; bui += bbi[h] * u[h]; }
            const float nxr = ar * xr - ai * xi + bur, nxi = ar * xi + ai * xr + bui; xr = nxr; xi = nxi;
            float yn = 0.f;
#pragma unroll
            for (int n = 0; n < 16; ++n) { const float v = wave_sum(cr[n] * xr - ci[n] * xi); if (p == n) yn = v + dsk * u[n]; }
            if (p < 16) { const float x3 = yn * yn * yn; const float gl = 0.5f * yn * (1.f + tanhf(0.7978845608028654f * (yn + 0.044715f * x3))); row[p] = f2bf(gl); }
        }
    }
}


__device__ __forceinline__ void run_phase(Frame& F, int ph) {
    bf16_t* wb = (bf16_t*)(F.ws + WS_W); bf16_t* u = (bf16_t*)(F.ws + WS_U); bf16_t* y = (bf16_t*)(F.ws + WS_Y);
    bf16_t* hid = (bf16_t*)(F.ws + WS_R0); bf16_t* proj = (bf16_t*)(F.ws + WS_R0);
    if (ph == PH_PROLOGUE) { ada_phase(F); convert_layer(F, 0); s5_tables(F, 0); return; }
    if (ph == PH_ROW0) { rowpass_phase(F, 0, 0); return; }
    const int l = (ph - PH_LAYER0) / NPL, s = (ph - PH_LAYER0) % NPL;
    const int cid = F.cid;
    switch (s) {
    case S_UP1: case S_UP2: {
        typedef pg8::GemmT<D, D, D, 0, 0> GT; GT g{u, wb + (s == S_UP1 ? W_UP1 : W_UP2)}; pg8::StaticOrder S; S.init(M, 2 * DFF, F.G, cid);
        pg8::EpiSwiGLU E{hid}; pg8::gemm_phase<pg8::EpiSwiGLU, pg8::StaticOrder, GT, true, true>(F.lds + RING_OFF, g, S, E); break; }
    case S_DN1: case S_DN2: {
        typedef pg8::GemmT<DFF, DFF, DFF, 0, 0> GT; GT g{hid, wb + (s == S_DN1 ? W_DN1 : W_DN2)}; pg8::StaticOrder S; S.init(M, D, F.G, cid);
        typedef pg8::EpiStore<D, 0> ET; ET E{y}; pg8::gemm_phase<ET, pg8::StaticOrder, GT, true, true>(F.lds + RING_OFF, g, S, E); break; }
    case S_ROWA: rowpass_phase(F, l, 1); break;
    case S_WIN: {
        typedef pg8::GemmT<D, D, D, 0, 0> GT; GT g{u, wb + W_IN}; pg8::StaticOrder S; S.init(M, PW, F.G, cid);
        typedef pg8::EpiStore<PW, 1> ET; ET E{proj}; pg8::gemm_phase<ET, pg8::StaticOrder, GT, true, true>(F.lds + RING_OFF, g, S, E); break; }
    case S_DFIN: dfin_phase(F, l); break;
    case S_GLU: {
        typedef pg8::GemmT<PW, 512, 512, 0, 0> GT; GT g{proj + C_YS5PRE, wb + W_GLU}; pg8::StaticOrder S; S.init(M, 1024, F.G, cid);
        pg8::EpiGLU E{proj, F.in[F.z + 26] + l * 1024}; pg8::gemm_phase<pg8::EpiGLU, pg8::StaticOrder, GT, true, true>(F.lds + RING_OFF, g, S, E); break; }
    case S_BRANCH: {
        typedef pg8::GemmT<PW, 512, 512, 512 * 2, 1024 * 512 * 2> GT; GT g{proj + C_YGLA, wb + W_BR}; pg8::StaticOrder S; S.init(M, D, F.G, cid, 3);
        pg8::EpiBranch E{proj}; pg8::gemm_phase<pg8::EpiBranch, pg8::StaticOrder, GT, true, true>(F.lds + RING_OFF, g, S, E); break; }
    case S_WOUT: {
        typedef pg8::GemmT<PW, D, D, 0, 0> GT; GT g{proj + C_MERGED, wb + W_OUT}; pg8::StaticOrder S; S.init(M, D, F.G, cid);
        typedef pg8::EpiStore<D, 0> ET; ET E{y}; pg8::gemm_phase<ET, pg8::StaticOrder, GT, true, true>(F.lds + RING_OFF, g, S, E); break; }
    case S_ROWB: rowpass_phase(F, l, 2); break;
    case S_ROWC: rowpass_phase(F, l, 3); if (l + 1 < DEPTH) { convert_layer(F, l + 1); s5_tables(F, l + 1); } break;
#ifndef FAST_GLA
#define FAST_GLA 1
#endif
#ifndef FAST_S5
#define FAST_S5 1
#endif
    case S_MIX1: if (FAST_GLA) gla_pass1(F, l); else gla_naive_phase(F, l); if (FAST_S5) s5_pass<false>(F, l); break;
    case S_MIX2: if (FAST_GLA) gla_pass2(F); if (FAST_S5) s5_carry(F); else s5_naive_phase(F, l); break;
    case S_MIX3: if (FAST_GLA) gla_pass3(F, l); if (FAST_S5) s5_pass<true>(F, l); break;
    case S_ATTN: { const attn_body::StaticOrder S(F.G, F.vcu); attn_body::attn_phase<attn_body::StaticOrder>(F.ldsg + RING_OFF, (const attn_body::bf16*)proj, F.in[F.z + 2], S); break; }
    default: break;
    }
}

__device__ __forceinline__ const void* opaque_sptr(const void* p) {
    unsigned lo = (unsigned)(uintptr_t)p, hi = (unsigned)((uintptr_t)p >> 32); asm volatile("" : "+s"(lo), "+s"(hi)); const void* q = (const void*)(((uintptr_t)hi << 32) | lo);
#if defined(__HIP_DEVICE_COMPILE__)
    __builtin_assume(!__builtin_amdgcn_is_shared(q)); __builtin_assume(!__builtin_amdgcn_is_private(q));
#endif
    return q;
}
__device__ __forceinline__ const void* opaque_ptr(const void* p) {
    unsigned lo = (unsigned)(uintptr_t)p, hi = (unsigned)((uintptr_t)p >> 32); asm volatile("" : "+v"(lo), "+v"(hi));
    lo = __builtin_amdgcn_readfirstlane(lo); hi = __builtin_amdgcn_readfirstlane(hi); return (const void*)(((uintptr_t)hi << 32) | lo);
}
__global__ void __launch_bounds__(NWAVES * 64, 2) mk_fwd(Args args) {
    extern __shared__ __attribute__((aligned(16))) unsigned char lds[];
    Frame F;
    F.lds = (LAS unsigned char*)lds; F.ldsg = (char*)lds;
    F.tid = threadIdx.x; F.lane = F.tid & 63; F.wave = __builtin_amdgcn_readfirstlane(F.tid >> 6);
    F.G = gridDim.x; int vcu0; { const int bx = blockIdx.x; vcu0 = (F.G % 8 == 0) ? (bx % 8) * (F.G / 8) + bx / 8 : bx; } F.vcu = vcu0; F.cid = blockIdx.x; F.z = 0;
    F.in = args.in; F.out = args.out; F.ws = args.ws;
    for (int u = F.tid; u < (LDS_BYTES - LDSCTL_OFF) / 4; u += NWAVES * 64) ((LAS unsigned*)(F.lds + LDSCTL_OFF))[u] = 0u;
    __syncthreads();
    XcdBarrier bar; bar.bar = (unsigned*)(args.ws + WS_CTL) + CW_BAR; bar.x = 0; bar.st = nullptr;
    const bool multi = (__builtin_amdgcn_readfirstlane(args.ph_hi) - __builtin_amdgcn_readfirstlane(args.ph_lo)) > 1;
    if (multi) bar = xcd_barrier_post((unsigned*)(args.ws + WS_CTL) + CW_BAR, (volatile LAS unsigned*)(F.lds + MISC_OFF) + 8);
    const int ph_lo = __builtin_amdgcn_readfirstlane(args.ph_lo), ph_hi = __builtin_amdgcn_readfirstlane(args.ph_hi);
    for (int ph = ph_lo; ph < ph_hi; ++ph) {
        int t_ = threadIdx.x; asm volatile("" : "+v"(t_));
        F.tid = t_; F.lane = t_ & 63; F.wave = __builtin_amdgcn_readfirstlane(t_ >> 6);
        { int z_ = 0, v_ = vcu0, g_ = (int)gridDim.x, c_ = (int)blockIdx.x; asm volatile("" : "+s"(z_), "+s"(v_), "+s"(g_), "+s"(c_));
          F.z = z_; F.vcu = v_; F.G = g_; F.cid = c_;
          F.ws = args.ws + z_; F.out = args.out + z_; }
        run_phase(F, ph);
        if (ph + 1 < ph_hi) { XcdBarrier b2 = bar; b2.bar = bar.bar + F.z; { unsigned x_ = bar.x; asm volatile("" : "+s"(x_)); b2.x = x_; } xcd_barrier(b2); }
    }
}

extern "C" void kernel_launch(void* const* d_in, const int* in_sizes, int n_in, void* d_out, int out_size, void* d_ws, size_t ws_size, hipStream_t stream) {
    static int grid = 0;
    if (grid == 0) {
        if (n_in != 29 || in_sizes[0] != M * D || out_size != M * D || ws_size < WS_END) {
            fprintf(stderr, "kernel_launch: unexpected shapes/workspace: n_in %d in0 %d out %d ws %zu (need %zu)\n", n_in, n_in > 0 ? in_sizes[0] : -1, out_size, ws_size, (size_t)WS_END); grid = -1; return; }
        int dev = 0, cus = 0;
        if (hipGetDevice(&dev) != hipSuccess || hipDeviceGetAttribute(&cus, hipDeviceAttributeMultiprocessorCount, dev) != hipSuccess) { grid = -1; return; }
        if (hipFuncSetAttribute((const void*)mk_fwd, hipFuncAttributeMaxDynamicSharedMemorySize, LDS_BYTES) != hipSuccess) { fprintf(stderr, "kernel_launch: hipFuncSetAttribute failed\n"); grid = -1; return; }
        grid = cus;
    }
    if (grid < 0) return;
    Args a{};
    for (int i = 0; i < 29; ++i) a.in[i] = (const float*)d_in[i];
    a.out = (float*)d_out; a.ws = (unsigned char*)d_ws;
    if (hipMemsetAsync((char*)d_ws + WS_CTL, 0, CTL_ZERO_BYTES, stream) != hipSuccess) { fprintf(stderr, "kernel_launch: memset failed\n"); return; }
    a.ph_lo = 0; a.ph_hi = N_PHASES;
    hipLaunchKernelGGL(mk_fwd, dim3(grid), dim3(NWAVES * 64), LDS_BYTES, stream, a);
}
```

```cpp
#define S5_SIMPLE 1
#include <hip/hip_runtime.h>
#include <cstdio>
#include <cstdint>
#include <cmath>

constexpr int D = 1024, BATCH = 8, SEQ = 2048, DEPTH = 2, M = BATCH * SEQ;
constexpr int DFF = 2816, INW = 6672, PW = 6912;
constexpr int ADA = 9 * D;
constexpr float EPS = 1e-6f;
constexpr float LOG2E = 1.4426950408889634f;
constexpr float QSCALE = 0.125f * LOG2E;
constexpr int C_GV = 0, C_DQ = 512, C_DK = 1024, C_DV = 1536, C_GQ = 2048, C_GK = 2304, C_GR = 2560, C_SU = 3072, C_GATE = 3584, C_GA = 6656;
constexpr int C_O = C_GQ;
constexpr int C_YGLA = C_GV, C_YDIFF = C_DQ, C_YS5 = C_DK, C_YS5PRE = C_SU, C_MERGED = C_GQ;

typedef unsigned short bf16_t;
typedef short bf16x8 __attribute__((ext_vector_type(8)));
typedef float f32x4 __attribute__((ext_vector_type(4)));
typedef unsigned u32x4 __attribute__((ext_vector_type(4)));
__device__ __forceinline__ float bf2f(bf16_t v) { return __uint_as_float(((unsigned)v) << 16); }
__device__ __forceinline__ bf16_t f2bf(float f) { unsigned u = __float_as_uint(f); return (bf16_t)((u + 0x7fffu + ((u >> 16) & 1u)) >> 16); }
__device__ __forceinline__ unsigned pk2(float lo, float hi) { return (unsigned)f2bf(lo) | ((unsigned)f2bf(hi) << 16); }
__device__ __forceinline__ float blo(unsigned w) { return __uint_as_float(w << 16); }
__device__ __forceinline__ float bhi(unsigned w) { return __uint_as_float(w & 0xffff0000u); }
__device__ __forceinline__ float sigmoidf_(float x) { return 1.f / (1.f + __expf(-x)); }
__device__ __forceinline__ float siluf_(float x) { return x / (1.f + __expf(-x)); }
template <int MSK> __device__ __forceinline__ float swz_xor(float v) { return __int_as_float(__builtin_amdgcn_ds_swizzle(__float_as_int(v), 0x1F | (MSK << 10))); }
__device__ __forceinline__ float xor32_sum(float v) { auto rr = __builtin_amdgcn_permlane32_swap(__float_as_uint(v), __float_as_uint(v), false, false); return __uint_as_float(rr[0]) + __uint_as_float(rr[1]); }
__device__ __forceinline__ float wave_sum(float v) {
    v += swz_xor<1>(v); v += swz_xor<2>(v); v += swz_xor<4>(v); v += swz_xor<8>(v); v += swz_xor<16>(v);
    return xor32_sum(v);
}
__device__ __forceinline__ int ref2my(int c) {
    if (c < 256) return C_GQ + c;
    if (c < 512) return C_GK + (c - 256);
    if (c < 1024) return C_GV + (c - 512);
    if (c < 1536) return C_GR + (c - 1024);
    if (c < 1552) return C_GA + (c - 1536);
    if (c < 2064) return C_DQ + (c - 1552);
    if (c < 2576) return C_DK + (c - 2064);
    if (c < 3088) return C_DV + (c - 2576);
    if (c < 3600) return C_SU + (c - 3088);
    return C_GATE + (c - 3600);
}
__device__ __forceinline__ int my2ref(int c) {
    if (c < C_DQ) return 512 + c;
    if (c < C_DK) return 1552 + (c - C_DQ);
    if (c < C_DV) return 2064 + (c - C_DK);
    if (c < C_GQ) return 2576 + (c - C_DV);
    if (c < C_GK) return c - C_GQ;
    if (c < C_GR) return 256 + (c - C_GK);
    if (c < C_SU) return 1024 + (c - C_GR);
    if (c < C_GATE) return 3088 + (c - C_SU);
    if (c < C_GA) return 3600 + (c - C_GATE);
    if (c < C_GA + 16) return 1536 + (c - C_GA);
    return -1;
}
__device__ const unsigned char T5B[128] = {0, 1, 2, 3, 4, 5, 6, 7, 8, 9, 10, 11, 12, 13, 14, 15, 16, 16, 16, 17, 17, 18, 18, 18, 19, 19, 19, 20, 20, 20, 20, 21, 21, 21, 21, 22, 22, 22, 22, 22, 23, 23, 23, 23, 23, 23, 24, 24, 24, 24, 24, 24, 25, 25, 25, 25, 25, 25, 25, 26, 26, 26, 26, 26, 26, 26, 26, 27, 27, 27, 27, 27, 27, 27, 27, 27, 27, 28, 28, 28, 28, 28, 28, 28, 28, 28, 28, 29, 29, 29, 29, 29, 29, 29, 29, 29, 29, 29, 29, 30, 30, 30, 30, 30, 30, 30, 30, 30, 30, 30, 30, 30, 30, 31, 31, 31, 31, 31, 31, 31, 31, 31, 31, 31, 31, 31, 31, 31};

constexpr size_t MiB = 1u << 20;
constexpr size_t WS_CTL = 0, CTL_ZERO_BYTES = 1 * MiB, WS_ADA = 1 * MiB, WS_S5ST = 2 * MiB, WS_W = 6 * MiB, WS_U = 59 * MiB, WS_GLA = 91 * MiB, WS_R0 = 123 * MiB, WS_S5ST2 = 339 * MiB, WS_END = 343 * MiB;
constexpr size_t WS_Y = WS_GLA;
constexpr size_t W_UP1 = 0, W_DN1 = W_UP1 + (size_t)2 * DFF * D, W_UP2 = W_DN1 + (size_t)D * DFF, W_DN2 = W_UP2 + (size_t)2 * DFF * D, W_IN = W_DN2 + (size_t)D * DFF,
                 W_GLU = W_IN + (size_t)PW * D, W_BR = W_GLU + (size_t)1024 * 512, W_OUT = W_BR + (size_t)3 * 1024 * 512, W_END = W_OUT + (size_t)D * D;
static_assert(W_END * 2 <= 53 * MiB, "weights fit");

__device__ __forceinline__ void rowpass_row(int row, int lane, const float* h_in, float* h_out, const bf16_t* y, const float* gpost, const float* gate, float coef,
                                            const float* gpre, const float* shift, const float* scale, bf16_t* u) {
    const int b = row / SEQ;
    f32x4 hv[4];
#pragma unroll
    for (int j = 0; j < 4; ++j) hv[j] = *(const f32x4*)(h_in + (size_t)row * D + j * 256 + lane * 4);
    if (y) {
        float yv[4][4]; float ss = 0.f;
#pragma unroll
        for (int j = 0; j < 4; ++j) {
            const uint2 raw = *(const uint2*)(y + (size_t)row * D + j * 256 + lane * 4);
            yv[j][0] = blo(raw.x); yv[j][1] = bhi(raw.x); yv[j][2] = blo(raw.y); yv[j][3] = bhi(raw.y);
#pragma unroll
            for (int i = 0; i < 4; ++i) ss += yv[j][i] * yv[j][i];
        }
        const float r = rsqrtf(wave_sum(ss) * (1.f / D) + EPS);
#pragma unroll
        for (int j = 0; j < 4; ++j) {
            const int c0 = j * 256 + lane * 4;
            const f32x4 gp = *(const f32x4*)(gpost + c0), gt = *(const f32x4*)(gate + (size_t)b * ADA + c0);
#pragma unroll
            for (int i = 0; i < 4; ++i) hv[j][i] += coef * gt[i] * (yv[j][i] * r * gp[i]);
        }
    }
    if (y || h_in != h_out) {
#pragma unroll
        for (int j = 0; j < 4; ++j) *(f32x4*)(h_out + (size_t)row * D + j * 256 + lane * 4) = hv[j];
    }
    if (u) {
        float ss = 0.f;
#pragma unroll
        for (int j = 0; j < 4; ++j)
#pragma unroll
            for (int i = 0; i < 4; ++i) ss += hv[j][i] * hv[j][i];
        const float r = rsqrtf(wave_sum(ss) * (1.f / D) + EPS);
#pragma unroll
        for (int j = 0; j < 4; ++j) {
            const int c0 = j * 256 + lane * 4;
            const f32x4 g = *(const f32x4*)(gpre + c0), sh = *(const f32x4*)(shift + (size_t)b * ADA + c0), sc = *(const f32x4*)(scale + (size_t)b * ADA + c0);
            float o[4];
#pragma unroll
            for (int i = 0; i < 4; ++i) o[i] = hv[j][i] * r * g[i] * (1.f + sc[i]) + sh[i];
            uint2 w; w.x = pk2(o[0], o[1]); w.y = pk2(o[2], o[3]);
            *(uint2*)(u + (size_t)row * D + c0) = w;
        }
    }
}

__device__ __forceinline__ void diff_fin_row(bf16_t* r, int lane, float lam, const float* norm_g, float lam_init) {
#pragma unroll
    for (int h = 0; h < 4; ++h) {
        const unsigned a = *(const unsigned*)(r + C_O + (2 * h) * 128 + lane * 2), c = *(const unsigned*)(r + C_O + (2 * h + 1) * 128 + lane * 2);
        const float o0 = blo(a) - lam * blo(c), o1 = bhi(a) - lam * bhi(c);
        const float rs = rsqrtf(wave_sum(o0 * o0 + o1 * o1) * (1.f / 128.f) + EPS) * (1.f - lam_init);
        const float g0 = norm_g[h * 128 + lane * 2], g1 = norm_g[h * 128 + lane * 2 + 1];
        *(unsigned*)(r + C_YDIFF + h * 128 + lane * 2) = pk2(o0 * rs * g0, o1 * rs * g1);
    }
}

namespace pg8 {
#define PG8_LAS __attribute__((address_space(3)))
constexpr int BM = 256, BK = 64, HALF = 128, HTB = HALF * BK * 2  , STAGE_BYTES = 8 * HTB, NXCD = 8, WGM = 8;

__host__ __device__ __forceinline__ int lds_byte(int r, int c) { const int st = (r >> 4) * 2 + (c >> 5), rr = r & 15, cc = c & 31, ob = rr * 64 + cc * 2; return st * 1024 + (ob ^ (((ob >> 9) & 1) << 5)); }
__host__ __device__ __forceinline__ void stage_rc(int b, int& R, int& C) { const int st = b / 1024, sb = b % 1024, swz = sb ^ (((sb >> 9) & 1) << 5); R = (st >> 1) * 16 + swz / 64; C = (st & 1) * 32 + (swz % 64) / 2; }
__host__ __device__ __forceinline__ int perm32(int rho) { const int n = rho >> 4, i = rho & 15; return 8 * (i >> 2) + 4 * n + (i & 3); }

struct Unit { int pm, pn, z; };
template <int LDA, int LDB, int KK, int ZA, int ZB> struct GemmT { const bf16_t* A; const bf16_t* Bt; static constexpr int lda = LDA, ldb = LDB, K = KK; static constexpr size_t zA = ZA, zB = ZB; };

struct StaticOrder {
    int nM, nN, nwg, G, c, nZ;
    __host__ __device__ void init(int M_, int N_, int G_, int c_, int nZ_ = 1) { nM = M_ / BM; nN = N_ / BM; nwg = nM * nN; G = G_; c = c_; nZ = nZ_; }
    __host__ __device__ bool next(int i, Unit& u) const {
        const long L = (long)(i / nZ) * G + c; if (L >= nwg) return false;
        int wgid = (int)L; { const int q = nwg / NXCD, r = nwg % NXCD, xcd = wgid % NXCD, off = wgid / NXCD; wgid = (xcd < r ? xcd * (q + 1) : r * (q + 1) + (xcd - r) * q) + off; }
        const int nig = WGM * nN, gid = wgid / nig, fm = gid * WGM, gsz = (nM - fm) < WGM ? (nM - fm) : WGM;
        u.pm = fm + ((wgid % nig) % gsz); u.pn = (wgid % nig) / gsz; u.z = i % nZ; return true;
    }
    __device__ __forceinline__ void a_ready(const Unit&) const {}
    __device__ __forceinline__ void done(const Unit&) const {}
};
__device__ __forceinline__ unsigned cvt_pk_bf16(float lo, float hi) { unsigned r; asm volatile("v_cvt_pk_bf16_f32 %0, %1, %2" : "=v"(r) : "v"(lo), "v"(hi)); return r; }

__device__ __forceinline__ u32x4 pack8(const f32x4 v0, const f32x4 v1) { u32x4 w; w.x = cvt_pk_bf16(v0[0], v0[1]); w.y = cvt_pk_bf16(v0[2], v0[3]); w.z = cvt_pk_bf16(v1[0], v1[1]); w.w = cvt_pk_bf16(v1[2], v1[3]); return w; }
__device__ __forceinline__ float fsig(float x) { return __builtin_amdgcn_rcpf(1.f + __expf(-x)); }
template <int ldc, int mode> struct EpiStore {
    static constexpr bool PERM = true, AFTER_DRAIN = false;
    bf16_t* O;
    __device__ __forceinline__ void operator()(const f32x4 (&acc)[2][2][4][2], const Unit& u, int wr, int wc, int fr, int fq) const {
        float sc = 1.f; if (mode == 1) { if (u.pn == 2 || u.pn == 3) sc = QSCALE; else if (u.pn == 8) sc = 0.125f; }
        const int row0 = u.pm * BM + wr * 64 + fr, col0 = u.pn * BM + wc * 32 + 8 * fq;
#pragma unroll
        for (int ai = 0; ai < 2; ++ai)
#pragma unroll
            for (int m = 0; m < 4; ++m) { bf16_t* rowp = O + (size_t)(row0 + ai * HALF + m * 16) * ldc + col0;
#pragma unroll
                for (int bj = 0; bj < 2; ++bj) *(u32x4*)(rowp + bj * HALF) = pack8(acc[ai][bj][m][0] * sc, acc[ai][bj][m][1] * sc); }
    }
};
struct EpiSwiGLU {
    static constexpr bool PERM = true, AFTER_DRAIN = false;
    bf16_t* H;
    __device__ __forceinline__ void operator()(const f32x4 (&acc)[2][2][4][2], const Unit& u, int wr, int wc, int fr, int fq) const {
        const int row0 = u.pm * BM + wr * 64 + fr, col0 = u.pn * HALF + wc * 32 + 8 * fq;
#pragma unroll
        for (int ai = 0; ai < 2; ++ai)
#pragma unroll
            for (int m = 0; m < 4; ++m) { f32x4 o[2];
#pragma unroll
                for (int n = 0; n < 2; ++n)
#pragma unroll
                    for (int j = 0; j < 4; ++j) { const float g = acc[ai][0][m][n][j]; o[n][j] = g * fsig(g) * acc[ai][1][m][n][j]; }
                *(u32x4*)(H + (size_t)(row0 + ai * HALF + m * 16) * DFF + col0) = pack8(o[0], o[1]); }
    }
};
struct EpiGLU {
    static constexpr bool PERM = true, AFTER_DRAIN = false;
    bf16_t* P; const float* bias;
    __device__ __forceinline__ void operator()(const f32x4 (&acc)[2][2][4][2], const Unit& u, int wr, int wc, int fr, int fq) const {
        const int row0 = u.pm * BM + wr * 64 + fr, col0 = u.pn * HALF + wc * 32 + 8 * fq;
        f32x4 bv[2], bg[2];
#pragma unroll
        for (int n = 0; n < 2; ++n) { bv[n] = *(const f32x4*)(bias + col0 + 4 * n); bg[n] = *(const f32x4*)(bias + 512 + col0 + 4 * n); }
#pragma unroll
        for (int ai = 0; ai < 2; ++ai)
#pragma unroll
            for (int m = 0; m < 4; ++m) { f32x4 o[2];
#pragma unroll
                for (int n = 0; n < 2; ++n)
#pragma unroll
                    for (int j = 0; j < 4; ++j) o[n][j] = (acc[ai][0][m][n][j] + bv[n][j]) * fsig(acc[ai][1][m][n][j] + bg[n][j]);
                *(u32x4*)(P + (size_t)(row0 + ai * HALF + m * 16) * PW + C_YS5 + col0) = pack8(o[0], o[1]); }
    }
};
struct EpiBranch {
    static constexpr bool PERM = true, AFTER_DRAIN = false;
    bf16_t* P;
    __device__ __forceinline__ void operator()(const f32x4 (&acc)[2][2][4][2], const Unit& u, int wr, int wc, int fr, int fq) const {
        const int row0 = u.pm * BM + wr * 64 + fr, col0 = u.pn * BM + wc * 32 + 8 * fq;
#pragma unroll
        for (int ai = 0; ai < 2; ++ai)
#pragma unroll
            for (int m = 0; m < 4; ++m) { bf16_t* rowp = P + (size_t)(row0 + ai * HALF + m * 16) * PW;
#pragma unroll
                for (int bj = 0; bj < 2; ++bj) { const int col = col0 + bj * HALF;
                    const u32x4 gw = *(const u32x4*)(rowp + C_GATE + u.z * D + col);
                    u32x4 pw = (u32x4){0u, 0u, 0u, 0u}; if (u.z > 0) pw = *(const u32x4*)(rowp + C_MERGED + col);
                    f32x4 o[2];
#pragma unroll
                    for (int n = 0; n < 2; ++n) { const unsigned g0 = gw[2 * n], g1 = gw[2 * n + 1], p0 = pw[2 * n], p1 = pw[2 * n + 1];
                        o[n][0] = blo(p0) + fsig(blo(g0)) * acc[ai][bj][m][n][0]; o[n][1] = bhi(p0) + fsig(bhi(g0)) * acc[ai][bj][m][n][1];
                        o[n][2] = blo(p1) + fsig(blo(g1)) * acc[ai][bj][m][n][2]; o[n][3] = bhi(p1) + fsig(bhi(g1)) * acc[ai][bj][m][n][3]; }
                    *(u32x4*)(rowp + C_MERGED + col) = pack8(o[0], o[1]); } }
    }
};

template <class Epi, class Sched, class GemmX, bool ALIGN_EPI = false, bool SP2 = false>
__device__ __forceinline__ void gemm_phase(PG8_LAS unsigned char* lds, const GemmX g, const Sched& S, const Epi& E) {
    int tid_ = threadIdx.x; asm volatile("" : "+v"(tid_));
    const int tid = tid_, wid = __builtin_amdgcn_readfirstlane(tid >> 6), lane = tid & 63, wr = wid >> 2, wc = wid & 3, fr = lane & 15, fq = lane >> 4;
    const int K = g.K, nt = K / BK;
    unsigned voffA[2], voffB[2];
#pragma unroll
    for (int i = 0; i < 2; ++i) { int R, C; stage_rc(tid * 16 + i * 8192, R, C); const int Rb = Epi::PERM ? ((R & ~31) + perm32(R & 31)) : R;
        voffA[i] = (unsigned)(R * g.lda + C) * 2u; voffB[i] = (unsigned)(Rb * g.ldb + C) * 2u; }
    const size_t kstep = (size_t)(BK * 2);
    const size_t hstepA = (size_t)HALF * g.lda * 2, hstepB = (size_t)HALF * g.ldb * 2;
    const size_t tstepA = 2 * hstepA, tstepB = 2 * hstepB;
    const unsigned ldsw = (unsigned)wid * 1024u;
    const int aoff = lds_byte(wr * 64 + fr, fq * 8), boff = lds_byte(wc * 32 + fr, fq * 8);
#define PG8_SA(b, h) (((b) * 2 + (h)) * HTB)
#define PG8_SB(b, h) ((4 + (b) * 2 + (h)) * HTB)
#define PG8_STAGE(bufoff, gbase, voff) do { _Pragma("unroll") for (int _i = 0; _i < 2; ++_i) \
        __builtin_amdgcn_global_load_lds((const unsigned*)((const char*)(gbase) + (voff)[_i]), (PG8_LAS unsigned*)(lds + (bufoff) + ldsw + _i * 8192), 16, 0, 0); } while (0)
#define PG8_LDA(dst, b, h) do { _Pragma("unroll") for (int m = 0; m < 4; ++m) _Pragma("unroll") for (int k = 0; k < 2; ++k) dst[m][k] = *(const PG8_LAS bf16x8*)(lds + PG8_SA(b, h) + aoff + m * 2048 + k * 1024); } while (0)
#define PG8_LDB(dst, b, h) do { _Pragma("unroll") for (int n = 0; n < 2; ++n) _Pragma("unroll") for (int k = 0; k < 2; ++k) dst[n][k] = *(const PG8_LAS bf16x8*)(lds + PG8_SB(b, h) + boff + n * 2048 + k * 1024); } while (0)
#define PG8_MMA(ai, bj, At, Bt) do { __builtin_amdgcn_s_setprio(1); _Pragma("unroll") for (int m = 0; m < 4; ++m) _Pragma("unroll") for (int n = 0; n < 2; ++n) _Pragma("unroll") for (int k = 0; k < 2; ++k) \
        acc[ai][bj][m][n] = __builtin_amdgcn_mfma_f32_16x16x32_bf16(Bt[n][k], At[m][k], acc[ai][bj][m][n], 0, 0, 0); __builtin_amdgcn_s_setprio(0); } while (0)
#define PG8_WAIT_V(n) asm volatile("s_waitcnt vmcnt(" #n ")" ::: "memory")
#define PG8_WAIT_L(n) asm volatile("s_waitcnt lgkmcnt(" #n ")" ::: "memory")
#define PG8_BAR __builtin_amdgcn_s_barrier()
#define PG8_SCHED __builtin_amdgcn_sched_barrier(0)
    Unit cur, nxt; int ui = 0;
    if (!S.next(0, cur)) return;
    f32x4 acc[2][2][4][2];
#pragma unroll
    for (int a = 0; a < 2; ++a)
#pragma unroll
        for (int b = 0; b < 2; ++b)
#pragma unroll
            for (int m = 0; m < 4; ++m)
#pragma unroll
                for (int n = 0; n < 2; ++n) acc[a][b][m][n] = (f32x4){0.f, 0.f, 0.f, 0.f};
    bf16x8 At[4][2], B0[2][2], B1[2][2];
    const char* cA = (const char*)g.A + (size_t)cur.pm * tstepA + (size_t)cur.z * g.zA; const char* cB = (const char*)g.Bt + (size_t)cur.pn * tstepB + (size_t)cur.z * g.zB;
    S.a_ready(cur);
    if constexpr (SP2) {
        PG8_STAGE(PG8_SB(0, 0), cB, voffB); PG8_STAGE(PG8_SB(0, 1), cB + hstepB, voffB); PG8_STAGE(PG8_SA(0, 0), cA, voffA); PG8_STAGE(PG8_SA(0, 1), cA + hstepA, voffA);
        if (wr == 1) PG8_BAR;
        PG8_WAIT_V(2); PG8_BAR;
        PG8_STAGE(PG8_SB(1, 0), cB + kstep, voffB); PG8_STAGE(PG8_SA(1, 0), cA + kstep, voffA); PG8_STAGE(PG8_SB(1, 1), cB + hstepB + kstep, voffB);
        PG8_WAIT_V(6); PG8_BAR;
    } else {
        PG8_STAGE(PG8_SB(0, 0), cB, voffB); PG8_STAGE(PG8_SA(0, 0), cA, voffA); PG8_STAGE(PG8_SB(0, 1), cB + hstepB, voffB); PG8_STAGE(PG8_SA(0, 1), cA + hstepA, voffA);
        if (wr == 1) PG8_BAR;
        PG8_WAIT_V(4); PG8_BAR;
        PG8_STAGE(PG8_SB(1, 0), cB + kstep, voffB); PG8_STAGE(PG8_SA(1, 0), cA + kstep, voffA); PG8_STAGE(PG8_SB(1, 1), cB + hstepB + kstep, voffB);
        PG8_WAIT_V(6); PG8_BAR;
    }
    for (;;) {
        const bool has_next = S.next(ui + 1, nxt);
        const char* nA = has_next ? (const char*)g.A + (size_t)nxt.pm * tstepA + (size_t)nxt.z * g.zA : cA; const char* nB = has_next ? (const char*)g.Bt + (size_t)nxt.pn * tstepB + (size_t)nxt.z * g.zB : cB;
        for (int t = 0; t < nt; t += 2) {
            const bool last = (t == nt - 2);
            const char* a1 = cA + (size_t)(t + 1) * kstep;
            const char* a2 = last ? nA : cA + (size_t)(t + 2) * kstep; const char* b2 = last ? nB : cB + (size_t)(t + 2) * kstep;
            const char* a3 = a2 + kstep; const char* b3 = b2 + kstep;
            if (last && has_next) S.a_ready(nxt);
            if constexpr (SP2) {
            PG8_LDB(B0, 0, 0); PG8_LDB(B1, 0, 1); PG8_SCHED; PG8_LDA(At, 0, 0); PG8_STAGE(PG8_SA(1, 1), a1 + hstepA, voffA);
            PG8_WAIT_V(8); PG8_WAIT_L(0); PG8_BAR; PG8_MMA(0, 0, At, B0); PG8_MMA(0, 1, At, B1); PG8_BAR; PG8_SCHED;
            PG8_LDA(At, 0, 1); PG8_STAGE(PG8_SB(0, 0), b2, voffB); PG8_STAGE(PG8_SB(0, 1), b2 + hstepB, voffB); PG8_STAGE(PG8_SA(0, 0), a2, voffA);
            PG8_WAIT_V(8); PG8_WAIT_L(0); PG8_BAR; PG8_MMA(1, 0, At, B0); PG8_MMA(1, 1, At, B1); PG8_BAR; PG8_SCHED;
            PG8_LDB(B0, 1, 0); PG8_LDB(B1, 1, 1); PG8_SCHED; PG8_LDA(At, 1, 0); PG8_STAGE(PG8_SA(0, 1), a2 + hstepA, voffA);
            PG8_WAIT_V(8); PG8_WAIT_L(0); PG8_BAR; PG8_MMA(0, 0, At, B0); PG8_MMA(0, 1, At, B1); PG8_BAR; PG8_SCHED;
            PG8_LDA(At, 1, 1); PG8_STAGE(PG8_SB(1, 0), b3, voffB); PG8_STAGE(PG8_SB(1, 1), b3 + hstepB, voffB); PG8_STAGE(PG8_SA(1, 0), a3, voffA);
            PG8_WAIT_V(8); PG8_WAIT_L(0); PG8_BAR; PG8_MMA(1, 0, At, B0); PG8_MMA(1, 1, At, B1); PG8_BAR; PG8_SCHED;
            } else {
            PG8_LDB(B0, 0, 0); PG8_SCHED; PG8_LDA(At, 0, 0); PG8_STAGE(PG8_SA(1, 1), a1 + hstepA, voffA);
            PG8_WAIT_L(8); PG8_BAR; PG8_WAIT_L(0); PG8_MMA(0, 0, At, B0); PG8_BAR; PG8_SCHED;
            PG8_LDB(B1, 0, 1); PG8_STAGE(PG8_SB(0, 0), b2, voffB);
            PG8_BAR; PG8_WAIT_L(0); PG8_MMA(0, 1, At, B1); PG8_BAR;
            PG8_LDA(At, 0, 1); PG8_STAGE(PG8_SA(0, 0), a2, voffA);
            PG8_BAR; PG8_WAIT_L(0); PG8_MMA(1, 0, At, B0); PG8_BAR; PG8_SCHED;
            PG8_STAGE(PG8_SB(0, 1), b2 + hstepB, voffB);
            PG8_WAIT_V(6); PG8_BAR; PG8_MMA(1, 1, At, B1); PG8_BAR;
            PG8_LDB(B0, 1, 0); PG8_SCHED; PG8_LDA(At, 1, 0); PG8_STAGE(PG8_SA(0, 1), a2 + hstepA, voffA);
            PG8_WAIT_L(8); PG8_BAR; PG8_WAIT_L(0); PG8_MMA(0, 0, At, B0); PG8_BAR; PG8_SCHED;
            PG8_LDB(B1, 1, 1); PG8_STAGE(PG8_SB(1, 0), b3, voffB);
            PG8_BAR; PG8_WAIT_L(0); PG8_MMA(0, 1, At, B1); PG8_BAR;
            PG8_LDA(At, 1, 1); PG8_STAGE(PG8_SA(1, 0), a3, voffA);
            PG8_BAR; PG8_WAIT_L(0); PG8_MMA(1, 0, At, B0); PG8_BAR; PG8_SCHED;
            PG8_STAGE(PG8_SB(1, 1), b3 + hstepB, voffB);
            PG8_WAIT_V(6); PG8_BAR; PG8_MMA(1, 1, At, B1); PG8_BAR;
            }
        }
        if constexpr (ALIGN_EPI) { if (wr == 0) PG8_BAR; }
        if constexpr (!Epi::AFTER_DRAIN) { E(acc, cur, wr, wc, fr, fq); S.done(cur); }
        if (!has_next) break;
#pragma unroll
        for (int a = 0; a < 2; ++a)
#pragma unroll
            for (int b = 0; b < 2; ++b)
#pragma unroll
                for (int m = 0; m < 4; ++m)
#pragma unroll
                    for (int n = 0; n < 2; ++n) acc[a][b][m][n] = (f32x4){0.f, 0.f, 0.f, 0.f};
        cur = nxt; cA = nA; cB = nB; ++ui;
        if constexpr (ALIGN_EPI) { if (wr == 1) PG8_BAR; }
    }
    PG8_WAIT_V(0);
    if constexpr (!ALIGN_EPI) { if (wr == 0) PG8_BAR; }
    PG8_BAR;
    if constexpr (Epi::AFTER_DRAIN) { E.fused(acc, cur, wr, wc, fr, fq, lds, wid, lane); S.done(cur); }
#undef PG8_SA
#undef PG8_SB
#undef PG8_STAGE
#undef PG8_LDA
#undef PG8_LDB
#undef PG8_MMA
#undef PG8_WAIT_V
#undef PG8_WAIT_L
#undef PG8_BAR
#undef PG8_SCHED
}
}

namespace attn_body {
using bf16=unsigned short;
using bf16x8=__attribute__((ext_vector_type(8)))short;
using s16x4=__attribute__((ext_vector_type(4)))short;
using f32x16=__attribute__((ext_vector_type(16)))float;
using u32x4=__attribute__((ext_vector_type(4)))unsigned;
constexpr int NMAP=8,SEQ=2048,D=64,DM=::PW;
constexpr int NW=8,QBLK=32,QB=QBLK*NW,KVBLK=64,NQB=SEQ/QB;

__device__ __forceinline__ int crow(int r,int hi){return (r&3)+8*(r>>2)+4*hi;}
#define SBAR() __builtin_amdgcn_sched_barrier(0)
__device__ __forceinline__ void cmask(f32x16&p0,f32x16&p1,int jb,int qrel,int hi){
  const float NEG=-INFINITY; int kb=64*jb+4*hi;
  #pragma unroll
  for(int r=0;r<16;++r){int kv=kb+(r&3)+8*(r>>2); if(kv>qrel)p0[r]=NEG; if(kv+32>qrel)p1[r]=NEG;}
}

typedef __attribute__((address_space(3))) const float* lds_cfptr;
__device__ __forceinline__ void addbias(f32x16&p0,f32x16&p1,int jb,int qrel,int hi,lds_cfptr tab){
  const int base=qrel-64*jb-4*hi;
  #pragma unroll
  for(int r=0;r<16;++r){const int d0=base-((r&3)+8*(r>>2)); const int i0=d0<0?0:(d0>127?127:d0); const int d1=d0-32; const int i1=d1<0?0:(d1>127?127:d1); p0[r]+=tab[i0]; p1[r]+=tab[i1];}
}
constexpr int NSLOT=3, SLOTB=8192;
constexpr int LDS_K=0, LDS_V=NSLOT*SLOTB, LDS_WS=2*NSLOT*SLOTB, LDS_OST=LDS_WS+NW*64*4, LDS_TAB=LDS_OST+NW*4096, LDS_BYTES=LDS_TAB+512;
constexpr float C2=0.125f*1.4426950408889634f;
__device__ __forceinline__ void glds16(const void*gsrc,unsigned lds_dst){unsigned keep;
  asm volatile("s_mov_b32 %0, m0\n\ts_mov_b32 m0, %2\n\ts_nop 0\n\tglobal_load_lds_dwordx4 %1, off\n\ts_mov_b32 m0, %0":"=&s"(keep):"v"(gsrc),"s"(lds_dst):"memory");}
__device__ __forceinline__ float max3f(float a,float b,float c){float r;asm("v_max3_f32 %0, %1, %2, %3":"=v"(r):"v"(a),"v"(b),"v"(c));return r;}
__device__ __forceinline__ float max2f(float a,float b){float r;asm("v_max_f32_e32 %0, %1, %2":"=v"(r):"v"(a),"v"(b));return r;}
__device__ __forceinline__ float fadd_s(float a,float b){float r;asm("v_add_f32_e32 %0, %1, %2":"=v"(r):"v"(a),"v"(b));return r;}
__device__ __forceinline__ float fsub_s(float a,float b){float r;asm("v_sub_f32_e32 %0, %1, %2":"=v"(r):"v"(a),"v"(b));return r;}
typedef float f32x2_t __attribute__((ext_vector_type(2))); typedef __bf16 bf16x2_t __attribute__((ext_vector_type(2)));
__device__ __forceinline__ unsigned cvtpk_s(float lo,float hi){f32x2_t v={lo,hi};bf16x2_t b=__builtin_convertvector(v,bf16x2_t);return __builtin_bit_cast(unsigned,b);}
#define WAIT_BAR(N) asm volatile("s_waitcnt vmcnt(" #N ") lgkmcnt(0)\n\ts_barrier":::"memory")

__device__ __forceinline__ void qkt(f32x16&p0,f32x16&p1,const char*Kslot,const bf16x8*qr,const f32x16&negm,int r32,int hi){
  const char*kb=Kslot+hi*1024+r32*16;
  #pragma unroll
  for(int d0=0;d0<4;++d0){
    const bf16x8 b0=*reinterpret_cast<const bf16x8*>(kb+d0*2048);
    const bf16x8 b1=*reinterpret_cast<const bf16x8*>(kb+d0*2048+512);
    if(d0==0){p0=__builtin_amdgcn_mfma_f32_32x32x16_bf16(b0,qr[0],negm,0,0,0);p1=__builtin_amdgcn_mfma_f32_32x32x16_bf16(b1,qr[0],negm,0,0,0);}
    else{p0=__builtin_amdgcn_mfma_f32_32x32x16_bf16(b0,qr[d0],p0,0,0,0);p1=__builtin_amdgcn_mfma_f32_32x32x16_bf16(b1,qr[d0],p1,0,0,0);}}
}
typedef __attribute__((address_space(3))) const char* lds_cptr;
typedef short v4i16_t __attribute__((ext_vector_type(4)));
__device__ __forceinline__ void kload8(bf16x8*kf,lds_cptr kp){
  kf[0]=*(const __attribute__((address_space(3))) bf16x8*)(kp);      kf[1]=*(const __attribute__((address_space(3))) bf16x8*)(kp+512);
  kf[2]=*(const __attribute__((address_space(3))) bf16x8*)(kp+2048); kf[3]=*(const __attribute__((address_space(3))) bf16x8*)(kp+2560);
  kf[4]=*(const __attribute__((address_space(3))) bf16x8*)(kp+4096); kf[5]=*(const __attribute__((address_space(3))) bf16x8*)(kp+4608);
  kf[6]=*(const __attribute__((address_space(3))) bf16x8*)(kp+6144); kf[7]=*(const __attribute__((address_space(3))) bf16x8*)(kp+6656);
}
__device__ __forceinline__ void kload2(bf16x8*kf,lds_cptr kp,int j){ kf[2*j]=*(const __attribute__((address_space(3))) bf16x8*)(kp+j*2048); kf[2*j+1]=*(const __attribute__((address_space(3))) bf16x8*)(kp+j*2048+512); }
__device__ __forceinline__ s16x4 vtr(lds_cptr p){ return __builtin_bit_cast(s16x4,__builtin_amdgcn_ds_read_tr16_b64_v4i16((__attribute__((address_space(3))) v4i16_t*)p)); }
__device__ __forceinline__ float rowmax(const f32x16&p0,const f32x16&p1){
  float a=max3f(p0[0],p0[1],p1[0]),b=max3f(p0[2],p0[3],p1[1]);a=max3f(a,p1[2],p1[3]);
  #pragma unroll
  for(int r=4;r<16;r+=4){a=max3f(a,p0[r],p0[r+1]);b=max3f(b,p0[r+2],p0[r+3]);a=max3f(a,p1[r],p1[r+1]);b=max3f(b,p1[r+2],p1[r+3]);}
  const float m=max2f(a,b);
  auto rr=__builtin_amdgcn_permlane32_swap(__float_as_uint(m),__float_as_uint(m),false,false);
  return max2f(__uint_as_float(rr[0]),__uint_as_float(rr[1]));
}
__device__ __forceinline__ void pv(f32x16*o,int vb,bf16x8 pa0,bf16x8 pa1,bf16x8 pa2,bf16x8 pa3){
  #pragma unroll
  for(int d0=0;d0<2;++d0){s16x4 lo[4],hi[4];
    #pragma unroll
    for(int ks=0;ks<4;++ks){
      asm volatile("ds_read_b64_tr_b16 %0,%1 offset:%c2":"=&v"(lo[ks]):"v"(vb),"i"(d0*4096+ks*1024):"memory");
      asm volatile("ds_read_b64_tr_b16 %0,%1 offset:%c2":"=&v"(hi[ks]):"v"(vb),"i"(d0*4096+ks*1024+512):"memory");}
    asm volatile("s_waitcnt lgkmcnt(0)":::"memory");SBAR();
    #define PK(k) (bf16x8){lo[k][0],lo[k][1],lo[k][2],lo[k][3],hi[k][0],hi[k][1],hi[k][2],hi[k][3]}
    o[d0]=__builtin_amdgcn_mfma_f32_32x32x16_bf16(pa0,PK(0),o[d0],0,0,0);
    o[d0]=__builtin_amdgcn_mfma_f32_32x32x16_bf16(pa1,PK(1),o[d0],0,0,0);
    o[d0]=__builtin_amdgcn_mfma_f32_32x32x16_bf16(pa2,PK(2),o[d0],0,0,0);
    o[d0]=__builtin_amdgcn_mfma_f32_32x32x16_bf16(pa3,PK(3),o[d0],0,0,0);
    #undef PK
  }
}

#ifndef ATTN_STORE16
#define ATTN_STORE16(p,v) (*(u32x4*)(p)=(v))
#endif
template<int THRL> __device__ __forceinline__ void attn_unit(int b,int m,int vh,int qb,const bf16*P,const float*rel_bias,char*shm){
  const bf16*Q=P+::C_DQ+m*64; const bf16*K=P+::C_DK+m*64; const bf16*V=P+::C_DV+(m>>1)*128+vh*64; bf16*O=(bf16*)P+::C_O+m*128+vh*64;
  int tid_=threadIdx.x; asm volatile("":"+v"(tid_));
  const int tid=tid_,lane=tid&63,r32=lane&31,hi=lane>>5; const int wid=__builtin_amdgcn_readfirstlane(tid>>6);
  const long rowbase=(long)b*SEQ; const int q0=qb*QB;
  const bf16*Qw=Q+(rowbase+q0+wid*QBLK)*DM;
  const bf16*Kh=K+rowbase*DM,*Vh=V+rowbase*DM;
  const unsigned lds0=(unsigned)(uintptr_t)shm;
  float*wsf=(float*)(shm+LDS_WS)+wid*64;
  const bf16*ksrc=Kh+(long)lane*DM+wid*8;
  const bf16*vsrc=Vh+(long)(16*(wid&3)+(lane>>2))*DM+(wid>>2)*32+(lane&3)*8;
  const unsigned kdst=lds0+LDS_K+wid*1024, vdst=lds0+LDS_V+wid*1024;
  #define DMA_K(t,slot) glds16(ksrc+(long)(t)*KVBLK*DM,(unsigned)__builtin_amdgcn_readfirstlane(kdst+(slot)))
  #define DMA_V(t,slot) glds16(vsrc+(long)(t)*KVBLK*DM,(unsigned)__builtin_amdgcn_readfirstlane(vdst+(slot)))
  const int vb0=(int)(lds0+LDS_V)+((lane>>4)&1)*32+(lane&3)*8+(4*hi+((lane&15)>>2))*64;
  const char*Kbase=shm+LDS_K; bf16x8 kf[8];
  const lds_cptr shm3=(lds_cptr)shm; const lds_cptr kp0=shm3+LDS_K+hi*1024+r32*16; const lds_cptr vp0=shm3+LDS_V+((lane>>4)&1)*32+(lane&3)*8+(4*hi+((lane&15)>>2))*64;
  const int NT=(q0+QB)/KVBLK;
  { __attribute__((address_space(3))) float* tabw=(__attribute__((address_space(3))) float*)((lds_cptr)shm+LDS_TAB);
    if(tid<128){ const float bv=(rel_bias[(int)::T5B[tid]*8+m]-rel_bias[31*8+m])*1.4426950408889634f; tabw[tid]=bv; }
    asm volatile("s_waitcnt vmcnt(0) lgkmcnt(0)":::"memory"); }
  const lds_cfptr tab=(lds_cfptr)((lds_cptr)shm+LDS_TAB);
  DMA_K(0,0);DMA_V(0,0);DMA_K(1,SLOTB);
  bf16x8 qr[4];
  #pragma unroll
  for(int d0=0;d0<4;++d0)qr[d0]=*reinterpret_cast<const bf16x8*>(&Qw[(long)r32*DM+d0*16+hi*8]);
  float mhat=0.f,l_reg=0.f;f32x16 o[2];o[0]=f32x16{};o[1]=f32x16{};f32x16 negm=f32x16{};asm volatile("":"+v"(negm));
  const int qrel=wid*QBLK+r32;
  #define CMASK(P0,P1,t) do{int jb_=(t)-(NT-4); if(jb_>=-2)addbias(P0,P1,jb_,qrel,hi,tab); if(jb_>=0)cmask(P0,P1,jb_,qrel,hi);}while(0)
  bool resc=false;
  #define START(P0,P1) do{ const float rm=rowmax(P0,P1); resc=false; \
    { const float dl=rm; mhat=fadd_s(mhat,dl); \
      _Pragma("unroll") for(int r=0;r<16;++r){P0[r]=fsub_s(P0[r],dl);P1[r]=fsub_s(P1[r],dl);} \
      _Pragma("unroll") for(int r=0;r<16;++r)negm[r]=-mhat; asm volatile("":"+v"(negm)); } \
    _Pragma("unroll") for(int r=0;r<16;++r)P0[r]=__builtin_amdgcn_exp2f(P0[r]); }while(0)
  #define RESC() do{ if(resc){ asm volatile("s_waitcnt lgkmcnt(0)":::"memory"); \
      _Pragma("unroll") for(int d_=0;d_<2;++d_) _Pragma("unroll") for(int r=0;r<16;++r)o[d_][r]*=wsf[crow(r,hi)]; } }while(0)
  f32x16 pA0,pA1,pB0,pB1;
  int sl_prev=0,sl_cur=0,sl_next=SLOTB;
  #define ROT() do{sl_prev=sl_cur;sl_cur=sl_next;sl_next=(sl_next==(NSLOT-1)*SLOTB)?0:sl_next+SLOTB;}while(0)
  DMA_K(2,2*SLOTB);
  WAIT_BAR(3);
  qkt(pA0,pA1,Kbase,qr,negm,r32,hi);asm volatile("s_nop 15\n\ts_nop 7":"+v"(pA0),"+v"(pA1));CMASK(pA0,pA1,0);
  START(pA0,pA1);
  _Pragma("unroll") for(int r=0;r<16;++r)pA1[r]=__builtin_amdgcn_exp2f(pA1[r]);
  WAIT_BAR(0);
  DMA_K(3,0);DMA_V(1,SLOTB);
  ROT();
  kload8(kf,kp0+sl_cur);
  WAIT_BAR(2);
  s16x4 vlo[8],vhi[8]; u32x4 pw0,pw1,pw2,pw3;
  #define PKW(P,B) cvtpk_s(P[B],P[B+1])
  #define PAF(k) __builtin_bit_cast(bf16x8,pw##k)
  #define VFR(i) (bf16x8){vlo[i][0],vlo[i][1],vlo[i][2],vlo[i][3],vhi[i][0],vhi[i][1],vhi[i][2],vhi[i][3]}
  #define PIN(x) asm volatile("":"+v"(x))
  #define MX3(a,b,c) __builtin_fmaxf(__builtin_fmaxf((a),(b)),(c))
  #define GAPA(MF,A0,A1,A2,A3,W0,W1,PW) do{ MF; sacc+=A0; sacc+=A1; sacc+=A2; sacc+=A3; PIN(sacc); W0; W1; PIN(PW); SBAR(); }while(0)
  #define EX(v) __builtin_amdgcn_exp2f(v)
  #define GAPB(MF,X,B) do{ MF; X[B]=EX(X[B]); X[B+1]=EX(X[B+1]); X[B+2]=EX(X[B+2]); X[B+3]=EX(X[B+3]); PIN(X); SBAR(); }while(0)
  #define VRD(i) do{ vlo[i]=vtr(vp_+(((i)>>2)*4096+((i)&3)*1024)); vhi[i]=vtr(vp_+(((i)>>2)*4096+((i)&3)*1024+512)); }while(0)
  #define KRD(G,j) do{ if(G){ kload2(kf,kp0+sl_next,j); SBAR(); } }while(0)
  #define STEP(C0,C1,P0,P1,t,GK,GV,GL) do{ SBAR(); \
    const lds_cptr vp_=vp0+sl_prev; \
    VRD(0); SBAR(); float sacc=(P0[0]+P0[1]); \
    GAPA(C0=__builtin_amdgcn_mfma_f32_32x32x16_bf16(kf[0],qr[0],negm,0,0,0), P0[2],P0[3],P0[4],P0[5],     pw0[0]=PKW(P0,0), pw0[1]=PKW(P0,2), pw0); \
    VRD(4); SBAR(); GAPA(C1=__builtin_amdgcn_mfma_f32_32x32x16_bf16(kf[1],qr[0],negm,0,0,0), P0[6],P0[7],P0[8],P0[9],     pw0[2]=PKW(P0,4), pw0[3]=PKW(P0,6), pw0); \
    VRD(1); SBAR(); GAPA(C0=__builtin_amdgcn_mfma_f32_32x32x16_bf16(kf[2],qr[1],C0,0,0,0),   P0[10],P0[11],P0[12],P0[13], pw1[0]=PKW(P0,8), pw1[1]=PKW(P0,10), pw1); \
    VRD(5); SBAR(); GAPA(C1=__builtin_amdgcn_mfma_f32_32x32x16_bf16(kf[3],qr[1],C1,0,0,0),   P0[14],P0[15],P1[0],P1[1],   pw1[2]=PKW(P0,12),pw1[3]=PKW(P0,14), pw1); \
    VRD(2); SBAR(); GAPA(C0=__builtin_amdgcn_mfma_f32_32x32x16_bf16(kf[4],qr[2],C0,0,0,0),   P1[2],P1[3],P1[4],P1[5],     pw2[0]=PKW(P1,0), pw2[1]=PKW(P1,2), pw2); \
    VRD(6); SBAR(); GAPA(C1=__builtin_amdgcn_mfma_f32_32x32x16_bf16(kf[5],qr[2],C1,0,0,0),   P1[6],P1[7],P1[8],P1[9],     pw2[2]=PKW(P1,4), pw2[3]=PKW(P1,6), pw2); \
    VRD(3); SBAR(); GAPA(C0=__builtin_amdgcn_mfma_f32_32x32x16_bf16(kf[6],qr[3],C0,0,0,0),   P1[10],P1[11],P1[12],P1[13], pw3[0]=PKW(P1,8), pw3[1]=PKW(P1,10), pw3); \
    VRD(7); SBAR(); GAPA(C1=__builtin_amdgcn_mfma_f32_32x32x16_bf16(kf[7],qr[3],C1,0,0,0),   P1[14],P1[15],0.f,0.f,       pw3[2]=PKW(P1,12),pw3[3]=PKW(P1,14), pw3); \
    l_reg+=sacc; \
    if(GK){DMA_K((t)+3,sl_cur);} if(GV){DMA_V((t)+1,sl_next);} \
    CMASK(C0,C1,t); \
    { float a=MX3(C0[0],C0[1],C1[0]),b=MX3(C0[2],C0[3],C1[1]); a=MX3(a,C1[2],C1[3]); \
      _Pragma("unroll") for(int r=4;r<16;r+=4){a=MX3(a,C0[r],C0[r+1]);b=MX3(b,C0[r+2],C0[r+3]);a=MX3(a,C1[r],C1[r+1]);b=MX3(b,C1[r+2],C1[r+3]);} \
      float rm=__builtin_fmaxf(a,b); { auto rr=__builtin_amdgcn_permlane32_swap(__float_as_uint(rm),__float_as_uint(rm),false,false); rm=__builtin_fmaxf(__uint_as_float(rr[0]),__uint_as_float(rr[1])); } \
      resc=false; \
      if(__builtin_expect(__any(rm>(float)THRL),0)){ const float dl=__builtin_fmaxf(rm,0.f); mhat+=dl; \
        _Pragma("unroll") for(int r=0;r<16;++r){C0[r]-=dl;C1[r]-=dl;} \
        _Pragma("unroll") for(int r=0;r<16;++r)negm[r]=-mhat; asm volatile("":"+v"(negm)); \
        const float f=__builtin_amdgcn_exp2f(-dl); l_reg*=f; if(hi==0)wsf[r32]=f; resc=true; } } \
    SBAR(); \
    GAPB(o[0]=__builtin_amdgcn_mfma_f32_32x32x16_bf16(PAF(0),VFR(0),o[0],0,0,0), C0,0); \
    GAPB(o[1]=__builtin_amdgcn_mfma_f32_32x32x16_bf16(PAF(0),VFR(4),o[1],0,0,0), C0,4); \
    KRD(GL,0); GAPB(o[0]=__builtin_amdgcn_mfma_f32_32x32x16_bf16(PAF(1),VFR(1),o[0],0,0,0), C0,8); \
    KRD(GL,1); GAPB(o[1]=__builtin_amdgcn_mfma_f32_32x32x16_bf16(PAF(1),VFR(5),o[1],0,0,0), C0,12); \
    KRD(GL,2); GAPB(o[0]=__builtin_amdgcn_mfma_f32_32x32x16_bf16(PAF(2),VFR(2),o[0],0,0,0), C1,0); \
    KRD(GL,3); GAPB(o[1]=__builtin_amdgcn_mfma_f32_32x32x16_bf16(PAF(2),VFR(6),o[1],0,0,0), C1,4); \
    GAPB(o[0]=__builtin_amdgcn_mfma_f32_32x32x16_bf16(PAF(3),VFR(3),o[0],0,0,0), C1,8); \
    GAPB(o[1]=__builtin_amdgcn_mfma_f32_32x32x16_bf16(PAF(3),VFR(7),o[1],0,0,0), C1,12); \
    }while(0)
  int t=1;
  #undef CMASK
  #define CMASK(P0,P1,t) do{}while(0)
  for(;t+7<NT;t+=2){
    STEP(pB0,pB1,pA0,pA1,t,true,true,true);     WAIT_BAR(2); RESC(); ROT();
    STEP(pA0,pA1,pB0,pB1,t+1,true,true,true);   WAIT_BAR(2); RESC(); ROT();
  }
  #undef CMASK
  #define CMASK(P0,P1,t) do{int jb_=(t)-(NT-4); if(jb_>=-2)addbias(P0,P1,jb_,qrel,hi,tab); if(jb_>=0)cmask(P0,P1,jb_,qrel,hi);}while(0)
  #define ENDW(tt) do{ if((tt)+3<NT){WAIT_BAR(2);} else if((tt)+2<NT){WAIT_BAR(1);} else {WAIT_BAR(0);} }while(0)
  for(;t+1<NT;t+=2){
    STEP(pB0,pB1,pA0,pA1,t,(t+3<NT),(t+1<NT),(t+1<NT));       ENDW(t);   RESC(); ROT();
    STEP(pA0,pA1,pB0,pB1,t+1,(t+4<NT),(t+2<NT),(t+2<NT));     ENDW(t+1); RESC(); ROT();
  }
  STEP(pB0,pB1,pA0,pA1,NT-1,false,false,false); RESC();
  { float sacc=pB0[0]+pB0[1]; _Pragma("unroll") for(int r=2;r<16;++r)sacc+=pB0[r]; _Pragma("unroll") for(int r=0;r<16;++r)sacc+=pB1[r]; l_reg+=sacc;
    pw0=(u32x4){PKW(pB0,0),PKW(pB0,2),PKW(pB0,4),PKW(pB0,6)};pw1=(u32x4){PKW(pB0,8),PKW(pB0,10),PKW(pB0,12),PKW(pB0,14)};pw2=(u32x4){PKW(pB1,0),PKW(pB1,2),PKW(pB1,4),PKW(pB1,6)};pw3=(u32x4){PKW(pB1,8),PKW(pB1,10),PKW(pB1,12),PKW(pB1,14)};
    SBAR(); pv(o,vb0+sl_cur,PAF(0),PAF(1),PAF(2),PAF(3)); }
  #undef PKW
  #undef PAF
  #undef VFR
  #undef PIN
  #undef MX3
  #undef GAPA
  #undef GAPB
  #undef EX
  #undef VRD
  #undef KRD
  #undef STEP
  #undef ENDW
  {auto rr=__builtin_amdgcn_permlane32_swap(__float_as_uint(l_reg),__float_as_uint(l_reg),false,false);l_reg=__uint_as_float(rr[0])+__uint_as_float(rr[1]);}
  if(hi==0)wsf[32+r32]=l_reg;asm volatile("s_waitcnt lgkmcnt(0)":::"memory");
  float rli[16];
  #pragma unroll
  for(int r=0;r<16;++r)rli[r]=__builtin_amdgcn_rcpf(wsf[32+crow(r,hi)]);
  bf16*Ow=O+(rowbase+q0+wid*QBLK)*DM;
  { bf16*stg=(bf16*)(shm+LDS_OST)+wid*2048;
    #pragma unroll
    for(int r=0;r<16;++r){const int orow=crow(r,hi);
      #pragma unroll
      for(int d0=0;d0<2;++d0)stg[orow*64+d0*32+r32]=::f2bf(o[d0][r]*rli[r]);}
    asm volatile("s_waitcnt lgkmcnt(0)":::"memory");
    #pragma unroll
    for(int i=0;i<4;++i){const int row=i*8+(lane>>3),ch=lane&7; const u32x4 v=*(const u32x4*)(stg+row*64+ch*8); ATTN_STORE16(Ow+(long)row*DM+ch*8,v);} }
  asm volatile("s_waitcnt lgkmcnt(0)\n\ts_barrier":::"memory");
  #undef DMA_K
  #undef DMA_V
  #undef CMASK
  #undef START
  #undef RESC
  #undef ROT
}
constexpr int ATTN_LDS_BYTES=LDS_BYTES;
struct AttnUnit { int b, m, vh, qb; };
struct StaticOrder {
  int vcu, G;
  __device__ __forceinline__ StaticOrder(int grid,int v):vcu(v),G(grid){}
  __device__ __forceinline__ bool next(int i,AttnUnit&u)const{
    int combo,qb;
    if(G==256){ if(i>=4)return false; const int s=vcu&1; combo=vcu>>1; qb=(i==0)?7-s:(i==1)?4+s:(i==2)?3-s:s; }
    else { const int idx=i*G+vcu; if(idx>=1024)return false; combo=idx>>3; qb=idx&7; }
    u.vh=combo&1; u.m=(combo>>1)&7; u.b=combo>>4; u.qb=qb; return true; }
};
template<class Sched,int THRL=8> __device__ __forceinline__ void attn_phase(char*lds,const bf16*P,const float*rel_bias,const Sched&S){
  AttnUnit u;
  for(int i=0;S.next(i,u);++i){ attn_unit<THRL>(u.b,u.m,u.vh,u.qb,P,rel_bias,lds); }
}
#undef SBAR
#undef WAIT_BAR
}

#define GAS __attribute__((address_space(1)))
#define LAS __attribute__((address_space(3)))
typedef unsigned v4u __attribute__((ext_vector_type(4)));
typedef GAS unsigned gu32;
typedef GAS unsigned long long gu64;
#define RLX_AGENT __ATOMIC_RELAXED, __HIP_MEMORY_SCOPE_AGENT
#define LDS_WAIT() asm volatile("s_waitcnt lgkmcnt(0)" ::: "memory")
#define VM_WAIT() asm volatile("s_waitcnt vmcnt(0)" ::: "memory")

#define XB_TMO      128
#define XB_XCNT(j)  (256  + 64 * (j))
#define XB_XSUB(j)  (1280 + 64 * (j))
#define XB_XGEN(j)  (2304 + 64 * (j))
#define XB_TOP      3328
#define XB_TOPGEN   3392
#define XCD_BAR_WORDS 3456
#define XB_SPIN_CAP (1u << 18)

__device__ __forceinline__ unsigned xb_ld(unsigned* p)              { return __hip_atomic_load(p, __ATOMIC_RELAXED, __HIP_MEMORY_SCOPE_AGENT); }
__device__ __forceinline__ unsigned xb_add(unsigned* p, unsigned v) { return __hip_atomic_fetch_add(p, v, __ATOMIC_RELAXED, __HIP_MEMORY_SCOPE_AGENT); }
__device__ __forceinline__ unsigned xb_xcc_id() { return (unsigned)__builtin_amdgcn_s_getreg((3 << 11) | 20) & 0xFu; }
#define XB_SPIN(cond, bar) do { unsigned _sp = 0; while (cond) { __builtin_amdgcn_s_sleep(1); \
    if ((++_sp & 255u) == 0u) { if (xb_ld(&(bar)[XB_TMO])) break; if (_sp > XB_SPIN_CAP) { atomicAdd(&(bar)[XB_TMO], 1u); break; } } } } while (0)

struct XcdBarrier {
    unsigned* bar; unsigned x;
    volatile LAS unsigned* st;
};

__device__ __forceinline__ XcdBarrier xcd_barrier_post(unsigned* bar, volatile LAS unsigned* st) {
    XcdBarrier b; b.bar = bar; b.x = xb_xcc_id(); b.st = st;
    if (threadIdx.x == 0) (void)xb_add(&bar[XB_XCNT(b.x)], 1u);
    return b;
}
__device__ __forceinline__ void xcd_barrier_complete(unsigned* bar, unsigned x, unsigned& nloc, unsigned& nx) {
    const unsigned G = gridDim.x * gridDim.y * gridDim.z;
    unsigned sum, cnt, mine, sp = 0u;
    for (;;) {
        sum = 0u; cnt = 0u; mine = 0u;
#pragma unroll
        for (unsigned j = 0; j < 16; ++j) { const unsigned c = xb_ld(&bar[XB_XCNT(j)]); sum += c; cnt += (c > 0u) ? 1u : 0u; mine = (j == x) ? c : mine; }
        if (sum == G) break;
        __builtin_amdgcn_s_sleep(1);
        if ((++sp & 255u) == 0u) { if (xb_ld(&bar[XB_TMO])) break; if (sp > XB_SPIN_CAP) { atomicAdd(&bar[XB_TMO], 1u); break; } }
    }
    nloc = mine > 0u ? mine : 1u; nx = cnt > 0u ? cnt : 1u;
}

__device__ __forceinline__ void xcd_barrier(const XcdBarrier& b) {
    asm volatile("s_waitcnt vmcnt(0)" ::: "memory");
    __syncthreads();
    if (threadIdx.x == 0) {
        unsigned* bar = b.bar;
        __builtin_amdgcn_s_waitcnt(0);
        unsigned nloc = b.st[0], nx = b.st[1];
        if (nloc == 0u) { xcd_barrier_complete(bar, b.x, nloc, nx); b.st[0] = nloc; b.st[1] = nx; }
        const unsigned old = xb_add(&bar[XB_XSUB(b.x)], 1u);
        const unsigned gen = old / nloc;
        if (old + 1u == (gen + 1u) * nloc) {
            __builtin_amdgcn_fence(__ATOMIC_RELEASE, "agent");
            asm volatile("s_waitcnt vmcnt(0)" ::: "memory");
            const unsigned og = xb_add(&bar[XB_TOP], 1u);
            const unsigned tg = og / nx;
            if (og + 1u == (tg + 1u) * nx) xb_add(&bar[XB_TOPGEN], 1u);
            else XB_SPIN(xb_ld(&bar[XB_TOPGEN]) == tg, bar);
            __builtin_amdgcn_fence(__ATOMIC_ACQUIRE, "agent");
            xb_add(&bar[XB_XGEN(b.x)], 1u);
            asm volatile("s_waitcnt vmcnt(0)" ::: "memory");
        } else {
            XB_SPIN(xb_ld(&bar[XB_XGEN(b.x)]) == gen, bar);
            __builtin_amdgcn_fence(__ATOMIC_ACQUIRE, "agent");
            asm volatile("s_waitcnt vmcnt(0)" ::: "memory");
        }
    }
    __syncthreads();
}

constexpr int NWAVES = 8;
constexpr int RING_OFF = 0, RING_BYTES = 131072;
constexpr int LDSCTL_OFF = RING_BYTES, MISC_OFF = LDSCTL_OFF + 320;
constexpr int LDS_BYTES = 147456;
constexpr int CW_BAR = 4096;
constexpr int PH_PROLOGUE = 0, PH_ROW0 = 1, PH_LAYER0 = 2, NPL = 16;
enum { S_UP1 = 0, S_DN1, S_ROWA, S_WIN, S_MIX1, S_MIX2, S_MIX3, S_ATTN, S_DFIN, S_GLU, S_BRANCH, S_WOUT, S_ROWB, S_UP2, S_DN2, S_ROWC };
constexpr int N_PHASES = PH_LAYER0 + DEPTH * NPL;

struct Args { const float* in[29]; float* out; unsigned char* ws; int ph_lo, ph_hi; };
struct Frame {
    LAS unsigned char* lds; char* ldsg;
    int tid, lane, wave, vcu, G, z, cid;
    const float* const* in; float* out; unsigned char* ws;
};

template <int MAP> __device__ __forceinline__ int conv_src(int n) {
    if (MAP == 0) return n;
    if (MAP == 1) { const int t = n >> 8, r = n & 255; return r < 128 ? 128 * t + r : DFF + 128 * t + (r - 128); }
    if (MAP == 2) return my2ref(n);
    { const int t = n >> 8, r = n & 255; return r < 128 ? 128 * t + r : 512 + 128 * t + (r - 128); }
}
template <int MAP> __device__ __forceinline__ void conv_item(const float* W, int K, int N, int Np, bf16_t* WT, LAS float* scr, int item, int lane) {
    const int nblk = Np / 32, kb = item / nblk, nb = item % nblk, k0 = 64 * kb, n0 = 32 * nb;
    const int src = conv_src<MAP>(n0 + (lane & 31));
#pragma unroll 8
    for (int i = 0; i < 32; ++i) { const int kk = 2 * i + (lane >> 5); scr[kk * 33 + (lane & 31)] = (src >= 0) ? W[(size_t)(k0 + kk) * N + src] : 0.f; }
    LDS_WAIT(); asm volatile("" ::: "memory");
    const int c = lane & 7;
#pragma unroll
    for (int j = 0; j < 4; ++j) { const int n = (lane >> 3) + 8 * j; const LAS float* s = scr + (8 * c) * 33 + n;
        v4u o; o.x = pk2(s[0 * 33], s[1 * 33]); o.y = pk2(s[2 * 33], s[3 * 33]); o.z = pk2(s[4 * 33], s[5 * 33]); o.w = pk2(s[6 * 33], s[7 * 33]);
        *(GAS v4u*)(WT + (size_t)(n0 + n) * K + k0 + 8 * c) = o; }
    LDS_WAIT(); asm volatile("" ::: "memory");
}
__device__ __forceinline__ void convert_layer(Frame& F, int l) {
    LAS float* scr = (LAS float*)(F.lds + RING_OFF + F.wave * 16384);
    const int gw = F.vcu * NWAVES + F.wave, NGW = F.G * NWAVES;
    bf16_t* wb = (bf16_t*)(F.ws + WS_W);
    constexpr int I_UP = (D / 64) * (2 * DFF / 32), I_DN = (DFF / 64) * (D / 32), I_IN = (D / 64) * (PW / 32), I_GLU = (512 / 64) * (1024 / 32), I_BR = I_GLU, I_OUT = (D / 64) * (D / 32);
    constexpr int NITEMS = 2 * I_UP + 2 * I_DN + I_IN + I_GLU + 3 * I_BR + I_OUT;
    const float* f1u = F.in[F.z + 7] + (size_t)l * D * 2 * DFF; const float* f1d = F.in[F.z + 8] + (size_t)l * DFF * D;
    const float* f2u = F.in[F.z + 9] + (size_t)l * D * 2 * DFF; const float* f2d = F.in[F.z + 10] + (size_t)l * DFF * D;
    const float* win = F.in[F.z + 11] + (size_t)l * D * INW; const float* wglu = F.in[F.z + 25] + (size_t)l * 512 * 1024;
    const float* wbr = F.in[F.z + 27] + (size_t)l * 3 * 512 * D; const float* wout = F.in[F.z + 28] + (size_t)l * D * D;
    for (int it = gw; it < NITEMS; it += NGW) {
        int r = it;
        if (r < I_UP) { conv_item<1>(f1u, D, 2 * DFF, 2 * DFF, wb + W_UP1, scr, r, F.lane); continue; } r -= I_UP;
        if (r < I_DN) { conv_item<0>(f1d, DFF, D, D, wb + W_DN1, scr, r, F.lane); continue; } r -= I_DN;
        if (r < I_UP) { conv_item<1>(f2u, D, 2 * DFF, 2 * DFF, wb + W_UP2, scr, r, F.lane); continue; } r -= I_UP;
        if (r < I_DN) { conv_item<0>(f2d, DFF, D, D, wb + W_DN2, scr, r, F.lane); continue; } r -= I_DN;
        if (r < I_IN) { conv_item<2>(win, D, INW, PW, wb + W_IN, scr, r, F.lane); continue; } r -= I_IN;
        if (r < I_GLU) { conv_item<3>(wglu, 512, 1024, 1024, wb + W_GLU, scr, r, F.lane); continue; } r -= I_GLU;
        if (r < 3 * I_BR) { const int i = r / I_BR; conv_item<0>(wbr + (size_t)i * 512 * D, 512, D, D, wb + W_BR + (size_t)i * 1024 * 512, scr, r % I_BR, F.lane); continue; } r -= 3 * I_BR;
        conv_item<0>(wout, D, D, D, wb + W_OUT, scr, r, F.lane);
    }
}
__device__ __forceinline__ void ada_phase(Frame& F) {
    if (F.vcu < 2 * 72) {
        const int l = F.vcu / 72, cb = F.vcu % 72;
        LAS float* cond = (LAS float*)(F.lds + RING_OFF);
        LAS float* red = (LAS float*)(F.lds + RING_OFF + 32768);
        const float* c = F.in[F.z + 1];
        for (int i = F.tid; i < BATCH * D; i += NWAVES * 64) cond[i] = siluf_(c[i]);
        __syncthreads();
        float acc[BATCH][2];
#pragma unroll
        for (int b = 0; b < BATCH; ++b) { acc[b][0] = 0.f; acc[b][1] = 0.f; }
        const float* w = F.in[F.z + 3] + ((size_t)l * D + F.wave * 128) * ADA + cb * 128 + 2 * F.lane;
#pragma unroll 4
        for (int k = 0; k < 128; ++k) { const float2 wv = *(const float2*)(w + (size_t)k * ADA);
#pragma unroll
            for (int b = 0; b < BATCH; ++b) { const float cv = cond[b * D + F.wave * 128 + k]; acc[b][0] += cv * wv.x; acc[b][1] += cv * wv.y; } }
#pragma unroll
        for (int b = 0; b < BATCH; ++b) { red[(F.wave * 8 + b) * 128 + 2 * F.lane] = acc[b][0]; red[(F.wave * 8 + b) * 128 + 2 * F.lane + 1] = acc[b][1]; }
        __syncthreads();
        float* ada = (float*)(F.ws + WS_ADA);
        for (int o = F.tid; o < BATCH * 128; o += NWAVES * 64) { const int b = o >> 7, cc = o & 127; float s = F.in[F.z + 4][l * ADA + cb * 128 + cc];
#pragma unroll
            for (int w8 = 0; w8 < 8; ++w8) s += red[(w8 * 8 + b) * 128 + cc];
            ada[((size_t)l * BATCH + b) * ADA + cb * 128 + cc] = s; }
        __syncthreads();
    }
}
__device__ __forceinline__ void rowpass_phase(Frame& F, int l, int sub) {
    const int gw = F.vcu * NWAVES + F.wave, NGW = F.G * NWAVES;
    const float* ada = (const float*)(F.ws + WS_ADA); const float* adal = ada + (size_t)l * BATCH * ADA;
    const float* npre = F.in[F.z + 5] + l * 3 * D; const float* npost = F.in[F.z + 6] + l * 3 * D;
    bf16_t* u = (bf16_t*)(F.ws + WS_U); const bf16_t* y = (const bf16_t*)(F.ws + WS_Y);
    const float* h_in = F.out; const bf16_t* yy = y; const float* gpost = nullptr; const float* gate = nullptr; float coef = 0.f;
    const float* gpre = nullptr; const float* shift = nullptr; const float* scale = nullptr; bf16_t* uu = u;
    if (sub == 0) { h_in = F.in[F.z + 0]; yy = nullptr; gpre = npre; shift = adal; scale = adal + D; }
    else if (sub == 1) { gpost = npost; gate = adal + 2 * D; coef = 0.5f; gpre = npre + D; shift = adal + 3 * D; scale = adal + 4 * D; }
    else if (sub == 2) { gpost = npost + D; gate = adal + 5 * D; coef = 1.0f; gpre = npre + 2 * D; shift = adal + 6 * D; scale = adal + 7 * D; }
    else { gpost = npost + 2 * D; gate = adal + 8 * D; coef = 0.5f;
        if (l + 1 < DEPTH) { gpre = F.in[F.z + 5] + (l + 1) * 3 * D; shift = adal + (size_t)BATCH * ADA; scale = shift + D; } else uu = nullptr; }
    for (int row = gw; row < M; row += NGW) rowpass_row(row, F.lane, h_in, F.out, yy, gpost, gate, coef, gpre, shift, scale, uu);
}
__device__ __forceinline__ void dfin_phase(Frame& F, int l) {
    const int gw = F.vcu * NWAVES + F.wave, NGW = F.G * NWAVES;
    const float* lamv = F.in[F.z + 15] + l * 256; const float lam_init = 0.8f - 0.6f * __expf(-0.3f * (float)l);
    const float lam = __expf(wave_sum(lamv[F.lane] * lamv[64 + F.lane])) - __expf(wave_sum(lamv[128 + F.lane] * lamv[192 + F.lane])) + lam_init;
    bf16_t* proj = (bf16_t*)(F.ws + WS_R0);
    for (int row = gw; row < M; row += NGW) diff_fin_row(proj + (size_t)row * PW, F.lane, lam, F.in[F.z + 16] + l * 512, lam_init);
}


constexpr size_t WS_S5TAB0 = WS_ADA + 640 * 1024, WS_S5TAB1 = WS_W + W_END * 2;
#define WS_S5TAB (l == 0 ? WS_S5TAB0 : WS_S5TAB1)
constexpr size_t S5T_AB = 0, S5T_A64 = 16384, S5T_BB = 32768, S5T_CC = S5T_BB + 131072, S5T_END = S5T_CC + 131072;
static_assert(WS_S5TAB0 + S5T_END <= WS_S5ST && WS_S5TAB1 + S5T_END <= WS_U, "S5 tables fit");
constexpr size_t WS_DECAY = WS_CTL + 512 * 1024;
constexpr size_t WS_SPT = WS_U, WS_OI = WS_U + 16 * MiB;
typedef float f32x2v __attribute__((ext_vector_type(2)));
#define MFMA16(a, b, c) __builtin_amdgcn_mfma_f32_16x16x32_bf16((a), (b), (c), 0, 0, 0)

__device__ __forceinline__ void s5_tables(Frame& F, int l) {
    const int gw = F.vcu * NWAVES + F.wave;
    if (gw >= 32) return;
    const int g = gw, p = F.lane;
    const float* lam_re = F.in[F.z + 17] + l * 2048; const float* lam_im = F.in[F.z + 18] + l * 2048; const float* log_step = F.in[F.z + 19] + l * 32;
    const float* b_re = F.in[F.z + 20] + l * 32768; const float* b_im = F.in[F.z + 21] + l * 32768; const float* c_re = F.in[F.z + 22] + l * 32768; const float* c_im = F.in[F.z + 23] + l * 32768;
    unsigned char* tb = F.ws + WS_S5TAB;
    const float lr = lam_re[g * 64 + p], li = lam_im[g * 64 + p], dt = expf(log_step[g]);
    const float mag = expf(lr * dt), ar = mag * cosf(li * dt), ai = mag * sinf(li * dt);
    const float nr = ar - 1.f, ni = ai, den = lr * lr + li * li, fre = (nr * lr + ni * li) / den, fim = (ni * lr - nr * li) / den;
    ((f32x2v*)(tb + S5T_AB))[g * 64 + p] = (f32x2v){ar, ai};
    float pr = ar, pi = ai;
#pragma unroll
    for (int i = 0; i < 6; ++i) { const float nr2 = pr * pr - pi * pi, ni2 = 2.f * pr * pi; pr = nr2; pi = ni2; }
    ((f32x2v*)(tb + S5T_A64))[g * 64 + p] = (f32x2v){pr, pi};
    bf16_t* BB = (bf16_t*)(tb + S5T_BB) + (size_t)g * 128 * 16; bf16_t* CC = (bf16_t*)(tb + S5T_CC) + (size_t)g * 16 * 128;
#pragma unroll
    for (int h = 0; h < 16; ++h) { const float br = b_re[(g * 64 + p) * 16 + h], bi = b_im[(g * 64 + p) * 16 + h];
        BB[(2 * p) * 16 + h] = f2bf(fre * br - fim * bi); BB[(2 * p + 1) * 16 + h] = f2bf(fre * bi + fim * br);
        CC[h * 128 + 2 * p] = f2bf(c_re[(g * 16 + h) * 64 + p]); CC[h * 128 + 2 * p + 1] = f2bf(-c_im[(g * 16 + h) * 64 + p]); }
}
template <bool OUT> __device__ __forceinline__ void s5_item(Frame& F, int l, int item, LAS unsigned char* wl) {
    int lane_ = F.lane; asm volatile("" : "+v"(lane_));
    const int lane = lane_, fr = lane & 15, fq = lane >> 4;
    const int b = item >> 10, g = (item >> 5) & 31, c = item & 31;
    const unsigned char* tb = F.ws + WS_S5TAB;
    bf16_t* proj = (bf16_t*)(F.ws + WS_R0);
    f32x2v* ST = (f32x2v*)(F.ws + WS_S5ST);
    const f32x2v ab = ((const f32x2v*)(tb + S5T_AB))[g * 64 + lane];
    const float ar = ab.x, ai = ab.y;
    const bf16x8 zero8 = (bf16x8){0, 0, 0, 0, 0, 0, 0, 0};
    bf16x8 bfrag[8];
#pragma unroll
    for (int ct = 0; ct < 8; ++ct) bfrag[ct] = (fq < 2) ? *(const bf16x8*)((const bf16_t*)(tb + S5T_BB) + ((size_t)(g * 128 + 16 * ct + fr) * 16 + 8 * fq)) : zero8;
    bf16x8 cfrag[4]; float dsk = 0.f;
    if (OUT) {
#pragma unroll
        for (int s = 0; s < 4; ++s) cfrag[s] = *(const bf16x8*)((const bf16_t*)(tb + S5T_CC) + ((size_t)(g * 16 + fr) * 128 + 32 * s + 8 * fq));
        dsk = (F.in[F.z + 24] + l * 512)[g * 16 + fr];
    }
    float xr = 0.f, xi = 0.f;
    if (OUT) { const f32x2v x0 = ((const f32x2v*)(F.ws + WS_S5ST2))[(size_t)item * 64 + lane]; xr = x0.x; xi = x0.y; }
    LAS float* buL = (LAS float*)wl;
    LAS unsigned char* XL = wl + 16 * 132 * 4;
    const size_t row0 = (size_t)b * SEQ + 64 * c;
#pragma unroll 1
    for (int w = 0; w < 4; ++w) {
        bf16_t* urow = proj + (row0 + 16 * w) * PW + C_SU + 16 * g;
        const bf16x8 a = (fq < 2) ? *(const bf16x8*)(urow + (size_t)fr * PW + 8 * fq) : zero8;
#pragma unroll
        for (int ct = 0; ct < 8; ++ct) { const f32x4 acc = MFMA16(a, bfrag[ct], ((f32x4){0.f, 0.f, 0.f, 0.f}));
#pragma unroll
            for (int j = 0; j < 4; ++j) buL[(4 * fq + j) * 132 + 16 * ct + fr] = acc[j]; }
        LDS_WAIT(); asm volatile("" ::: "memory");
        f32x2v bu[16];
#pragma unroll
        for (int t = 0; t < 16; ++t) bu[t] = *(const LAS f32x2v*)(buL + t * 132 + 2 * lane);
        LDS_WAIT(); asm volatile("" ::: "memory");
#pragma unroll
        for (int t = 0; t < 16; ++t) { const float nxr = ar * xr - ai * xi + bu[t].x, nxi = ar * xi + ai * xr + bu[t].y; xr = nxr; xi = nxi;
            if (OUT) *(LAS unsigned*)(XL + (t * 136 + 2 * lane) * 2) = pk2(xr, xi); }
        if (OUT) {
            LDS_WAIT(); asm volatile("" ::: "memory");
            f32x4 y = (f32x4){0.f, 0.f, 0.f, 0.f};
#pragma unroll
            for (int s = 0; s < 4; ++s) { const bf16x8 xa = *(const LAS bf16x8*)(XL + (fr * 136 + 32 * s + 8 * fq) * 2); y = MFMA16(xa, cfrag[s], y); }
#pragma unroll
            for (int j = 0; j < 4; ++j) { bf16_t* up = urow + (size_t)(4 * fq + j) * PW + fr; const float yn = y[j] + dsk * bf2f(*up);
                const float x3 = yn * yn * yn; const bf16_t outv = f2bf(0.5f * yn * (1.f + tanhf(0.7978845608028654f * (yn + 0.044715f * x3))));
#if defined(S5_DUMMY_OUT)
                ((bf16_t*)(F.ws + WS_GLA))[(row0 + 16 * w + 4 * fq + j) * 512 + 16 * g + fr] = outv;
#else
                *up = outv;
#endif
            }
            LDS_WAIT(); asm volatile("" ::: "memory");
        }
    }
    if (!OUT) ST[(size_t)item * 64 + lane] = (f32x2v){xr, xi};
}
template <bool OUT> __device__ __forceinline__ void s5_item_simple(Frame& F, int l, int item);
template <bool OUT> __device__ __forceinline__ void s5_pass(Frame& F, int l) {
    LAS unsigned char* wl = F.lds + RING_OFF + F.wave * 12800;
    const int gw = F.vcu * NWAVES + F.wave, NGW = F.G * NWAVES;
    for (int it = gw; it < BATCH * 8 * 32; it += NGW) { const int b = it >> 8, gq = (it >> 5) & 7, c = it & 31;
#pragma unroll 1
#if defined(S5_SIMPLE)
        for (int gi = 0; gi < 4; ++gi) s5_item_simple<OUT>(F, l, ((b * 32 + 4 * gq + gi) << 5) + c); }
#else
        for (int gi = 0; gi < 4; ++gi) s5_item<OUT>(F, l, ((b * 32 + 4 * gq + gi) << 5) + c, wl); }
#endif
}
__device__ __forceinline__ void s5_carry(Frame& F, int l) {
    const f32x2v* ST = (const f32x2v*)(F.ws + WS_S5ST); f32x2v* ST2 = (f32x2v*)(F.ws + WS_S5ST2);
    int b = -1, g = 0;
    if (F.G == 256) { if ((F.vcu & 31) < 4) { b = F.vcu >> 5; g = (F.vcu & 3) * 8 + F.wave; } }
    else { const int gw = F.vcu * NWAVES + F.wave; if (gw < BATCH * 32) { b = gw >> 5; g = gw & 31; } }
    if (b < 0) return;
    const int bg = b * 32 + g;
#if defined(S5_SIMPLE)
    f32x2v a64;
    { const float lr = (F.in[F.z + 17] + l * 2048)[g * 64 + F.lane], li = (F.in[F.z + 18] + l * 2048)[g * 64 + F.lane], dt = expf((F.in[F.z + 19] + l * 32)[g]);
      const float mag = expf(lr * dt); float pr = mag * cosf(li * dt), pi = mag * sinf(li * dt);
#pragma unroll
      for (int i = 0; i < 6; ++i) { const float nr2 = pr * pr - pi * pi, ni2 = 2.f * pr * pi; pr = nr2; pi = ni2; }
      a64 = (f32x2v){pr, pi}; }
#else
    const f32x2v a64 = ((const f32x2v*)(F.ws + WS_S5TAB + S5T_A64))[g * 64 + F.lane];
#endif
    const f32x2v* st = ST + (size_t)bg * 32 * 64 + F.lane; f32x2v* st2 = ST2 + (size_t)bg * 32 * 64 + F.lane; f32x2v e[32];
#pragma unroll
    for (int c = 0; c < 32; ++c) e[c] = st[c * 64];
    float xr = 0.f, xi = 0.f; asm volatile("" : "+v"(xr), "+v"(xi));
#pragma unroll
    for (int c = 0; c < 32; ++c) { st2[c * 64] = (f32x2v){xr, xi}; const float nxr = a64.x * xr - a64.y * xi + e[c].x, nxi = a64.x * xi + a64.y * xr + e[c].y; xr = nxr; xi = nxi; }
}
template <bool OUT> __device__ __forceinline__ void s5_item_simple(Frame& F, int l, int item) {
    int lane_ = F.lane; asm volatile("" : "+v"(lane_)); const int p = lane_;
    const int b = item >> 10, g = (item >> 5) & 31, c = item & 31;
    const float* lam_re = F.in[F.z + 17] + l * 2048; const float* lam_im = F.in[F.z + 18] + l * 2048; const float* log_step = F.in[F.z + 19] + l * 32;
    const float* b_re = F.in[F.z + 20] + l * 32768; const float* b_im = F.in[F.z + 21] + l * 32768; const float* c_re = F.in[F.z + 22] + l * 32768; const float* c_im = F.in[F.z + 23] + l * 32768; const float* d_skip = F.in[F.z + 24] + l * 512;
    bf16_t* proj = (bf16_t*)(F.ws + WS_R0);
    const float lr = lam_re[g * 64 + p], li = lam_im[g * 64 + p], dt = expf(log_step[g]);
    const float mag = expf(lr * dt), ar = mag * cosf(li * dt), ai = mag * sinf(li * dt);
    const float nr = ar - 1.f, ni = ai, den = lr * lr + li * li, fre = (nr * lr + ni * li) / den, fim = (ni * lr - nr * li) / den;
    float bbr[16], bbi[16], cr[16], ci[16];
#pragma unroll
    for (int h = 0; h < 16; ++h) { const float br = b_re[(g * 64 + p) * 16 + h], bi = b_im[(g * 64 + p) * 16 + h]; bbr[h] = fre * br - fim * bi; bbi[h] = fre * bi + fim * br;
        cr[h] = c_re[(g * 16 + h) * 64 + p]; ci[h] = c_im[(g * 16 + h) * 64 + p]; }
    const float dsk = (p < 16) ? d_skip[g * 16 + p] : 0.f;
    float xr = 0.f, xi = 0.f;
    if (OUT) { const f32x2v x0 = ((const f32x2v*)(F.ws + WS_S5ST2))[(size_t)item * 64 + p]; xr = x0.x; xi = x0.y; }
#pragma unroll 1
    for (int s = 0; s < 64; ++s) {
        bf16_t* row = proj + ((size_t)b * SEQ + 64 * c + s) * PW + C_SU + g * 16;
        float u[16];
#pragma unroll
        for (int h = 0; h < 16; ++h) u[h] = bf2f(row[h]);
        float bur = 0.f, bui = 0.f;
#pragma unroll
        for (int h = 0; h < 16; ++h) { bur += bbr[h] * u[h]; bui += bbi[h] * u[h]; }
        const float nxr = ar * xr - ai * xi + bur, nxi = ar * xi + ai * xr + bui; xr = nxr; xi = nxi;
        if (OUT) { float yn = 0.f;
#pragma unroll
            for (int n = 0; n < 16; ++n) { const float v = wave_sum(cr[n] * xr - ci[n] * xi); if (p == n) yn = v + dsk * u[n]; }
            if (p < 16) { const float x3 = yn * yn * yn; row[p] = f2bf(0.5f * yn * (1.f + tanhf(0.7978845608028654f * (yn + 0.044715f * x3)))); } }
    }
    if (!OUT) ((f32x2v*)(F.ws + WS_S5ST))[(size_t)item * 64 + p] = (f32x2v){xr, xi};
}

constexpr int GL_QD = 0, GL_KD = 9216, GL_KRT = 18432, GL_VT = 27648, GL_ATT = 46080, GL_WAL = 55296, GL_END = GL_WAL + 17 * 64 * 4;
__device__ __forceinline__ void gla_pass1(Frame& F, int l) {
    bf16_t* proj = (bf16_t*)(F.ws + WS_R0);
    const float* w_alpha = F.in[F.z + 12] + l * 16 * 256; const float* b_alpha = F.in[F.z + 13] + l * 256;
    float* dST = (float*)(F.ws + WS_GLA); float* decay = (float*)(F.ws + WS_DECAY); unsigned* OI = (unsigned*)(F.ws + WS_OI);
    LAS unsigned char* L = F.lds + RING_OFF;
    LAS float* wal = (LAS float*)(L + GL_WAL);
    const int w = F.wave;
    for (int item = F.vcu; item < BATCH * 4 * 32; item += F.G) {
        int lane_ = F.lane; asm volatile("" : "+v"(lane_));
        const int lane = lane_, t = w * 64 + lane, fr = lane & 15, fq = lane >> 4;
        const int b = item >> 7, h = (item >> 5) & 3, n = item & 31;
        const size_t row0 = (size_t)b * SEQ + 64 * n;
        for (int i = t; i < 17 * 64; i += NWAVES * 64) wal[i] = (i < 1024) ? w_alpha[(i >> 6) * 256 + h * 64 + (i & 63)] : b_alpha[h * 64 + (i & 63)];
#pragma unroll
        for (int i = 0; i < 2; ++i) { const int id = t + 512 * i, s = id & 63, e0 = (id >> 6) * 8;
            const u32x4 vv = *(const u32x4*)(proj + (row0 + s) * PW + C_GV + h * 128 + e0);
#pragma unroll
            for (int k = 0; k < 4; ++k) { *(LAS bf16_t*)(L + GL_VT + ((e0 + 2 * k) * 72 + s) * 2) = (bf16_t)(vv[k] & 0xffffu); *(LAS bf16_t*)(L + GL_VT + ((e0 + 2 * k + 1) * 72 + s) * 2) = (bf16_t)(vv[k] >> 16); } }
        __syncthreads();
        {
            const int c = lane, d0 = 8 * w;
            const bf16_t* rowp = proj + (row0 + c) * PW;
            const u32x4 a0 = *(const u32x4*)(rowp + C_GA), a1 = *(const u32x4*)(rowp + C_GA + 8);
            float al[16];
#pragma unroll
            for (int k = 0; k < 4; ++k) { al[2 * k] = blo(a0[k]); al[2 * k + 1] = bhi(a0[k]); al[8 + 2 * k] = blo(a1[k]); al[8 + 2 * k + 1] = bhi(a1[k]); }
            float bb[8];
#pragma unroll
            for (int i = 0; i < 8; ++i) { float z = wal[1024 + d0 + i];
#pragma unroll
                for (int j = 0; j < 16; ++j) z += al[j] * wal[j * 64 + d0 + i];
                bb[i] = (fminf(z, 0.f) - log1pf(__expf(-fabsf(z)))) * (1.f / 16.f); }
#pragma unroll
            for (int i = 0; i < 8; ++i) {
#pragma unroll
                for (int o = 1; o < 64; o <<= 1) { const float up = __int_as_float(__builtin_amdgcn_ds_bpermute((lane - o) << 2, __float_as_int(bb[i]))); if (lane >= o) bb[i] += up; } }
            const u32x4 qv = *(const u32x4*)(rowp + C_GQ + h * 64 + d0), kv = *(const u32x4*)(rowp + C_GK + h * 64 + d0);
            float qd[8], kd[8], kr[8];
#pragma unroll
            for (int i = 0; i < 8; ++i) { const float bl = __int_as_float(__builtin_amdgcn_readlane(__float_as_int(bb[i]), 63)); const float q = (i & 1) ? bhi(qv[i >> 1]) : blo(qv[i >> 1]), k = (i & 1) ? bhi(kv[i >> 1]) : blo(kv[i >> 1]);
                qd[i] = q * __expf(bb[i]); kd[i] = k * __expf(-bb[i]); kr[i] = k * __expf(bl - bb[i]);
                if (lane == 63) decay[(size_t)item * 64 + d0 + i] = __expf(bl); }
            u32x4 qw, kw;
#pragma unroll
            for (int k = 0; k < 4; ++k) { qw[k] = pk2(qd[2 * k], qd[2 * k + 1]); kw[k] = pk2(kd[2 * k], kd[2 * k + 1]); }
            *(LAS u32x4*)(L + GL_QD + (c * 72 + d0) * 2) = qw; *(LAS u32x4*)(L + GL_KD + (c * 72 + d0) * 2) = kw;
            *(u32x4*)(proj + (row0 + c) * PW + C_GQ + h * 64 + d0) = qw;
#pragma unroll
            for (int i = 0; i < 8; ++i) *(LAS bf16_t*)(L + GL_KRT + ((d0 + i) * 72 + c) * 2) = f2bf(kr[i]);
        }
        __syncthreads();
        {
            const int ct = w >> 1;
#pragma unroll
            for (int si = 0; si < 2; ++si) { const int st = 2 * (w & 1) + si;
                f32x4 acc = (f32x4){0.f, 0.f, 0.f, 0.f};
                if (st <= ct) {
#pragma unroll
                    for (int ks = 0; ks < 2; ++ks) { const bf16x8 a = *(const LAS bf16x8*)(L + GL_QD + ((16 * ct + fr) * 72 + 32 * ks + 8 * fq) * 2), bq = *(const LAS bf16x8*)(L + GL_KD + ((16 * st + fr) * 72 + 32 * ks + 8 * fq) * 2);
                        acc = MFMA16(a, bq, acc); } }
#pragma unroll
                for (int j = 0; j < 4; ++j) { const int cc = 16 * ct + 4 * fq + j, ss = 16 * st + fr; *(LAS bf16_t*)(L + GL_ATT + (cc * 72 + ss) * 2) = f2bf(ss <= cc ? acc[j] : 0.f); } }
        }
        __syncthreads();
        {
            bf16x8 vf[2];
#pragma unroll
            for (int ks = 0; ks < 2; ++ks) vf[ks] = *(const LAS bf16x8*)(L + GL_VT + ((16 * w + fr) * 72 + 32 * ks + 8 * fq) * 2);
#pragma unroll
            for (int ct = 0; ct < 4; ++ct) { f32x4 acc = (f32x4){0.f, 0.f, 0.f, 0.f};
#pragma unroll
                for (int ks = 0; ks < 2; ++ks) { const bf16x8 a = *(const LAS bf16x8*)(L + GL_ATT + ((16 * ct + fr) * 72 + 32 * ks + 8 * fq) * 2); acc = MFMA16(a, vf[ks], acc); }
                uint2 o; o.x = pk2(acc[0], acc[1]); o.y = pk2(acc[2], acc[3]);
                *(uint2*)(OI + ((((size_t)item * 4 + ct) * 8 + w) * 64 + lane) * 2) = o; }
#pragma unroll
            for (int dt = 0; dt < 4; ++dt) { f32x4 acc = (f32x4){0.f, 0.f, 0.f, 0.f};
#pragma unroll
                for (int ks = 0; ks < 2; ++ks) { const bf16x8 bk = *(const LAS bf16x8*)(L + GL_KRT + ((16 * dt + fr) * 72 + 32 * ks + 8 * fq) * 2); acc = MFMA16(vf[ks], bk, acc); }
#pragma unroll
                for (int j = 0; j < 4; ++j) dST[((size_t)item * 128 + 16 * w + 4 * fq + j) * 64 + 16 * dt + fr] = acc[j]; }
        }
        __syncthreads();
    }
}
__device__ __forceinline__ void gla_pass2(Frame& F) {
    const float* dST = (const float*)(F.ws + WS_GLA); const float* decay = (const float*)(F.ws + WS_DECAY); unsigned* SPT = (unsigned*)(F.ws + WS_SPT);
    for (int idx = F.vcu * (NWAVES * 64) + F.tid; idx < 32 * 4096; idx += F.G * NWAVES * 64) {
        const int bh = idx >> 12, j = idx & 4095, e = j >> 5, d2 = (j & 31) * 2;
        float sx = 0.f, sy = 0.f;
#pragma unroll 1
        for (int n0 = 0; n0 < 32; n0 += 8) {
            f32x2v dv[8], dc[8];
#pragma unroll
            for (int k = 0; k < 8; ++k) { const size_t item = (size_t)bh * 32 + n0 + k; dv[k] = *(const f32x2v*)(dST + (item * 128 + e) * 64 + d2); dc[k] = *(const f32x2v*)(decay + item * 64 + d2); }
#pragma unroll
            for (int k = 0; k < 8; ++k) { const size_t item = (size_t)bh * 32 + n0 + k; SPT[((item * 128 + e) * 64 + d2) >> 1] = pk2(sx, sy); sx = dc[k].x * sx + dv[k].x; sy = dc[k].y * sy + dv[k].y; }
        }
    }
}
__device__ __forceinline__ void gla_pass3(Frame& F, int l) {
    bf16_t* proj = (bf16_t*)(F.ws + WS_R0); const bf16_t* SPT = (const bf16_t*)(F.ws + WS_SPT); const unsigned* OI = (const unsigned*)(F.ws + WS_OI);
    const float* norm_g = F.in[F.z + 14] + l * 512;
    const int ct = F.wave & 3;
    for (int item = F.vcu * 2 + (F.wave >> 2); item < BATCH * 4 * 32; item += F.G * 2) {
        int lane_ = F.lane; asm volatile("" : "+v"(lane_));
        const int lane = lane_, fr = lane & 15, fq = lane >> 4;
        const int b = item >> 7, h = (item >> 5) & 3, n = item & 31;
        const size_t row0 = (size_t)b * SEQ + 64 * n + 16 * ct;
        bf16x8 qa[2];
#pragma unroll
        for (int ks = 0; ks < 2; ++ks) qa[ks] = *(const bf16x8*)(proj + (row0 + fr) * PW + C_GQ + h * 64 + 32 * ks + 8 * fq);
        f32x4 acc[8];
#pragma unroll
        for (int et = 0; et < 8; ++et) { const uint2 oi = *(const uint2*)(OI + ((((size_t)item * 4 + ct) * 8 + et) * 64 + lane) * 2);
            acc[et] = (f32x4){blo(oi.x), bhi(oi.x), blo(oi.y), bhi(oi.y)};
#pragma unroll
            for (int ks = 0; ks < 2; ++ks) { const bf16x8 sb = *(const bf16x8*)(SPT + ((size_t)item * 128 + 16 * et + fr) * 64 + 32 * ks + 8 * fq); acc[et] = MFMA16(qa[ks], sb, acc[et]); } }
        float ss[4];
#pragma unroll
        for (int j = 0; j < 4; ++j) { float s = 0.f;
#pragma unroll
            for (int et = 0; et < 8; ++et) s += acc[et][j] * acc[et][j];
            s += swz_xor<1>(s); s += swz_xor<2>(s); s += swz_xor<4>(s); s += swz_xor<8>(s);
            ss[j] = rsqrtf(s * (1.f / 128.f) + EPS); }
#pragma unroll
        for (int et = 0; et < 8; ++et) { const float ng = norm_g[h * 128 + 16 * et + fr];
#pragma unroll
            for (int j = 0; j < 4; ++j) { bf16_t* rp = proj + (row0 + 4 * fq + j) * PW + h * 128 + 16 * et + fr; const float rr = bf2f(rp[C_GR]);
                rp[C_YGLA] = f2bf(acc[et][j] * ss[j] * ng * siluf_(rr)); } }
    }
}

__device__ __forceinline__ void gla_naive_phase(Frame& F, int l) {
    if (F.vcu >= BATCH * 4) return;
    bf16_t* proj = (bf16_t*)(F.ws + WS_R0);
    const float* w_alpha = F.in[F.z + F.z + 12] + l * 16 * 256; const float* b_alpha = F.in[F.z + F.z + 13] + l * 256; const float* norm_g = F.in[F.z + F.z + 14] + l * 512;
    const int b = F.vcu >> 2, h = F.vcu & 3, t = F.tid, lane = t & 63, e = t & 127, half = (t >> 7) & 1; const bool act = t < 256;
    LAS float* sa = (LAS float*)(F.lds + RING_OFF); LAS float* sq = sa + 64; LAS float* sk = sq + 64; LAS float* part = sk + 64; LAS float* red = part + 256;
    float S[32];
#pragma unroll
    for (int i = 0; i < 32; ++i) S[i] = 0.f;
    float wa[16]; float ba = 0.f;
#pragma unroll
    for (int j = 0; j < 16; ++j) wa[j] = 0.f;
    if (t < 64) { for (int j = 0; j < 16; ++j) wa[j] = w_alpha[j * 256 + h * 64 + t]; ba = b_alpha[h * 64 + t]; }
    const float ng = norm_g[h * 128 + e];
    for (int s = 0; s < SEQ; ++s) {
        bf16_t* row = proj + (size_t)(b * SEQ + s) * PW;
        if (t < 64) {
            float z = ba;
#pragma unroll
            for (int j = 0; j < 16; ++j) z += bf2f(row[C_GA + j]) * wa[j];
            const float ls = fminf(z, 0.f) - log1pf(__expf(-fabsf(z)));
            sa[t] = __expf(ls * (1.f / 16.f)); sq[t] = bf2f(row[C_GQ + h * 64 + t]); sk[t] = bf2f(row[C_GK + h * 64 + t]);
        }
        const float v = bf2f(row[C_GV + h * 128 + e]);
        const float rr = bf2f(row[C_GR + h * 128 + e]);
        __syncthreads();
        if (act) { float p = 0.f;
#pragma unroll
            for (int i = 0; i < 32; ++i) { const int d = half * 32 + i; S[i] = sa[d] * S[i] + sk[d] * v; p += sq[d] * S[i]; }
            part[half * 128 + e] = p; }
        __syncthreads();
        float o = 0.f;
        if (t < 128) { o = part[e] + part[128 + e]; const float ss = wave_sum(o * o); if (lane == 0) red[t >> 6] = ss; }
        __syncthreads();
        if (t < 128) { const float r = rsqrtf((red[0] + red[1]) * (1.f / 128.f) + EPS); row[C_YGLA + h * 128 + e] = f2bf(o * r * ng * siluf_(rr)); }
        __syncthreads();
    }
}
template <bool STONLY> __device__ __forceinline__ void s5_naive_phase_t(Frame& F, int l) {
    if (F.wave != 0) return;
    const float* lam_re = F.in[F.z + F.z + 17] + l * 2048; const float* lam_im = F.in[F.z + F.z + 18] + l * 2048; const float* log_step = F.in[F.z + F.z + 19] + l * 32;
    const float* b_re = F.in[F.z + F.z + 20] + l * 32768; const float* b_im = F.in[F.z + F.z + 21] + l * 32768; const float* c_re = F.in[F.z + F.z + 22] + l * 32768; const float* c_im = F.in[F.z + F.z + 23] + l * 32768; const float* d_skip = F.in[F.z + F.z + 24] + l * 512;
    bf16_t* proj = (bf16_t*)(F.ws + WS_R0);
    for (int item = F.vcu; item < BATCH * 32; item += F.G) {
        const int b = item >> 5, g = item & 31, p = F.lane;
        const float lr = lam_re[g * 64 + p], li = lam_im[g * 64 + p], dt = expf(log_step[g]);
        const float mag = expf(lr * dt), ar = mag * cosf(li * dt), ai = mag * sinf(li * dt);
        const float nr = ar - 1.f, ni = ai, den = lr * lr + li * li, fre = (nr * lr + ni * li) / den, fim = (ni * lr - nr * li) / den;
        float bbr[16], bbi[16], cr[16], ci[16];
#pragma unroll
        for (int h = 0; h < 16; ++h) { const float br = b_re[(g * 64 + p) * 16 + h], bi = b_im[(g * 64 + p) * 16 + h]; bbr[h] = fre * br - fim * bi; bbi[h] = fre * bi + fim * br;
            cr[h] = c_re[(g * 16 + h) * 64 + p]; ci[h] = c_im[(g * 16 + h) * 64 + p]; }
        const float dsk = (p < 16) ? d_skip[g * 16 + p] : 0.f;
        float xr = 0.f, xi = 0.f;
        for (int s = 0; s < SEQ; ++s) {
            bf16_t* row = proj + (size_t)(b * SEQ + s) * PW + C_SU + g * 16;
            float u[16];
#pragma unroll
            for (int h = 0; h < 16; ++h) u[h] = bf2f(row[h]);
            float bur = 0.f, bui = 0.f;
#pragma unroll
            for (int h = 0; h < 16; ++h) { bur += bbr[h] * u[h]; bui += bbi[h] * u[h]; }
            if (STONLY && (s & 63) == 0) ((float2*)(F.ws + WS_S5ST))[((size_t)item * 32 + (s >> 6)) * 64 + p] = make_float2(xr, xi);
#if defined(S5_DIAG)
            if ((s & 63) == 0) ((float2*)(F.ws + WS_U))[((size_t)item * 32 + (s >> 6)) * 64 + p] = make_float2(xr, xi);
#endif
            const float nxr = ar * xr - ai * xi + bur, nxi = ar * xi + ai * xr + bui; xr = nxr; xi = nxi;
            float yn = 0.f;
#pragma unroll
            for (int n = 0; n < 16; ++n) { const float v = wave_sum(cr[n] * xr - ci[n] * xi); if (p == n) yn = v + dsk * u[n]; }
            if (!STONLY && p < 16) { const float x3 = yn * yn * yn; const float gl = 0.5f * yn * (1.f + tanhf(0.7978845608028654f * (yn + 0.044715f * x3))); row[p] = f2bf(gl); }
        }
    }
}

__device__ __forceinline__ void s5_naive_phase(Frame& F, int l) { s5_naive_phase_t<false>(F, l); }


__device__ __forceinline__ void run_phase(Frame& F, int ph) {
    bf16_t* wb = (bf16_t*)(F.ws + WS_W); bf16_t* u = (bf16_t*)(F.ws + WS_U); bf16_t* y = (bf16_t*)(F.ws + WS_Y);
    bf16_t* hid = (bf16_t*)(F.ws + WS_R0); bf16_t* proj = (bf16_t*)(F.ws + WS_R0);
    if (ph == PH_PROLOGUE) { ada_phase(F); convert_layer(F, 0); s5_tables(F, 0); return; }
    if (ph == PH_ROW0) { rowpass_phase(F, 0, 0); return; }
    const int l = (ph - PH_LAYER0) / NPL, s = (ph - PH_LAYER0) % NPL;
    const int cid = F.cid;
    switch (s) {
    case S_UP1: case S_UP2: {
        typedef pg8::GemmT<D, D, D, 0, 0> GT; GT g{u, wb + (s == S_UP1 ? W_UP1 : W_UP2)}; pg8::StaticOrder S; S.init(M, 2 * DFF, F.G, cid);
        pg8::EpiSwiGLU E{hid}; pg8::gemm_phase<pg8::EpiSwiGLU, pg8::StaticOrder, GT, true, true>(F.lds + RING_OFF, g, S, E); break; }
    case S_DN1: case S_DN2: {
        typedef pg8::GemmT<DFF, DFF, DFF, 0, 0> GT; GT g{hid, wb + (s == S_DN1 ? W_DN1 : W_DN2)}; pg8::StaticOrder S; S.init(M, D, F.G, cid);
        typedef pg8::EpiStore<D, 0> ET; ET E{y}; pg8::gemm_phase<ET, pg8::StaticOrder, GT, true, true>(F.lds + RING_OFF, g, S, E); break; }
    case S_ROWA: rowpass_phase(F, l, 1); break;
    case S_WIN: {
        typedef pg8::GemmT<D, D, D, 0, 0> GT; GT g{u, wb + W_IN}; pg8::StaticOrder S; S.init(M, PW, F.G, cid);
        typedef pg8::EpiStore<PW, 1> ET; ET E{proj}; pg8::gemm_phase<ET, pg8::StaticOrder, GT, true, true>(F.lds + RING_OFF, g, S, E); break; }
    case S_DFIN: dfin_phase(F, l); break;
    case S_GLU: {
#if defined(S5_DUMMY_OUT) && !defined(S5_EXP1)
        typedef pg8::GemmT<512, 512, 512, 0, 0> GT; GT g{(const bf16_t*)(F.ws + WS_GLA), wb + W_GLU}; pg8::StaticOrder S; S.init(M, 1024, F.G, cid);
#else
        typedef pg8::GemmT<PW, 512, 512, 0, 0> GT; GT g{proj + C_YS5PRE, wb + W_GLU}; pg8::StaticOrder S; S.init(M, 1024, F.G, cid);
#endif
        pg8::EpiGLU E{proj, F.in[F.z + 26] + l * 1024}; pg8::gemm_phase<pg8::EpiGLU, pg8::StaticOrder, GT, true, true>(F.lds + RING_OFF, g, S, E); break; }
    case S_BRANCH: {
        typedef pg8::GemmT<PW, 512, 512, 512 * 2, 1024 * 512 * 2> GT; GT g{proj + C_YGLA, wb + W_BR}; pg8::StaticOrder S; S.init(M, D, F.G, cid, 3);
        pg8::EpiBranch E{proj}; pg8::gemm_phase<pg8::EpiBranch, pg8::StaticOrder, GT, true, true>(F.lds + RING_OFF, g, S, E); break; }
    case S_WOUT: {
        typedef pg8::GemmT<PW, D, D, 0, 0> GT; GT g{proj + C_MERGED, wb + W_OUT}; pg8::StaticOrder S; S.init(M, D, F.G, cid);
        typedef pg8::EpiStore<D, 0> ET; ET E{y}; pg8::gemm_phase<ET, pg8::StaticOrder, GT, true, true>(F.lds + RING_OFF, g, S, E); break; }
    case S_ROWB: rowpass_phase(F, l, 2); break;
    case S_ROWC: rowpass_phase(F, l, 3); if (l + 1 < DEPTH) { convert_layer(F, l + 1); s5_tables(F, l + 1); } break;
#ifndef FAST_GLA
#define FAST_GLA 1
#endif
#ifndef FAST_S5
#define FAST_S5 1
#endif
#ifndef S5_EXP
#define S5_EXP 0
#endif
#if defined(S5_DUMMY_OUT)
#define S5_DUMMY 1
#else
#define S5_DUMMY 0
#endif
    case S_MIX1: if (FAST_GLA) gla_pass1(F, l); else gla_naive_phase(F, l); if (FAST_S5) s5_pass<false>(F, l); break;
    case S_MIX2: if (FAST_GLA) gla_pass2(F); if (FAST_S5 && S5_EXP != 2) s5_carry(F, l); if (!FAST_S5 || S5_EXP == 1) s5_naive_phase(F, l); if (S5_EXP == 2) s5_naive_phase_t<true>(F, l); break;
    case S_MIX3: if (FAST_GLA) gla_pass3(F, l); if (FAST_S5 && (S5_EXP != 1 || S5_DUMMY)) s5_pass<true>(F, l); break;
    case S_ATTN: { const attn_body::StaticOrder S(F.G, F.vcu); attn_body::attn_phase<attn_body::StaticOrder>(F.ldsg + RING_OFF, (const attn_body::bf16*)proj, F.in[F.z + 2], S); break; }
    default: break;
    }
}

__device__ __forceinline__ const void* opaque_sptr(const void* p) {
    unsigned lo = (unsigned)(uintptr_t)p, hi = (unsigned)((uintptr_t)p >> 32); asm volatile("" : "+s"(lo), "+s"(hi)); const void* q = (const void*)(((uintptr_t)hi << 32) | lo);
#if defined(__HIP_DEVICE_COMPILE__)
    __builtin_assume(!__builtin_amdgcn_is_shared(q)); __builtin_assume(!__builtin_amdgcn_is_private(q));
#endif
    return q;
}
__device__ __forceinline__ const void* opaque_ptr(const void* p) {
    unsigned lo = (unsigned)(uintptr_t)p, hi = (unsigned)((uintptr_t)p >> 32); asm volatile("" : "+v"(lo), "+v"(hi));
    lo = __builtin_amdgcn_readfirstlane(lo); hi = __builtin_amdgcn_readfirstlane(hi); return (const void*)(((uintptr_t)hi << 32) | lo);
}
__global__ void __launch_bounds__(NWAVES * 64, 2) mk_fwd(Args args) {
    extern __shared__ __attribute__((aligned(16))) unsigned char lds[];
    Frame F;
    F.lds = (LAS unsigned char*)lds; F.ldsg = (char*)lds;
    F.tid = threadIdx.x; F.lane = F.tid & 63; F.wave = __builtin_amdgcn_readfirstlane(F.tid >> 6);
    F.G = gridDim.x; int vcu0; { const int bx = blockIdx.x; vcu0 = (F.G % 8 == 0) ? (bx % 8) * (F.G / 8) + bx / 8 : bx; } F.vcu = vcu0; F.cid = blockIdx.x; F.z = 0;
    F.in = args.in; F.out = args.out; F.ws = args.ws;
    for (int u = F.tid; u < (LDS_BYTES - LDSCTL_OFF) / 4; u += NWAVES * 64) ((LAS unsigned*)(F.lds + LDSCTL_OFF))[u] = 0u;
    __syncthreads();
    XcdBarrier bar; bar.bar = (unsigned*)(args.ws + WS_CTL) + CW_BAR; bar.x = 0; bar.st = nullptr;
    const bool multi = (__builtin_amdgcn_readfirstlane(args.ph_hi) - __builtin_amdgcn_readfirstlane(args.ph_lo)) > 1;
    if (multi) bar = xcd_barrier_post((unsigned*)(args.ws + WS_CTL) + CW_BAR, (volatile LAS unsigned*)(F.lds + MISC_OFF) + 8);
    const int ph_lo = __builtin_amdgcn_readfirstlane(args.ph_lo), ph_hi = __builtin_amdgcn_readfirstlane(args.ph_hi);
    for (int ph = ph_lo; ph < ph_hi; ++ph) {
        int t_ = threadIdx.x; asm volatile("" : "+v"(t_));
        F.tid = t_; F.lane = t_ & 63; F.wave = __builtin_amdgcn_readfirstlane(t_ >> 6);
        { int z_ = 0, v_ = vcu0, g_ = (int)gridDim.x, c_ = (int)blockIdx.x; asm volatile("" : "+s"(z_), "+s"(v_), "+s"(g_), "+s"(c_));
          F.z = z_; F.vcu = v_; F.G = g_; F.cid = c_;
          F.ws = args.ws + z_; F.out = args.out + z_; }
        run_phase(F, ph);
        if (ph + 1 < ph_hi) { XcdBarrier b2 = bar; b2.bar = bar.bar + F.z; { unsigned x_ = bar.x; asm volatile("" : "+s"(x_)); b2.x = x_; } xcd_barrier(b2); }
    }
}

extern "C" void kernel_launch(void* const* d_in, const int* in_sizes, int n_in, void* d_out, int out_size, void* d_ws, size_t ws_size, hipStream_t stream) {
    static int grid = 0;
    if (grid == 0) {
        if (n_in != 29 || in_sizes[0] != M * D || out_size != M * D || ws_size < WS_END) {
            fprintf(stderr, "kernel_launch: unexpected shapes/workspace: n_in %d in0 %d out %d ws %zu (need %zu)\n", n_in, n_in > 0 ? in_sizes[0] : -1, out_size, ws_size, (size_t)WS_END); grid = -1; return; }
        int dev = 0, cus = 0;
        if (hipGetDevice(&dev) != hipSuccess || hipDeviceGetAttribute(&cus, hipDeviceAttributeMultiprocessorCount, dev) != hipSuccess) { grid = -1; return; }
        if (hipFuncSetAttribute((const void*)mk_fwd, hipFuncAttributeMaxDynamicSharedMemorySize, LDS_BYTES) != hipSuccess) { fprintf(stderr, "kernel_launch: hipFuncSetAttribute failed\n"); grid = -1; return; }
        grid = cus;
    }
    if (grid < 0) return;
    Args a{};
    for (int i = 0; i < 29; ++i) a.in[i] = (const float*)d_in[i];
    a.out = (float*)d_out; a.ws = (unsigned char*)d_ws;
    if (hipMemsetAsync((char*)d_ws + WS_CTL, 0, CTL_ZERO_BYTES, stream) != hipSuccess) { fprintf(stderr, "kernel_launch: memset failed\n"); return; }
    a.ph_lo = 0; a.ph_hi = N_PHASES;
    hipLaunchKernelGGL(mk_fwd, dim3(grid), dim3(NWAVES * 64), LDS_BYTES, stream, a);
}
```

```cpp
#include <hip/hip_runtime.h>
#include <cstdio>
#include <cstdint>
#include <cmath>

constexpr int D = 1024, BATCH = 8, SEQ = 2048, DEPTH = 2, M = BATCH * SEQ;
constexpr int DFF = 2816, INW = 6672, PW = 6912;
constexpr int ADA = 9 * D;
constexpr float EPS = 1e-6f;
constexpr float LOG2E = 1.4426950408889634f;
constexpr float QSCALE = 0.125f * LOG2E;
constexpr int C_GV = 0, C_DQ = 512, C_DK = 1024, C_DV = 1536, C_GQ = 2048, C_GK = 2304, C_GR = 2560, C_SU = 3072, C_GATE = 3584, C_GA = 6656;
constexpr int C_O = C_GQ;
constexpr int C_YGLA = C_GV, C_YDIFF = C_DQ, C_YS5 = C_DK, C_YS5PRE = C_SU, C_MERGED = C_GQ;

typedef unsigned short bf16_t;
typedef short bf16x8 __attribute__((ext_vector_type(8)));
typedef float f32x4 __attribute__((ext_vector_type(4)));
typedef unsigned u32x4 __attribute__((ext_vector_type(4)));
__device__ __forceinline__ float bf2f(bf16_t v) { return __uint_as_float(((unsigned)v) << 16); }
__device__ __forceinline__ bf16_t f2bf(float f) { unsigned u = __float_as_uint(f); return (bf16_t)((u + 0x7fffu + ((u >> 16) & 1u)) >> 16); }
__device__ __forceinline__ unsigned pk2(float lo, float hi) { return (unsigned)f2bf(lo) | ((unsigned)f2bf(hi) << 16); }
__device__ __forceinline__ float blo(unsigned w) { return __uint_as_float(w << 16); }
__device__ __forceinline__ float bhi(unsigned w) { return __uint_as_float(w & 0xffff0000u); }
__device__ __forceinline__ float sigmoidf_(float x) { return 1.f / (1.f + __expf(-x)); }
__device__ __forceinline__ float siluf_(float x) { return x / (1.f + __expf(-x)); }
template <int MSK> __device__ __forceinline__ float swz_xor(float v) { return __int_as_float(__builtin_amdgcn_ds_swizzle(__float_as_int(v), 0x1F | (MSK << 10))); }
__device__ __forceinline__ float xor32_sum(float v) { auto rr = __builtin_amdgcn_permlane32_swap(__float_as_uint(v), __float_as_uint(v), false, false); return __uint_as_float(rr[0]) + __uint_as_float(rr[1]); }
__device__ __forceinline__ float wave_sum(float v) {
    v += swz_xor<1>(v); v += swz_xor<2>(v); v += swz_xor<4>(v); v += swz_xor<8>(v); v += swz_xor<16>(v);
    return xor32_sum(v);
}
__device__ __forceinline__ int ref2my(int c) {
    if (c < 256) return C_GQ + c;
    if (c < 512) return C_GK + (c - 256);
    if (c < 1024) return C_GV + (c - 512);
    if (c < 1536) return C_GR + (c - 1024);
    if (c < 1552) return C_GA + (c - 1536);
    if (c < 2064) return C_DQ + (c - 1552);
    if (c < 2576) return C_DK + (c - 2064);
    if (c < 3088) return C_DV + (c - 2576);
    if (c < 3600) return C_SU + (c - 3088);
    return C_GATE + (c - 3600);
}
__device__ __forceinline__ int my2ref(int c) {
    if (c < C_DQ) return 512 + c;
    if (c < C_DK) return 1552 + (c - C_DQ);
    if (c < C_DV) return 2064 + (c - C_DK);
    if (c < C_GQ) return 2576 + (c - C_DV);
    if (c < C_GK) return c - C_GQ;
    if (c < C_GR) return 256 + (c - C_GK);
    if (c < C_SU) return 1024 + (c - C_GR);
    if (c < C_GATE) return 3088 + (c - C_SU);
    if (c < C_GA) return 3600 + (c - C_GATE);
    if (c < C_GA + 16) return 1536 + (c - C_GA);
    return -1;
}
__device__ const unsigned char T5B[128] = {0, 1, 2, 3, 4, 5, 6, 7, 8, 9, 10, 11, 12, 13, 14, 15, 16, 16, 16, 17, 17, 18, 18, 18, 19, 19, 19, 20, 20, 20, 20, 21, 21, 21, 21, 22, 22, 22, 22, 22, 23, 23, 23, 23, 23, 23, 24, 24, 24, 24, 24, 24, 25, 25, 25, 25, 25, 25, 25, 26, 26, 26, 26, 26, 26, 26, 26, 27, 27, 27, 27, 27, 27, 27, 27, 27, 27, 28, 28, 28, 28, 28, 28, 28, 28, 28, 28, 29, 29, 29, 29, 29, 29, 29, 29, 29, 29, 29, 29, 30, 30, 30, 30, 30, 30, 30, 30, 30, 30, 30, 30, 30, 30, 31, 31, 31, 31, 31, 31, 31, 31, 31, 31, 31, 31, 31, 31, 31};

constexpr size_t MiB = 1u << 20;
constexpr size_t WS_CTL = 0, CTL_ZERO_BYTES = 1 * MiB, WS_ADA = 1 * MiB, WS_S5ST = 2 * MiB, WS_W = 6 * MiB, WS_U = 59 * MiB, WS_GLA = 91 * MiB, WS_R0 = 123 * MiB, WS_S5ST2 = 339 * MiB, WS_END = 343 * MiB;
constexpr size_t WS_Y = WS_GLA;
constexpr size_t W_UP1 = 0, W_DN1 = W_UP1 + (size_t)2 * DFF * D, W_UP2 = W_DN1 + (size_t)D * DFF, W_DN2 = W_UP2 + (size_t)2 * DFF * D, W_IN = W_DN2 + (size_t)D * DFF,
                 W_GLU = W_IN + (size_t)PW * D, W_BR = W_GLU + (size_t)1024 * 512, W_OUT = W_BR + (size_t)3 * 1024 * 512, W_END = W_OUT + (size_t)D * D;
static_assert(W_END * 2 <= 53 * MiB, "weights fit");

__device__ __forceinline__ void rowpass_row(int row, int lane, const float* h_in, float* h_out, const bf16_t* y, const float* gpost, const float* gate, float coef,
                                            const float* gpre, const float* shift, const float* scale, bf16_t* u) {
    const int b = row / SEQ;
    f32x4 hv[4];
#pragma unroll
    for (int j = 0; j < 4; ++j) hv[j] = *(const f32x4*)(h_in + (size_t)row * D + j * 256 + lane * 4);
    if (y) {
        float yv[4][4]; float ss = 0.f;
#pragma unroll
        for (int j = 0; j < 4; ++j) {
            const uint2 raw = *(const uint2*)(y + (size_t)row * D + j * 256 + lane * 4);
            yv[j][0] = blo(raw.x); yv[j][1] = bhi(raw.x); yv[j][2] = blo(raw.y); yv[j][3] = bhi(raw.y);
#pragma unroll
            for (int i = 0; i < 4; ++i) ss += yv[j][i] * yv[j][i];
        }
        const float r = rsqrtf(wave_sum(ss) * (1.f / D) + EPS);
#pragma unroll
        for (int j = 0; j < 4; ++j) {
            const int c0 = j * 256 + lane * 4;
            const f32x4 gp = *(const f32x4*)(gpost + c0), gt = *(const f32x4*)(gate + (size_t)b * ADA + c0);
#pragma unroll
            for (int i = 0; i < 4; ++i) hv[j][i] += coef * gt[i] * (yv[j][i] * r * gp[i]);
        }
    }
    if (y || h_in != h_out) {
#pragma unroll
        for (int j = 0; j < 4; ++j) *(f32x4*)(h_out + (size_t)row * D + j * 256 + lane * 4) = hv[j];
    }
    if (u) {
        float ss = 0.f;
#pragma unroll
        for (int j = 0; j < 4; ++j)
#pragma unroll
            for (int i = 0; i < 4; ++i) ss += hv[j][i] * hv[j][i];
        const float r = rsqrtf(wave_sum(ss) * (1.f / D) + EPS);
#pragma unroll
        for (int j = 0; j < 4; ++j) {
            const int c0 = j * 256 + lane * 4;
            const f32x4 g = *(const f32x4*)(gpre + c0), sh = *(const f32x4*)(shift + (size_t)b * ADA + c0), sc = *(const f32x4*)(scale + (size_t)b * ADA + c0);
            float o[4];
#pragma unroll
            for (int i = 0; i < 4; ++i) o[i] = hv[j][i] * r * g[i] * (1.f + sc[i]) + sh[i];
            uint2 w; w.x = pk2(o[0], o[1]); w.y = pk2(o[2], o[3]);
            *(uint2*)(u + (size_t)row * D + c0) = w;
        }
    }
}

__device__ __forceinline__ void diff_fin_row(bf16_t* r, int lane, float lam, const float* norm_g, float lam_init) {
#pragma unroll
    for (int h = 0; h < 4; ++h) {
        const unsigned a = *(const unsigned*)(r + C_O + (2 * h) * 128 + lane * 2), c = *(const unsigned*)(r + C_O + (2 * h + 1) * 128 + lane * 2);
        const float o0 = blo(a) - lam * blo(c), o1 = bhi(a) - lam * bhi(c);
        const float rs = rsqrtf(wave_sum(o0 * o0 + o1 * o1) * (1.f / 128.f) + EPS) * (1.f - lam_init);
        const float g0 = norm_g[h * 128 + lane * 2], g1 = norm_g[h * 128 + lane * 2 + 1];
        *(unsigned*)(r + C_YDIFF + h * 128 + lane * 2) = pk2(o0 * rs * g0, o1 * rs * g1);
    }
}

namespace pg8 {
#define PG8_LAS __attribute__((address_space(3)))
constexpr int BM = 256, BK = 64, HALF = 128, HTB = HALF * BK * 2  , STAGE_BYTES = 8 * HTB, NXCD = 8, WGM = 8;

__host__ __device__ __forceinline__ int lds_byte(int r, int c) { const int st = (r >> 4) * 2 + (c >> 5), rr = r & 15, cc = c & 31, ob = rr * 64 + cc * 2; return st * 1024 + (ob ^ (((ob >> 9) & 1) << 5)); }
__host__ __device__ __forceinline__ void stage_rc(int b, int& R, int& C) { const int st = b / 1024, sb = b % 1024, swz = sb ^ (((sb >> 9) & 1) << 5); R = (st >> 1) * 16 + swz / 64; C = (st & 1) * 32 + (swz % 64) / 2; }
__host__ __device__ __forceinline__ int perm32(int rho) { const int n = rho >> 4, i = rho & 15; return 8 * (i >> 2) + 4 * n + (i & 3); }

struct Unit { int pm, pn, z; };
template <int LDA, int LDB, int KK, int ZA, int ZB> struct GemmT { const bf16_t* A; const bf16_t* Bt; static constexpr int lda = LDA, ldb = LDB, K = KK; static constexpr size_t zA = ZA, zB = ZB; };

struct StaticOrder {
    int nM, nN, nwg, G, c, nZ;
    __host__ __device__ void init(int M_, int N_, int G_, int c_, int nZ_ = 1) { nM = M_ / BM; nN = N_ / BM; nwg = nM * nN; G = G_; c = c_; nZ = nZ_; }
    __host__ __device__ bool next(int i, Unit& u) const {
        const long L = (long)(i / nZ) * G + c; if (L >= nwg) return false;
        int wgid = (int)L; { const int q = nwg / NXCD, r = nwg % NXCD, xcd = wgid % NXCD, off = wgid / NXCD; wgid = (xcd < r ? xcd * (q + 1) : r * (q + 1) + (xcd - r) * q) + off; }
        const int nig = WGM * nN, gid = wgid / nig, fm = gid * WGM, gsz = (nM - fm) < WGM ? (nM - fm) : WGM;
        u.pm = fm + ((wgid % nig) % gsz); u.pn = (wgid % nig) / gsz; u.z = i % nZ; return true;
    }
    __device__ __forceinline__ void a_ready(const Unit&) const {}
    __device__ __forceinline__ void done(const Unit&) const {}
};
__device__ __forceinline__ unsigned cvt_pk_bf16(float lo, float hi) { unsigned r; asm volatile("v_cvt_pk_bf16_f32 %0, %1, %2" : "=v"(r) : "v"(lo), "v"(hi)); return r; }

__device__ __forceinline__ u32x4 pack8(const f32x4 v0, const f32x4 v1) { u32x4 w; w.x = cvt_pk_bf16(v0[0], v0[1]); w.y = cvt_pk_bf16(v0[2], v0[3]); w.z = cvt_pk_bf16(v1[0], v1[1]); w.w = cvt_pk_bf16(v1[2], v1[3]); return w; }
__device__ __forceinline__ float fsig(float x) { return __builtin_amdgcn_rcpf(1.f + __expf(-x)); }
template <int ldc, int mode> struct EpiStore {
    static constexpr bool PERM = true, AFTER_DRAIN = false;
    bf16_t* O;
    __device__ __forceinline__ void operator()(const f32x4 (&acc)[2][2][4][2], const Unit& u, int wr, int wc, int fr, int fq) const {
        float sc = 1.f; if (mode == 1) { if (u.pn == 2 || u.pn == 3) sc = QSCALE; else if (u.pn == 8) sc = 0.125f; }
        const int row0 = u.pm * BM + wr * 64 + fr, col0 = u.pn * BM + wc * 32 + 8 * fq;
#pragma unroll
        for (int ai = 0; ai < 2; ++ai)
#pragma unroll
            for (int m = 0; m < 4; ++m) { bf16_t* rowp = O + (size_t)(row0 + ai * HALF + m * 16) * ldc + col0;
#pragma unroll
                for (int bj = 0; bj < 2; ++bj) *(u32x4*)(rowp + bj * HALF) = pack8(acc[ai][bj][m][0] * sc, acc[ai][bj][m][1] * sc); }
    }
};
struct EpiSwiGLU {
    static constexpr bool PERM = true, AFTER_DRAIN = false;
    bf16_t* H;
    __device__ __forceinline__ void operator()(const f32x4 (&acc)[2][2][4][2], const Unit& u, int wr, int wc, int fr, int fq) const {
        const int row0 = u.pm * BM + wr * 64 + fr, col0 = u.pn * HALF + wc * 32 + 8 * fq;
#pragma unroll
        for (int ai = 0; ai < 2; ++ai)
#pragma unroll
            for (int m = 0; m < 4; ++m) { f32x4 o[2];
#pragma unroll
                for (int n = 0; n < 2; ++n)
#pragma unroll
                    for (int j = 0; j < 4; ++j) { const float g = acc[ai][0][m][n][j]; o[n][j] = g * fsig(g) * acc[ai][1][m][n][j]; }
                *(u32x4*)(H + (size_t)(row0 + ai * HALF + m * 16) * DFF + col0) = pack8(o[0], o[1]); }
    }
};
struct EpiGLU {
    static constexpr bool PERM = true, AFTER_DRAIN = false;
    bf16_t* P; const float* bias;
    __device__ __forceinline__ void operator()(const f32x4 (&acc)[2][2][4][2], const Unit& u, int wr, int wc, int fr, int fq) const {
        const int row0 = u.pm * BM + wr * 64 + fr, col0 = u.pn * HALF + wc * 32 + 8 * fq;
        f32x4 bv[2], bg[2];
#pragma unroll
        for (int n = 0; n < 2; ++n) { bv[n] = *(const f32x4*)(bias + col0 + 4 * n); bg[n] = *(const f32x4*)(bias + 512 + col0 + 4 * n); }
#pragma unroll
        for (int ai = 0; ai < 2; ++ai)
#pragma unroll
            for (int m = 0; m < 4; ++m) { f32x4 o[2];
#pragma unroll
                for (int n = 0; n < 2; ++n)
#pragma unroll
                    for (int j = 0; j < 4; ++j) o[n][j] = (acc[ai][0][m][n][j] + bv[n][j]) * fsig(acc[ai][1][m][n][j] + bg[n][j]);
                *(u32x4*)(P + (size_t)(row0 + ai * HALF + m * 16) * PW + C_YS5 + col0) = pack8(o[0], o[1]); }
    }
};
struct EpiBranch {
    static constexpr bool PERM = true, AFTER_DRAIN = false;
    bf16_t* P;
    __device__ __forceinline__ void operator()(const f32x4 (&acc)[2][2][4][2], const Unit& u, int wr, int wc, int fr, int fq) const {
        const int row0 = u.pm * BM + wr * 64 + fr, col0 = u.pn * BM + wc * 32 + 8 * fq;
#pragma unroll
        for (int ai = 0; ai < 2; ++ai)
#pragma unroll
            for (int m = 0; m < 4; ++m) { bf16_t* rowp = P + (size_t)(row0 + ai * HALF + m * 16) * PW;
#pragma unroll
                for (int bj = 0; bj < 2; ++bj) { const int col = col0 + bj * HALF;
                    const u32x4 gw = *(const u32x4*)(rowp + C_GATE + u.z * D + col);
                    u32x4 pw = (u32x4){0u, 0u, 0u, 0u}; if (u.z > 0) pw = *(const u32x4*)(rowp + C_MERGED + col);
                    f32x4 o[2];
#pragma unroll
                    for (int n = 0; n < 2; ++n) { const unsigned g0 = gw[2 * n], g1 = gw[2 * n + 1], p0 = pw[2 * n], p1 = pw[2 * n + 1];
                        o[n][0] = blo(p0) + fsig(blo(g0)) * acc[ai][bj][m][n][0]; o[n][1] = bhi(p0) + fsig(bhi(g0)) * acc[ai][bj][m][n][1];
                        o[n][2] = blo(p1) + fsig(blo(g1)) * acc[ai][bj][m][n][2]; o[n][3] = bhi(p1) + fsig(bhi(g1)) * acc[ai][bj][m][n][3]; }
                    *(u32x4*)(rowp + C_MERGED + col) = pack8(o[0], o[1]); } }
    }
};

template <class Epi, class Sched, class GemmX, bool ALIGN_EPI = false, bool SP2 = false>
__device__ __forceinline__ void gemm_phase(PG8_LAS unsigned char* lds, const GemmX g, const Sched& S, const Epi& E) {
    int tid_ = threadIdx.x; asm volatile("" : "+v"(tid_));
    const int tid = tid_, wid = __builtin_amdgcn_readfirstlane(tid >> 6), lane = tid & 63, wr = wid >> 2, wc = wid & 3, fr = lane & 15, fq = lane >> 4;
    const int K = g.K, nt = K / BK;
    unsigned voffA[2], voffB[2];
#pragma unroll
    for (int i = 0; i < 2; ++i) { int R, C; stage_rc(tid * 16 + i * 8192, R, C); const int Rb = Epi::PERM ? ((R & ~31) + perm32(R & 31)) : R;
        voffA[i] = (unsigned)(R * g.lda + C) * 2u; voffB[i] = (unsigned)(Rb * g.ldb + C) * 2u; }
    const size_t kstep = (size_t)(BK * 2);
    const size_t hstepA = (size_t)HALF * g.lda * 2, hstepB = (size_t)HALF * g.ldb * 2;
    const size_t tstepA = 2 * hstepA, tstepB = 2 * hstepB;
    const unsigned ldsw = (unsigned)wid * 1024u;
    const int aoff = lds_byte(wr * 64 + fr, fq * 8), boff = lds_byte(wc * 32 + fr, fq * 8);
#define PG8_SA(b, h) (((b) * 2 + (h)) * HTB)
#define PG8_SB(b, h) ((4 + (b) * 2 + (h)) * HTB)
#define PG8_STAGE(bufoff, gbase, voff) do { _Pragma("unroll") for (int _i = 0; _i < 2; ++_i) \
        __builtin_amdgcn_global_load_lds((const unsigned*)((const char*)(gbase) + (voff)[_i]), (PG8_LAS unsigned*)(lds + (bufoff) + ldsw + _i * 8192), 16, 0, 0); } while (0)
#define PG8_LDA(dst, b, h) do { _Pragma("unroll") for (int m = 0; m < 4; ++m) _Pragma("unroll") for (int k = 0; k < 2; ++k) dst[m][k] = *(const PG8_LAS bf16x8*)(lds + PG8_SA(b, h) + aoff + m * 2048 + k * 1024); } while (0)
#define PG8_LDB(dst, b, h) do { _Pragma("unroll") for (int n = 0; n < 2; ++n) _Pragma("unroll") for (int k = 0; k < 2; ++k) dst[n][k] = *(const PG8_LAS bf16x8*)(lds + PG8_SB(b, h) + boff + n * 2048 + k * 1024); } while (0)
#define PG8_MMA(ai, bj, At, Bt) do { __builtin_amdgcn_s_setprio(1); _Pragma("unroll") for (int m = 0; m < 4; ++m) _Pragma("unroll") for (int n = 0; n < 2; ++n) _Pragma("unroll") for (int k = 0; k < 2; ++k) \
        acc[ai][bj][m][n] = __builtin_amdgcn_mfma_f32_16x16x32_bf16(Bt[n][k], At[m][k], acc[ai][bj][m][n], 0, 0, 0); __builtin_amdgcn_s_setprio(0); } while (0)
#define PG8_WAIT_V(n) asm volatile("s_waitcnt vmcnt(" #n ")" ::: "memory")
#define PG8_WAIT_L(n) asm volatile("s_waitcnt lgkmcnt(" #n ")" ::: "memory")
#define PG8_BAR __builtin_amdgcn_s_barrier()
#define PG8_SCHED __builtin_amdgcn_sched_barrier(0)
    Unit cur, nxt; int ui = 0;
    if (!S.next(0, cur)) return;
    f32x4 acc[2][2][4][2];
#pragma unroll
    for (int a = 0; a < 2; ++a)
#pragma unroll
        for (int b = 0; b < 2; ++b)
#pragma unroll
            for (int m = 0; m < 4; ++m)
#pragma unroll
                for (int n = 0; n < 2; ++n) acc[a][b][m][n] = (f32x4){0.f, 0.f, 0.f, 0.f};
    bf16x8 At[4][2], B0[2][2], B1[2][2];
    const char* cA = (const char*)g.A + (size_t)cur.pm * tstepA + (size_t)cur.z * g.zA; const char* cB = (const char*)g.Bt + (size_t)cur.pn * tstepB + (size_t)cur.z * g.zB;
    S.a_ready(cur);
    if constexpr (SP2) {
        PG8_STAGE(PG8_SB(0, 0), cB, voffB); PG8_STAGE(PG8_SB(0, 1), cB + hstepB, voffB); PG8_STAGE(PG8_SA(0, 0), cA, voffA); PG8_STAGE(PG8_SA(0, 1), cA + hstepA, voffA);
        if (wr == 1) PG8_BAR;
        PG8_WAIT_V(2); PG8_BAR;
        PG8_STAGE(PG8_SB(1, 0), cB + kstep, voffB); PG8_STAGE(PG8_SA(1, 0), cA + kstep, voffA); PG8_STAGE(PG8_SB(1, 1), cB + hstepB + kstep, voffB);
        PG8_WAIT_V(6); PG8_BAR;
    } else {
        PG8_STAGE(PG8_SB(0, 0), cB, voffB); PG8_STAGE(PG8_SA(0, 0), cA, voffA); PG8_STAGE(PG8_SB(0, 1), cB + hstepB, voffB); PG8_STAGE(PG8_SA(0, 1), cA + hstepA, voffA);
        if (wr == 1) PG8_BAR;
        PG8_WAIT_V(4); PG8_BAR;
        PG8_STAGE(PG8_SB(1, 0), cB + kstep, voffB); PG8_STAGE(PG8_SA(1, 0), cA + kstep, voffA); PG8_STAGE(PG8_SB(1, 1), cB + hstepB + kstep, voffB);
        PG8_WAIT_V(6); PG8_BAR;
    }
    for (;;) {
        const bool has_next = S.next(ui + 1, nxt);
        const char* nA = has_next ? (const char*)g.A + (size_t)nxt.pm * tstepA + (size_t)nxt.z * g.zA : cA; const char* nB = has_next ? (const char*)g.Bt + (size_t)nxt.pn * tstepB + (size_t)nxt.z * g.zB : cB;
        for (int t = 0; t < nt; t += 2) {
            const bool last = (t == nt - 2);
            const char* a1 = cA + (size_t)(t + 1) * kstep;
            const char* a2 = last ? nA : cA + (size_t)(t + 2) * kstep; const char* b2 = last ? nB : cB + (size_t)(t + 2) * kstep;
            const char* a3 = a2 + kstep; const char* b3 = b2 + kstep;
            if (last && has_next) S.a_ready(nxt);
            if constexpr (SP2) {
            PG8_LDB(B0, 0, 0); PG8_LDB(B1, 0, 1); PG8_SCHED; PG8_LDA(At, 0, 0); PG8_STAGE(PG8_SA(1, 1), a1 + hstepA, voffA);
            PG8_WAIT_V(8); PG8_WAIT_L(0); PG8_BAR; PG8_MMA(0, 0, At, B0); PG8_MMA(0, 1, At, B1); PG8_BAR; PG8_SCHED;
            PG8_LDA(At, 0, 1); PG8_STAGE(PG8_SB(0, 0), b2, voffB); PG8_STAGE(PG8_SB(0, 1), b2 + hstepB, voffB); PG8_STAGE(PG8_SA(0, 0), a2, voffA);
            PG8_WAIT_V(8); PG8_WAIT_L(0); PG8_BAR; PG8_MMA(1, 0, At, B0); PG8_MMA(1, 1, At, B1); PG8_BAR; PG8_SCHED;
            PG8_LDB(B0, 1, 0); PG8_LDB(B1, 1, 1); PG8_SCHED; PG8_LDA(At, 1, 0); PG8_STAGE(PG8_SA(0, 1), a2 + hstepA, voffA);
            PG8_WAIT_V(8); PG8_WAIT_L(0); PG8_BAR; PG8_MMA(0, 0, At, B0); PG8_MMA(0, 1, At, B1); PG8_BAR; PG8_SCHED;
            PG8_LDA(At, 1, 1); PG8_STAGE(PG8_SB(1, 0), b3, voffB); PG8_STAGE(PG8_SB(1, 1), b3 + hstepB, voffB); PG8_STAGE(PG8_SA(1, 0), a3, voffA);
            PG8_WAIT_V(8); PG8_WAIT_L(0); PG8_BAR; PG8_MMA(1, 0, At, B0); PG8_MMA(1, 1, At, B1); PG8_BAR; PG8_SCHED;
            } else {
            PG8_LDB(B0, 0, 0); PG8_SCHED; PG8_LDA(At, 0, 0); PG8_STAGE(PG8_SA(1, 1), a1 + hstepA, voffA);
            PG8_WAIT_L(8); PG8_BAR; PG8_WAIT_L(0); PG8_MMA(0, 0, At, B0); PG8_BAR; PG8_SCHED;
            PG8_LDB(B1, 0, 1); PG8_STAGE(PG8_SB(0, 0), b2, voffB);
            PG8_BAR; PG8_WAIT_L(0); PG8_MMA(0, 1, At, B1); PG8_BAR;
            PG8_LDA(At, 0, 1); PG8_STAGE(PG8_SA(0, 0), a2, voffA);
            PG8_BAR; PG8_WAIT_L(0); PG8_MMA(1, 0, At, B0); PG8_BAR; PG8_SCHED;
            PG8_STAGE(PG8_SB(0, 1), b2 + hstepB, voffB);
            PG8_WAIT_V(6); PG8_BAR; PG8_MMA(1, 1, At, B1); PG8_BAR;
            PG8_LDB(B0, 1, 0); PG8_SCHED; PG8_LDA(At, 1, 0); PG8_STAGE(PG8_SA(0, 1), a2 + hstepA, voffA);
            PG8_WAIT_L(8); PG8_BAR; PG8_WAIT_L(0); PG8_MMA(0, 0, At, B0); PG8_BAR; PG8_SCHED;
            PG8_LDB(B1, 1, 1); PG8_STAGE(PG8_SB(1, 0), b3, voffB);
            PG8_BAR; PG8_WAIT_L(0); PG8_MMA(0, 1, At, B1); PG8_BAR;
            PG8_LDA(At, 1, 1); PG8_STAGE(PG8_SA(1, 0), a3, voffA);
            PG8_BAR; PG8_WAIT_L(0); PG8_MMA(1, 0, At, B0); PG8_BAR; PG8_SCHED;
            PG8_STAGE(PG8_SB(1, 1), b3 + hstepB, voffB);
            PG8_WAIT_V(6); PG8_BAR; PG8_MMA(1, 1, At, B1); PG8_BAR;
            }
        }
        if constexpr (ALIGN_EPI) { if (wr == 0) PG8_BAR; }
        if constexpr (!Epi::AFTER_DRAIN) { E(acc, cur, wr, wc, fr, fq); S.done(cur); }
        if (!has_next) break;
#pragma unroll
        for (int a = 0; a < 2; ++a)
#pragma unroll
            for (int b = 0; b < 2; ++b)
#pragma unroll
                for (int m = 0; m < 4; ++m)
#pragma unroll
                    for (int n = 0; n < 2; ++n) acc[a][b][m][n] = (f32x4){0.f, 0.f, 0.f, 0.f};
        cur = nxt; cA = nA; cB = nB; ++ui;
        if constexpr (ALIGN_EPI) { if (wr == 1) PG8_BAR; }
    }
    PG8_WAIT_V(0);
    if constexpr (!ALIGN_EPI) { if (wr == 0) PG8_BAR; }
    PG8_BAR;
    if constexpr (Epi::AFTER_DRAIN) { E.fused(acc, cur, wr, wc, fr, fq, lds, wid, lane); S.done(cur); }
#undef PG8_SA
#undef PG8_SB
#undef PG8_STAGE
#undef PG8_LDA
#undef PG8_LDB
#undef PG8_MMA
#undef PG8_WAIT_V
#undef PG8_WAIT_L
#undef PG8_BAR
#undef PG8_SCHED
}
}

namespace attn_body {
using bf16=unsigned short;
using bf16x8=__attribute__((ext_vector_type(8)))short;
using s16x4=__attribute__((ext_vector_type(4)))short;
using f32x16=__attribute__((ext_vector_type(16)))float;
using u32x4=__attribute__((ext_vector_type(4)))unsigned;
constexpr int NMAP=8,SEQ=2048,D=64,DM=::PW;
constexpr int NW=8,QBLK=32,QB=QBLK*NW,KVBLK=64,NQB=SEQ/QB;

__device__ __forceinline__ int crow(int r,int hi){return (r&3)+8*(r>>2)+4*hi;}
#define SBAR() __builtin_amdgcn_sched_barrier(0)
__device__ __forceinline__ void cmask(f32x16&p0,f32x16&p1,int jb,int qrel,int hi){
  const float NEG=-INFINITY; int kb=64*jb+4*hi;
  #pragma unroll
  for(int r=0;r<16;++r){int kv=kb+(r&3)+8*(r>>2); if(kv>qrel)p0[r]=NEG; if(kv+32>qrel)p1[r]=NEG;}
}

typedef __attribute__((address_space(3))) const float* lds_cfptr;
__device__ __forceinline__ void addbias(f32x16&p0,f32x16&p1,int jb,int qrel,int hi,lds_cfptr tab){
  const int base=qrel-64*jb-4*hi;
  #pragma unroll
  for(int r=0;r<16;++r){const int d0=base-((r&3)+8*(r>>2)); const int i0=d0<0?0:(d0>127?127:d0); const int d1=d0-32; const int i1=d1<0?0:(d1>127?127:d1); p0[r]+=tab[i0]; p1[r]+=tab[i1];}
}
constexpr int NSLOT=3, SLOTB=8192;
constexpr int LDS_K=0, LDS_V=NSLOT*SLOTB, LDS_WS=2*NSLOT*SLOTB, LDS_OST=LDS_WS+NW*64*4, LDS_TAB=LDS_OST+NW*4096, LDS_BYTES=LDS_TAB+512;
constexpr float C2=0.125f*1.4426950408889634f;
__device__ __forceinline__ void glds16(const void*gsrc,unsigned lds_dst){unsigned keep;
  asm volatile("s_mov_b32 %0, m0\n\ts_mov_b32 m0, %2\n\ts_nop 0\n\tglobal_load_lds_dwordx4 %1, off\n\ts_mov_b32 m0, %0":"=&s"(keep):"v"(gsrc),"s"(lds_dst):"memory");}
__device__ __forceinline__ float max3f(float a,float b,float c){float r;asm("v_max3_f32 %0, %1, %2, %3":"=v"(r):"v"(a),"v"(b),"v"(c));return r;}
__device__ __forceinline__ float max2f(float a,float b){float r;asm("v_max_f32_e32 %0, %1, %2":"=v"(r):"v"(a),"v"(b));return r;}
__device__ __forceinline__ float fadd_s(float a,float b){float r;asm("v_add_f32_e32 %0, %1, %2":"=v"(r):"v"(a),"v"(b));return r;}
__device__ __forceinline__ float fsub_s(float a,float b){float r;asm("v_sub_f32_e32 %0, %1, %2":"=v"(r):"v"(a),"v"(b));return r;}
typedef float f32x2_t __attribute__((ext_vector_type(2))); typedef __bf16 bf16x2_t __attribute__((ext_vector_type(2)));
__device__ __forceinline__ unsigned cvtpk_s(float lo,float hi){f32x2_t v={lo,hi};bf16x2_t b=__builtin_convertvector(v,bf16x2_t);return __builtin_bit_cast(unsigned,b);}
#define WAIT_BAR(N) asm volatile("s_waitcnt vmcnt(" #N ") lgkmcnt(0)\n\ts_barrier":::"memory")

__device__ __forceinline__ void qkt(f32x16&p0,f32x16&p1,const char*Kslot,const bf16x8*qr,const f32x16&negm,int r32,int hi){
  const char*kb=Kslot+hi*1024+r32*16;
  #pragma unroll
  for(int d0=0;d0<4;++d0){
    const bf16x8 b0=*reinterpret_cast<const bf16x8*>(kb+d0*2048);
    const bf16x8 b1=*reinterpret_cast<const bf16x8*>(kb+d0*2048+512);
    if(d0==0){p0=__builtin_amdgcn_mfma_f32_32x32x16_bf16(b0,qr[0],negm,0,0,0);p1=__builtin_amdgcn_mfma_f32_32x32x16_bf16(b1,qr[0],negm,0,0,0);}
    else{p0=__builtin_amdgcn_mfma_f32_32x32x16_bf16(b0,qr[d0],p0,0,0,0);p1=__builtin_amdgcn_mfma_f32_32x32x16_bf16(b1,qr[d0],p1,0,0,0);}}
}
typedef __attribute__((address_space(3))) const char* lds_cptr;
typedef short v4i16_t __attribute__((ext_vector_type(4)));
__device__ __forceinline__ void kload8(bf16x8*kf,lds_cptr kp){
  kf[0]=*(const __attribute__((address_space(3))) bf16x8*)(kp);      kf[1]=*(const __attribute__((address_space(3))) bf16x8*)(kp+512);
  kf[2]=*(const __attribute__((address_space(3))) bf16x8*)(kp+2048); kf[3]=*(const __attribute__((address_space(3))) bf16x8*)(kp+2560);
  kf[4]=*(const __attribute__((address_space(3))) bf16x8*)(kp+4096); kf[5]=*(const __attribute__((address_space(3))) bf16x8*)(kp+4608);
  kf[6]=*(const __attribute__((address_space(3))) bf16x8*)(kp+6144); kf[7]=*(const __attribute__((address_space(3))) bf16x8*)(kp+6656);
}
__device__ __forceinline__ void kload2(bf16x8*kf,lds_cptr kp,int j){ kf[2*j]=*(const __attribute__((address_space(3))) bf16x8*)(kp+j*2048); kf[2*j+1]=*(const __attribute__((address_space(3))) bf16x8*)(kp+j*2048+512); }
__device__ __forceinline__ s16x4 vtr(lds_cptr p){ return __builtin_bit_cast(s16x4,__builtin_amdgcn_ds_read_tr16_b64_v4i16((__attribute__((address_space(3))) v4i16_t*)p)); }
__device__ __forceinline__ float rowmax(const f32x16&p0,const f32x16&p1){
  float a=max3f(p0[0],p0[1],p1[0]),b=max3f(p0[2],p0[3],p1[1]);a=max3f(a,p1[2],p1[3]);
  #pragma unroll
  for(int r=4;r<16;r+=4){a=max3f(a,p0[r],p0[r+1]);b=max3f(b,p0[r+2],p0[r+3]);a=max3f(a,p1[r],p1[r+1]);b=max3f(b,p1[r+2],p1[r+3]);}
  const float m=max2f(a,b);
  auto rr=__builtin_amdgcn_permlane32_swap(__float_as_uint(m),__float_as_uint(m),false,false);
  return max2f(__uint_as_float(rr[0]),__uint_as_float(rr[1]));
}
__device__ __forceinline__ void pv(f32x16*o,int vb,bf16x8 pa0,bf16x8 pa1,bf16x8 pa2,bf16x8 pa3){
  #pragma unroll
  for(int d0=0;d0<2;++d0){s16x4 lo[4],hi[4];
    #pragma unroll
    for(int ks=0;ks<4;++ks){
      asm volatile("ds_read_b64_tr_b16 %0,%1 offset:%c2":"=&v"(lo[ks]):"v"(vb),"i"(d0*4096+ks*1024):"memory");
      asm volatile("ds_read_b64_tr_b16 %0,%1 offset:%c2":"=&v"(hi[ks]):"v"(vb),"i"(d0*4096+ks*1024+512):"memory");}
    asm volatile("s_waitcnt lgkmcnt(0)":::"memory");SBAR();
    #define PK(k) (bf16x8){lo[k][0],lo[k][1],lo[k][2],lo[k][3],hi[k][0],hi[k][1],hi[k][2],hi[k][3]}
    o[d0]=__builtin_amdgcn_mfma_f32_32x32x16_bf16(pa0,PK(0),o[d0],0,0,0);
    o[d0]=__builtin_amdgcn_mfma_f32_32x32x16_bf16(pa1,PK(1),o[d0],0,0,0);
    o[d0]=__builtin_amdgcn_mfma_f32_32x32x16_bf16(pa2,PK(2),o[d0],0,0,0);
    o[d0]=__builtin_amdgcn_mfma_f32_32x32x16_bf16(pa3,PK(3),o[d0],0,0,0);
    #undef PK
  }
}

#ifndef ATTN_STORE16
#define ATTN_STORE16(p,v) (*(u32x4*)(p)=(v))
#endif
template<int THRL> __device__ __forceinline__ void attn_unit(int b,int m,int vh,int qb,const bf16*P,const float*rel_bias,char*shm){
  const bf16*Q=P+::C_DQ+m*64; const bf16*K=P+::C_DK+m*64; const bf16*V=P+::C_DV+(m>>1)*128+vh*64; bf16*O=(bf16*)P+::C_O+m*128+vh*64;
  int tid_=threadIdx.x; asm volatile("":"+v"(tid_));
  const int tid=tid_,lane=tid&63,r32=lane&31,hi=lane>>5; const int wid=__builtin_amdgcn_readfirstlane(tid>>6);
  const long rowbase=(long)b*SEQ; const int q0=qb*QB;
  const bf16*Qw=Q+(rowbase+q0+wid*QBLK)*DM;
  const bf16*Kh=K+rowbase*DM,*Vh=V+rowbase*DM;
  const unsigned lds0=(unsigned)(uintptr_t)shm;
  float*wsf=(float*)(shm+LDS_WS)+wid*64;
  const bf16*ksrc=Kh+(long)lane*DM+wid*8;
  const bf16*vsrc=Vh+(long)(16*(wid&3)+(lane>>2))*DM+(wid>>2)*32+(lane&3)*8;
  const unsigned kdst=lds0+LDS_K+wid*1024, vdst=lds0+LDS_V+wid*1024;
  #define DMA_K(t,slot) glds16(ksrc+(long)(t)*KVBLK*DM,(unsigned)__builtin_amdgcn_readfirstlane(kdst+(slot)))
  #define DMA_V(t,slot) glds16(vsrc+(long)(t)*KVBLK*DM,(unsigned)__builtin_amdgcn_readfirstlane(vdst+(slot)))
  const int vb0=(int)(lds0+LDS_V)+((lane>>4)&1)*32+(lane&3)*8+(4*hi+((lane&15)>>2))*64;
  const char*Kbase=shm+LDS_K; bf16x8 kf[8];
  const lds_cptr shm3=(lds_cptr)shm; const lds_cptr kp0=shm3+LDS_K+hi*1024+r32*16; const lds_cptr vp0=shm3+LDS_V+((lane>>4)&1)*32+(lane&3)*8+(4*hi+((lane&15)>>2))*64;
  const int NT=(q0+QB)/KVBLK;
  { __attribute__((address_space(3))) float* tabw=(__attribute__((address_space(3))) float*)((lds_cptr)shm+LDS_TAB);
    if(tid<128){ const float bv=(rel_bias[(int)::T5B[tid]*8+m]-rel_bias[31*8+m])*1.4426950408889634f; tabw[tid]=bv; }
    asm volatile("s_waitcnt vmcnt(0) lgkmcnt(0)":::"memory"); }
  const lds_cfptr tab=(lds_cfptr)((lds_cptr)shm+LDS_TAB);
  DMA_K(0,0);DMA_V(0,0);DMA_K(1,SLOTB);
  bf16x8 qr[4];
  #pragma unroll
  for(int d0=0;d0<4;++d0)qr[d0]=*reinterpret_cast<const bf16x8*>(&Qw[(long)r32*DM+d0*16+hi*8]);
  float mhat=0.f,l_reg=0.f;f32x16 o[2];o[0]=f32x16{};o[1]=f32x16{};f32x16 negm=f32x16{};asm volatile("":"+v"(negm));
  const int qrel=wid*QBLK+r32;
  #define CMASK(P0,P1,t) do{int jb_=(t)-(NT-4); if(jb_>=-2)addbias(P0,P1,jb_,qrel,hi,tab); if(jb_>=0)cmask(P0,P1,jb_,qrel,hi);}while(0)
  bool resc=false;
  #define START(P0,P1) do{ const float rm=rowmax(P0,P1); resc=false; \
    { const float dl=rm; mhat=fadd_s(mhat,dl); \
      _Pragma("unroll") for(int r=0;r<16;++r){P0[r]=fsub_s(P0[r],dl);P1[r]=fsub_s(P1[r],dl);} \
      _Pragma("unroll") for(int r=0;r<16;++r)negm[r]=-mhat; asm volatile("":"+v"(negm)); } \
    _Pragma("unroll") for(int r=0;r<16;++r)P0[r]=__builtin_amdgcn_exp2f(P0[r]); }while(0)
  #define RESC() do{ if(resc){ asm volatile("s_waitcnt lgkmcnt(0)":::"memory"); \
      _Pragma("unroll") for(int d_=0;d_<2;++d_) _Pragma("unroll") for(int r=0;r<16;++r)o[d_][r]*=wsf[crow(r,hi)]; } }while(0)
  f32x16 pA0,pA1,pB0,pB1;
  int sl_prev=0,sl_cur=0,sl_next=SLOTB;
  #define ROT() do{sl_prev=sl_cur;sl_cur=sl_next;sl_next=(sl_next==(NSLOT-1)*SLOTB)?0:sl_next+SLOTB;}while(0)
  DMA_K(2,2*SLOTB);
  WAIT_BAR(3);
  qkt(pA0,pA1,Kbase,qr,negm,r32,hi);asm volatile("s_nop 15\n\ts_nop 7":"+v"(pA0),"+v"(pA1));CMASK(pA0,pA1,0);
  START(pA0,pA1);
  _Pragma("unroll") for(int r=0;r<16;++r)pA1[r]=__builtin_amdgcn_exp2f(pA1[r]);
  WAIT_BAR(0);
  DMA_K(3,0);DMA_V(1,SLOTB);
  ROT();
  kload8(kf,kp0+sl_cur);
  WAIT_BAR(2);
  s16x4 vlo[8],vhi[8]; u32x4 pw0,pw1,pw2,pw3;
  #define PKW(P,B) cvtpk_s(P[B],P[B+1])
  #define PAF(k) __builtin_bit_cast(bf16x8,pw##k)
  #define VFR(i) (bf16x8){vlo[i][0],vlo[i][1],vlo[i][2],vlo[i][3],vhi[i][0],vhi[i][1],vhi[i][2],vhi[i][3]}
  #define PIN(x) asm volatile("":"+v"(x))
  #define MX3(a,b,c) __builtin_fmaxf(__builtin_fmaxf((a),(b)),(c))
  #define GAPA(MF,A0,A1,A2,A3,W0,W1,PW) do{ MF; sacc+=A0; sacc+=A1; sacc+=A2; sacc+=A3; PIN(sacc); W0; W1; PIN(PW); SBAR(); }while(0)
  #define EX(v) __builtin_amdgcn_exp2f(v)
  #define GAPB(MF,X,B) do{ MF; X[B]=EX(X[B]); X[B+1]=EX(X[B+1]); X[B+2]=EX(X[B+2]); X[B+3]=EX(X[B+3]); PIN(X); SBAR(); }while(0)
  #define VRD(i) do{ vlo[i]=vtr(vp_+(((i)>>2)*4096+((i)&3)*1024)); vhi[i]=vtr(vp_+(((i)>>2)*4096+((i)&3)*1024+512)); }while(0)
  #define KRD(G,j) do{ if(G){ kload2(kf,kp0+sl_next,j); SBAR(); } }while(0)
  #define STEP(C0,C1,P0,P1,t,GK,GV,GL) do{ SBAR(); \
    const lds_cptr vp_=vp0+sl_prev; \
    VRD(0); SBAR(); float sacc=(P0[0]+P0[1]); \
    GAPA(C0=__builtin_amdgcn_mfma_f32_32x32x16_bf16(kf[0],qr[0],negm,0,0,0), P0[2],P0[3],P0[4],P0[5],     pw0[0]=PKW(P0,0), pw0[1]=PKW(P0,2), pw0); \
    VRD(4); SBAR(); GAPA(C1=__builtin_amdgcn_mfma_f32_32x32x16_bf16(kf[1],qr[0],negm,0,0,0), P0[6],P0[7],P0[8],P0[9],     pw0[2]=PKW(P0,4), pw0[3]=PKW(P0,6), pw0); \
    VRD(1); SBAR(); GAPA(C0=__builtin_amdgcn_mfma_f32_32x32x16_bf16(kf[2],qr[1],C0,0,0,0),   P0[10],P0[11],P0[12],P0[13], pw1[0]=PKW(P0,8), pw1[1]=PKW(P0,10), pw1); \
    VRD(5); SBAR(); GAPA(C1=__builtin_amdgcn_mfma_f32_32x32x16_bf16(kf[3],qr[1],C1,0,0,0),   P0[14],P0[15],P1[0],P1[1],   pw1[2]=PKW(P0,12),pw1[3]=PKW(P0,14), pw1); \
    VRD(2); SBAR(); GAPA(C0=__builtin_amdgcn_mfma_f32_32x32x16_bf16(kf[4],qr[2],C0,0,0,0),   P1[2],P1[3],P1[4],P1[5],     pw2[0]=PKW(P1,0), pw2[1]=PKW(P1,2), pw2); \
    VRD(6); SBAR(); GAPA(C1=__builtin_amdgcn_mfma_f32_32x32x16_bf16(kf[5],qr[2],C1,0,0,0),   P1[6],P1[7],P1[8],P1[9],     pw2[2]=PKW(P1,4), pw2[3]=PKW(P1,6), pw2); \
    VRD(3); SBAR(); GAPA(C0=__builtin_amdgcn_mfma_f32_32x32x16_bf16(kf[6],qr[3],C0,0,0,0),   P1[10],P1[11],P1[12],P1[13], pw3[0]=PKW(P1,8), pw3[1]=PKW(P1,10), pw3); \
    VRD(7); SBAR(); GAPA(C1=__builtin_amdgcn_mfma_f32_32x32x16_bf16(kf[7],qr[3],C1,0,0,0),   P1[14],P1[15],0.f,0.f,       pw3[2]=PKW(P1,12),pw3[3]=PKW(P1,14), pw3); \
    l_reg+=sacc; \
    if(GK){DMA_K((t)+3,sl_cur);} if(GV){DMA_V((t)+1,sl_next);} \
    CMASK(C0,C1,t); \
    { float a=MX3(C0[0],C0[1],C1[0]),b=MX3(C0[2],C0[3],C1[1]); a=MX3(a,C1[2],C1[3]); \
      _Pragma("unroll") for(int r=4;r<16;r+=4){a=MX3(a,C0[r],C0[r+1]);b=MX3(b,C0[r+2],C0[r+3]);a=MX3(a,C1[r],C1[r+1]);b=MX3(b,C1[r+2],C1[r+3]);} \
      float rm=__builtin_fmaxf(a,b); { auto rr=__builtin_amdgcn_permlane32_swap(__float_as_uint(rm),__float_as_uint(rm),false,false); rm=__builtin_fmaxf(__uint_as_float(rr[0]),__uint_as_float(rr[1])); } \
      resc=false; \
      if(__builtin_expect(__any(rm>(float)THRL),0)){ const float dl=__builtin_fmaxf(rm,0.f); mhat+=dl; \
        _Pragma("unroll") for(int r=0;r<16;++r){C0[r]-=dl;C1[r]-=dl;} \
        _Pragma("unroll") for(int r=0;r<16;++r)negm[r]=-mhat; asm volatile("":"+v"(negm)); \
        const float f=__builtin_amdgcn_exp2f(-dl); l_reg*=f; if(hi==0)wsf[r32]=f; resc=true; } } \
    SBAR(); \
    GAPB(o[0]=__builtin_amdgcn_mfma_f32_32x32x16_bf16(PAF(0),VFR(0),o[0],0,0,0), C0,0); \
    GAPB(o[1]=__builtin_amdgcn_mfma_f32_32x32x16_bf16(PAF(0),VFR(4),o[1],0,0,0), C0,4); \
    KRD(GL,0); GAPB(o[0]=__builtin_amdgcn_mfma_f32_32x32x16_bf16(PAF(1),VFR(1),o[0],0,0,0), C0,8); \
    KRD(GL,1); GAPB(o[1]=__builtin_amdgcn_mfma_f32_32x32x16_bf16(PAF(1),VFR(5),o[1],0,0,0), C0,12); \
    KRD(GL,2); GAPB(o[0]=__builtin_amdgcn_mfma_f32_32x32x16_bf16(PAF(2),VFR(2),o[0],0,0,0), C1,0); \
    KRD(GL,3); GAPB(o[1]=__builtin_amdgcn_mfma_f32_32x32x16_bf16(PAF(2),VFR(6),o[1],0,0,0), C1,4); \
    GAPB(o[0]=__builtin_amdgcn_mfma_f32_32x32x16_bf16(PAF(3),VFR(3),o[0],0,0,0), C1,8); \
    GAPB(o[1]=__builtin_amdgcn_mfma_f32_32x32x16_bf16(PAF(3),VFR(7),o[1],0,0,0), C1,12); \
    }while(0)
  int t=1;
  #undef CMASK
  #define CMASK(P0,P1,t) do{}while(0)
  for(;t+7<NT;t+=2){
    STEP(pB0,pB1,pA0,pA1,t,true,true,true);     WAIT_BAR(2); RESC(); ROT();
    STEP(pA0,pA1,pB0,pB1,t+1,true,true,true);   WAIT_BAR(2); RESC(); ROT();
  }
  #undef CMASK
  #define CMASK(P0,P1,t) do{int jb_=(t)-(NT-4); if(jb_>=-2)addbias(P0,P1,jb_,qrel,hi,tab); if(jb_>=0)cmask(P0,P1,jb_,qrel,hi);}while(0)
  #define ENDW(tt) do{ if((tt)+3<NT){WAIT_BAR(2);} else if((tt)+2<NT){WAIT_BAR(1);} else {WAIT_BAR(0);} }while(0)
  for(;t+1<NT;t+=2){
    STEP(pB0,pB1,pA0,pA1,t,(t+3<NT),(t+1<NT),(t+1<NT));       ENDW(t);   RESC(); ROT();
    STEP(pA0,pA1,pB0,pB1,t+1,(t+4<NT),(t+2<NT),(t+2<NT));     ENDW(t+1); RESC(); ROT();
  }
  STEP(pB0,pB1,pA0,pA1,NT-1,false,false,false); RESC();
  { float sacc=pB0[0]+pB0[1]; _Pragma("unroll") for(int r=2;r<16;++r)sacc+=pB0[r]; _Pragma("unroll") for(int r=0;r<16;++r)sacc+=pB1[r]; l_reg+=sacc;
    pw0=(u32x4){PKW(pB0,0),PKW(pB0,2),PKW(pB0,4),PKW(pB0,6)};pw1=(u32x4){PKW(pB0,8),PKW(pB0,10),PKW(pB0,12),PKW(pB0,14)};pw2=(u32x4){PKW(pB1,0),PKW(pB1,2),PKW(pB1,4),PKW(pB1,6)};pw3=(u32x4){PKW(pB1,8),PKW(pB1,10),PKW(pB1,12),PKW(pB1,14)};
    SBAR(); pv(o,vb0+sl_cur,PAF(0),PAF(1),PAF(2),PAF(3)); }
  #undef PKW
  #undef PAF
  #undef VFR
  #undef PIN
  #undef MX3
  #undef GAPA
  #undef GAPB
  #undef EX
  #undef VRD
  #undef KRD
  #undef STEP
  #undef ENDW
  {auto rr=__builtin_amdgcn_permlane32_swap(__float_as_uint(l_reg),__float_as_uint(l_reg),false,false);l_reg=__uint_as_float(rr[0])+__uint_as_float(rr[1]);}
  if(hi==0)wsf[32+r32]=l_reg;asm volatile("s_waitcnt lgkmcnt(0)":::"memory");
  float rli[16];
  #pragma unroll
  for(int r=0;r<16;++r)rli[r]=__builtin_amdgcn_rcpf(wsf[32+crow(r,hi)]);
  bf16*Ow=O+(rowbase+q0+wid*QBLK)*DM;
  { bf16*stg=(bf16*)(shm+LDS_OST)+wid*2048;
    #pragma unroll
    for(int r=0;r<16;++r){const int orow=crow(r,hi);
      #pragma unroll
      for(int d0=0;d0<2;++d0)stg[orow*64+d0*32+r32]=::f2bf(o[d0][r]*rli[r]);}
    asm volatile("s_waitcnt lgkmcnt(0)":::"memory");
    #pragma unroll
    for(int i=0;i<4;++i){const int row=i*8+(lane>>3),ch=lane&7; const u32x4 v=*(const u32x4*)(stg+row*64+ch*8); ATTN_STORE16(Ow+(long)row*DM+ch*8,v);} }
  asm volatile("s_waitcnt lgkmcnt(0)\n\ts_barrier":::"memory");
  #undef DMA_K
  #undef DMA_V
  #undef CMASK
  #undef START
  #undef RESC
  #undef ROT
}
constexpr int ATTN_LDS_BYTES=LDS_BYTES;
struct AttnUnit { int b, m, vh, qb; };
struct StaticOrder {
  int vcu, G;
  __device__ __forceinline__ StaticOrder(int grid,int v):vcu(v),G(grid){}
  __device__ __forceinline__ bool next(int i,AttnUnit&u)const{
    int combo,qb;
    if(G==256){ if(i>=4)return false; const int s=vcu&1; combo=vcu>>1; qb=(i==0)?7-s:(i==1)?4+s:(i==2)?3-s:s; }
    else { const int idx=i*G+vcu; if(idx>=1024)return false; combo=idx>>3; qb=idx&7; }
    u.vh=combo&1; u.m=(combo>>1)&7; u.b=combo>>4; u.qb=qb; return true; }
};
template<class Sched,int THRL=8> __device__ __forceinline__ void attn_phase(char*lds,const bf16*P,const float*rel_bias,const Sched&S){
  AttnUnit u;
  for(int i=0;S.next(i,u);++i){ attn_unit<THRL>(u.b,u.m,u.vh,u.qb,P,rel_bias,lds); }
}
#undef SBAR
#undef WAIT_BAR
}

#define GAS __attribute__((address_space(1)))
#define LAS __attribute__((address_space(3)))
typedef unsigned v4u __attribute__((ext_vector_type(4)));
typedef GAS unsigned gu32;
typedef GAS unsigned long long gu64;
#define RLX_AGENT __ATOMIC_RELAXED, __HIP_MEMORY_SCOPE_AGENT
#define LDS_WAIT() asm volatile("s_waitcnt lgkmcnt(0)" ::: "memory")
#define VM_WAIT() asm volatile("s_waitcnt vmcnt(0)" ::: "memory")

#define XB_TMO      128
#define XB_XCNT(j)  (256  + 64 * (j))
#define XB_XSUB(j)  (1280 + 64 * (j))
#define XB_XGEN(j)  (2304 + 64 * (j))
#define XB_TOP      3328
#define XB_TOPGEN   3392
#define XCD_BAR_WORDS 3456
#define XB_SPIN_CAP (1u << 18)

__device__ __forceinline__ unsigned xb_ld(unsigned* p)              { return __hip_atomic_load(p, __ATOMIC_RELAXED, __HIP_MEMORY_SCOPE_AGENT); }
__device__ __forceinline__ unsigned xb_add(unsigned* p, unsigned v) { return __hip_atomic_fetch_add(p, v, __ATOMIC_RELAXED, __HIP_MEMORY_SCOPE_AGENT); }
__device__ __forceinline__ unsigned xb_xcc_id() { return (unsigned)__builtin_amdgcn_s_getreg((3 << 11) | 20) & 0xFu; }
#define XB_SPIN(cond, bar) do { unsigned _sp = 0; while (cond) { __builtin_amdgcn_s_sleep(1); \
    if ((++_sp & 255u) == 0u) { if (xb_ld(&(bar)[XB_TMO])) break; if (_sp > XB_SPIN_CAP) { atomicAdd(&(bar)[XB_TMO], 1u); break; } } } } while (0)

struct XcdBarrier {
    unsigned* bar; unsigned x;
    volatile LAS unsigned* st;
};

__device__ __forceinline__ XcdBarrier xcd_barrier_post(unsigned* bar, volatile LAS unsigned* st) {
    XcdBarrier b; b.bar = bar; b.x = xb_xcc_id(); b.st = st;
    if (threadIdx.x == 0) (void)xb_add(&bar[XB_XCNT(b.x)], 1u);
    return b;
}
__device__ __forceinline__ void xcd_barrier_complete(unsigned* bar, unsigned x, unsigned& nloc, unsigned& nx) {
    const unsigned G = gridDim.x * gridDim.y * gridDim.z;
    unsigned sum, cnt, mine, sp = 0u;
    for (;;) {
        sum = 0u; cnt = 0u; mine = 0u;
#pragma unroll
        for (unsigned j = 0; j < 16; ++j) { const unsigned c = xb_ld(&bar[XB_XCNT(j)]); sum += c; cnt += (c > 0u) ? 1u : 0u; mine = (j == x) ? c : mine; }
        if (sum == G) break;
        __builtin_amdgcn_s_sleep(1);
        if ((++sp & 255u) == 0u) { if (xb_ld(&bar[XB_TMO])) break; if (sp > XB_SPIN_CAP) { atomicAdd(&bar[XB_TMO], 1u); break; } }
    }
    nloc = mine > 0u ? mine : 1u; nx = cnt > 0u ? cnt : 1u;
}

__device__ __forceinline__ void xcd_barrier(const XcdBarrier& b) {
    asm volatile("s_waitcnt vmcnt(0)" ::: "memory");
    __syncthreads();
    if (threadIdx.x == 0) {
        unsigned* bar = b.bar;
        __builtin_amdgcn_s_waitcnt(0);
        unsigned nloc = b.st[0], nx = b.st[1];
        if (nloc == 0u) { xcd_barrier_complete(bar, b.x, nloc, nx); b.st[0] = nloc; b.st[1] = nx; }
        const unsigned old = xb_add(&bar[XB_XSUB(b.x)], 1u);
        const unsigned gen = old / nloc;
        if (old + 1u == (gen + 1u) * nloc) {
            __builtin_amdgcn_fence(__ATOMIC_RELEASE, "agent");
            asm volatile("s_waitcnt vmcnt(0)" ::: "memory");
            const unsigned og = xb_add(&bar[XB_TOP], 1u);
            const unsigned tg = og / nx;
            if (og + 1u == (tg + 1u) * nx) xb_add(&bar[XB_TOPGEN], 1u);
            else XB_SPIN(xb_ld(&bar[XB_TOPGEN]) == tg, bar);
            __builtin_amdgcn_fence(__ATOMIC_ACQUIRE, "agent");
            xb_add(&bar[XB_XGEN(b.x)], 1u);
            asm volatile("s_waitcnt vmcnt(0)" ::: "memory");
        } else {
            XB_SPIN(xb_ld(&bar[XB_XGEN(b.x)]) == gen, bar);
            __builtin_amdgcn_fence(__ATOMIC_ACQUIRE, "agent");
            asm volatile("s_waitcnt vmcnt(0)" ::: "memory");
        }
    }
    __syncthreads();
}

constexpr int NWAVES = 8;
constexpr int RING_OFF = 0, RING_BYTES = 131072;
constexpr int LDSCTL_OFF = RING_BYTES, MISC_OFF = LDSCTL_OFF + 320;
constexpr int LDS_BYTES = 147456;
constexpr int CW_BAR = 4096;
constexpr int PH_PROLOGUE = 0, PH_ROW0 = 1, PH_LAYER0 = 2, NPL = 16;
enum { S_UP1 = 0, S_DN1, S_ROWA, S_WIN, S_MIX1, S_MIX2, S_MIX3, S_ATTN, S_DFIN, S_GLU, S_BRANCH, S_WOUT, S_ROWB, S_UP2, S_DN2, S_ROWC };
constexpr int N_PHASES = PH_LAYER0 + DEPTH * NPL;

struct Args { const float* in[29]; float* out; unsigned char* ws; int ph_lo, ph_hi; };
struct Frame {
    LAS unsigned char* lds; char* ldsg;
    int tid, lane, wave, vcu, G, z, cid, rep;
    const float* const* in; float* out; unsigned char* ws;
};

template <int MAP> __device__ __forceinline__ int conv_src(int n) {
    if (MAP == 0) return n;
    if (MAP == 1) { const int t = n >> 8, r = n & 255; return r < 128 ? 128 * t + r : DFF + 128 * t + (r - 128); }
    if (MAP == 2) return my2ref(n);
    { const int t = n >> 8, r = n & 255; return r < 128 ? 128 * t + r : 512 + 128 * t + (r - 128); }
}
template <int MAP> __device__ __forceinline__ void conv_item(const float* W, int K, int N, int Np, bf16_t* WT, LAS float* scr, int item, int lane) {
    const int nblk = Np / 32, kb = item / nblk, nb = item % nblk, k0 = 64 * kb, n0 = 32 * nb;
    const int src = conv_src<MAP>(n0 + (lane & 31));
#pragma unroll 8
    for (int i = 0; i < 32; ++i) { const int kk = 2 * i + (lane >> 5); scr[kk * 33 + (lane & 31)] = (src >= 0) ? W[(size_t)(k0 + kk) * N + src] : 0.f; }
    LDS_WAIT(); asm volatile("" ::: "memory");
    const int c = lane & 7;
#pragma unroll
    for (int j = 0; j < 4; ++j) { const int n = (lane >> 3) + 8 * j; const LAS float* s = scr + (8 * c) * 33 + n;
        v4u o; o.x = pk2(s[0 * 33], s[1 * 33]); o.y = pk2(s[2 * 33], s[3 * 33]); o.z = pk2(s[4 * 33], s[5 * 33]); o.w = pk2(s[6 * 33], s[7 * 33]);
        *(GAS v4u*)(WT + (size_t)(n0 + n) * K + k0 + 8 * c) = o; }
    LDS_WAIT(); asm volatile("" ::: "memory");
}
__device__ __forceinline__ void convert_layer(Frame& F, int l) {
    LAS float* scr = (LAS float*)(F.lds + RING_OFF + F.wave * 16384);
    const int gw = F.vcu * NWAVES + F.wave, NGW = F.G * NWAVES;
    bf16_t* wb = (bf16_t*)(F.ws + WS_W);
    constexpr int I_UP = (D / 64) * (2 * DFF / 32), I_DN = (DFF / 64) * (D / 32), I_IN = (D / 64) * (PW / 32), I_GLU = (512 / 64) * (1024 / 32), I_BR = I_GLU, I_OUT = (D / 64) * (D / 32);
    constexpr int NITEMS = 2 * I_UP + 2 * I_DN + I_IN + I_GLU + 3 * I_BR + I_OUT;
    const float* f1u = F.in[F.z + 7] + (size_t)l * D * 2 * DFF; const float* f1d = F.in[F.z + 8] + (size_t)l * DFF * D;
    const float* f2u = F.in[F.z + 9] + (size_t)l * D * 2 * DFF; const float* f2d = F.in[F.z + 10] + (size_t)l * DFF * D;
    const float* win = F.in[F.z + 11] + (size_t)l * D * INW; const float* wglu = F.in[F.z + 25] + (size_t)l * 512 * 1024;
    const float* wbr = F.in[F.z + 27] + (size_t)l * 3 * 512 * D; const float* wout = F.in[F.z + 28] + (size_t)l * D * D;
    for (int it = gw; it < NITEMS; it += NGW) {
        int r = it;
        if (r < I_UP) { conv_item<1>(f1u, D, 2 * DFF, 2 * DFF, wb + W_UP1, scr, r, F.lane); continue; } r -= I_UP;
        if (r < I_DN) { conv_item<0>(f1d, DFF, D, D, wb + W_DN1, scr, r, F.lane); continue; } r -= I_DN;
        if (r < I_UP) { conv_item<1>(f2u, D, 2 * DFF, 2 * DFF, wb + W_UP2, scr, r, F.lane); continue; } r -= I_UP;
        if (r < I_DN) { conv_item<0>(f2d, DFF, D, D, wb + W_DN2, scr, r, F.lane); continue; } r -= I_DN;
        if (r < I_IN) { conv_item<2>(win, D, INW, PW, wb + W_IN, scr, r, F.lane); continue; } r -= I_IN;
        if (r < I_GLU) { conv_item<3>(wglu, 512, 1024, 1024, wb + W_GLU, scr, r, F.lane); continue; } r -= I_GLU;
        if (r < 3 * I_BR) { const int i = r / I_BR; conv_item<0>(wbr + (size_t)i * 512 * D, 512, D, D, wb + W_BR + (size_t)i * 1024 * 512, scr, r % I_BR, F.lane); continue; } r -= 3 * I_BR;
        conv_item<0>(wout, D, D, D, wb + W_OUT, scr, r, F.lane);
    }
}
__device__ __forceinline__ void ada_phase(Frame& F) {
    if (F.vcu < 2 * 72) {
        const int l = F.vcu / 72, cb = F.vcu % 72;
        LAS float* cond = (LAS float*)(F.lds + RING_OFF);
        LAS float* red = (LAS float*)(F.lds + RING_OFF + 32768);
        const float* c = F.in[F.z + 1];
        for (int i = F.tid; i < BATCH * D; i += NWAVES * 64) cond[i] = siluf_(c[i]);
        __syncthreads();
        float acc[BATCH][2];
#pragma unroll
        for (int b = 0; b < BATCH; ++b) { acc[b][0] = 0.f; acc[b][1] = 0.f; }
        const float* w = F.in[F.z + 3] + ((size_t)l * D + F.wave * 128) * ADA + cb * 128 + 2 * F.lane;
#pragma unroll 4
        for (int k = 0; k < 128; ++k) { const float2 wv = *(const float2*)(w + (size_t)k * ADA);
#pragma unroll
            for (int b = 0; b < BATCH; ++b) { const float cv = cond[b * D + F.wave * 128 + k]; acc[b][0] += cv * wv.x; acc[b][1] += cv * wv.y; } }
#pragma unroll
        for (int b = 0; b < BATCH; ++b) { red[(F.wave * 8 + b) * 128 + 2 * F.lane] = acc[b][0]; red[(F.wave * 8 + b) * 128 + 2 * F.lane + 1] = acc[b][1]; }
        __syncthreads();
        float* ada = (float*)(F.ws + WS_ADA);
        for (int o = F.tid; o < BATCH * 128; o += NWAVES * 64) { const int b = o >> 7, cc = o & 127; float s = F.in[F.z + 4][l * ADA + cb * 128 + cc];
#pragma unroll
            for (int w8 = 0; w8 < 8; ++w8) s += red[(w8 * 8 + b) * 128 + cc];
            ada[((size_t)l * BATCH + b) * ADA + cb * 128 + cc] = s; }
        __syncthreads();
    }
}
__device__ __forceinline__ void rowpass_phase(Frame& F, int l, int sub) {
    const int gw = F.vcu * NWAVES + F.wave, NGW = F.G * NWAVES;
    const float* ada = (const float*)(F.ws + WS_ADA); const float* adal = ada + (size_t)l * BATCH * ADA;
    const float* npre = F.in[F.z + 5] + l * 3 * D; const float* npost = F.in[F.z + 6] + l * 3 * D;
    bf16_t* u = (bf16_t*)(F.ws + WS_U); const bf16_t* y = (const bf16_t*)(F.ws + WS_Y);
    const float* h_in = F.out; const bf16_t* yy = y; const float* gpost = nullptr; const float* gate = nullptr; float coef = 0.f;
    const float* gpre = nullptr; const float* shift = nullptr; const float* scale = nullptr; bf16_t* uu = u;
    if (sub == 0) { h_in = F.in[F.z + 0]; yy = nullptr; gpre = npre; shift = adal; scale = adal + D; }
    else if (sub == 1) { gpost = npost; gate = adal + 2 * D; coef = 0.5f; gpre = npre + D; shift = adal + 3 * D; scale = adal + 4 * D; }
    else if (sub == 2) { gpost = npost + D; gate = adal + 5 * D; coef = 1.0f; gpre = npre + 2 * D; shift = adal + 6 * D; scale = adal + 7 * D; }
    else { gpost = npost + 2 * D; gate = adal + 8 * D; coef = 0.5f;
        if (l + 1 < DEPTH) { gpre = F.in[F.z + 5] + (l + 1) * 3 * D; shift = adal + (size_t)BATCH * ADA; scale = shift + D; } else uu = nullptr; }
    for (int row = gw; row < M; row += NGW) rowpass_row(row, F.lane, h_in, F.out, yy, gpost, gate, coef, gpre, shift, scale, uu);
}
__device__ __forceinline__ void dfin_phase(Frame& F, int l) {
    const int gw = F.vcu * NWAVES + F.wave, NGW = F.G * NWAVES;
    const float* lamv = F.in[F.z + 15] + l * 256; const float lam_init = 0.8f - 0.6f * __expf(-0.3f * (float)l);
    const float lam = __expf(wave_sum(lamv[F.lane] * lamv[64 + F.lane])) - __expf(wave_sum(lamv[128 + F.lane] * lamv[192 + F.lane])) + lam_init;
    bf16_t* proj = (bf16_t*)(F.ws + WS_R0);
    for (int row = gw; row < M; row += NGW) diff_fin_row(proj + (size_t)row * PW, F.lane, lam, F.in[F.z + 16] + l * 512, lam_init);
}


constexpr size_t WS_S5TAB0 = WS_ADA + 640 * 1024, WS_S5TAB1 = WS_W + W_END * 2;
#define WS_S5TAB (l == 0 ? WS_S5TAB0 : WS_S5TAB1)
constexpr size_t S5T_AB = 0, S5T_A64 = 16384, S5T_BB = 32768, S5T_CC = S5T_BB + 131072, S5T_END = S5T_CC + 131072;
static_assert(WS_S5TAB0 + S5T_END <= WS_S5ST && WS_S5TAB1 + S5T_END <= WS_U, "S5 tables fit");
constexpr size_t WS_DECAY = WS_CTL + 512 * 1024;
constexpr size_t WS_SPT = WS_U, WS_OI = WS_U + 16 * MiB;
typedef float f32x2v __attribute__((ext_vector_type(2)));
__device__ __forceinline__ f32x4 mfma16_nooverlap(bf16x8 a, bf16x8 b, f32x4 c) { f32x4 d = __builtin_amdgcn_mfma_f32_16x16x32_bf16(a, b, c, 0, 0, 0); asm volatile("" : "+v"(d) : "v"(a), "v"(b)); return d; }
#define MFMA16(a, b, c) mfma16_nooverlap((a), (b), (c))

__device__ __forceinline__ void s5_tables(Frame& F, int l) {
    const int gw = F.vcu * NWAVES + F.wave;
    if (gw >= 32) return;
    const int g = gw, p = F.lane;
    const float* lam_re = F.in[F.z + 17] + l * 2048; const float* lam_im = F.in[F.z + 18] + l * 2048; const float* log_step = F.in[F.z + 19] + l * 32;
    const float* b_re = F.in[F.z + 20] + l * 32768; const float* b_im = F.in[F.z + 21] + l * 32768; const float* c_re = F.in[F.z + 22] + l * 32768; const float* c_im = F.in[F.z + 23] + l * 32768;
    unsigned char* tb = F.ws + WS_S5TAB;
    const float lr = lam_re[g * 64 + p], li = lam_im[g * 64 + p], dt = expf(log_step[g]);
    const float mag = expf(lr * dt), ar = mag * cosf(li * dt), ai = mag * sinf(li * dt);
    const float nr = ar - 1.f, ni = ai, den = lr * lr + li * li, fre = (nr * lr + ni * li) / den, fim = (ni * lr - nr * li) / den;
    ((f32x2v*)(tb + S5T_AB))[g * 64 + p] = (f32x2v){ar, ai};
    float pr = ar, pi = ai;
#pragma unroll
    for (int i = 0; i < 6; ++i) { const float nr2 = pr * pr - pi * pi, ni2 = 2.f * pr * pi; pr = nr2; pi = ni2; }
    ((f32x2v*)(tb + S5T_A64))[g * 64 + p] = (f32x2v){pr, pi};
    bf16_t* BB = (bf16_t*)(tb + S5T_BB) + (size_t)g * 128 * 16; bf16_t* CC = (bf16_t*)(tb + S5T_CC) + (size_t)g * 16 * 128;
#pragma unroll
    for (int h = 0; h < 16; ++h) { const float br = b_re[(g * 64 + p) * 16 + h], bi = b_im[(g * 64 + p) * 16 + h];
        BB[(2 * p) * 16 + h] = f2bf(fre * br - fim * bi); BB[(2 * p + 1) * 16 + h] = f2bf(fre * bi + fim * br);
        CC[h * 128 + 2 * p] = f2bf(c_re[(g * 16 + h) * 64 + p]); CC[h * 128 + 2 * p + 1] = f2bf(-c_im[(g * 16 + h) * 64 + p]); }
}
template <bool OUT> __device__ __forceinline__ void s5_item(Frame& F, int l, int item, LAS unsigned char* wl) {
    int lane_ = F.lane; asm volatile("" : "+v"(lane_));
    const int lane = lane_, fr = lane & 15, fq = lane >> 4;
    const int b = item >> 10, g = (item >> 5) & 31, c = item & 31;
    const unsigned char* tb = F.ws + WS_S5TAB;
    bf16_t* proj = (bf16_t*)(F.ws + WS_R0);
    const f32x2v ab = ((const f32x2v*)(tb + S5T_AB))[g * 64 + lane];
    const float ar = ab.x, ai = ab.y;
    f32x2v bb[16];
    { const u32x4* BBt = (const u32x4*)((const bf16_t*)(tb + S5T_BB) + (size_t)(g * 128 + 2 * lane) * 16);
      const u32x4 r0 = BBt[0], r1 = BBt[1], i0 = BBt[2], i1 = BBt[3];
#pragma unroll
      for (int k = 0; k < 4; ++k) { bb[2 * k] = (f32x2v){blo(r0[k]), blo(i0[k])}; bb[2 * k + 1] = (f32x2v){bhi(r0[k]), bhi(i0[k])};
                                    bb[8 + 2 * k] = (f32x2v){blo(r1[k]), blo(i1[k])}; bb[8 + 2 * k + 1] = (f32x2v){bhi(r1[k]), bhi(i1[k])}; } }
    bf16x8 cfrag[4]; float dsk = 0.f;
    if (OUT) {
#pragma unroll
        for (int s = 0; s < 4; ++s) cfrag[s] = *(const bf16x8*)((const bf16_t*)(tb + S5T_CC) + ((size_t)(g * 16 + fr) * 128 + 32 * s + 8 * fq));
        dsk = (F.in[F.z + 24] + l * 512)[g * 16 + fr];
    }
    float xr = 0.f, xi = 0.f; asm volatile("" : "+v"(xr), "+v"(xi));
    if (OUT) { const f32x2v x0 = ((const f32x2v*)(F.ws + WS_S5ST2))[(size_t)item * 64 + lane]; xr = x0.x; xi = x0.y; }
    LAS float* uL = (LAS float*)wl;
    LAS unsigned char* XL = wl + 1024;
    const size_t row0 = (size_t)b * SEQ + 64 * c;
#pragma unroll 1
    for (int w = 0; w < 4; ++w) {
        bf16_t* urow = proj + (row0 + 16 * w) * PW + C_SU + 16 * g;
        { const int tt = lane >> 2, hh = (lane & 3) * 4; const uint2 v = *(const uint2*)(urow + (size_t)tt * PW + hh);
          *(LAS f32x4*)(uL + tt * 16 + hh) = (f32x4){blo(v.x), bhi(v.x), blo(v.y), bhi(v.y)}; }
        LDS_WAIT(); asm volatile("" ::: "memory");
#pragma unroll 4
        for (int t = 0; t < 16; ++t) {
            f32x2v bu = (f32x2v){0.f, 0.f};
#pragma unroll
            for (int k = 0; k < 4; ++k) { const f32x4 q = *(const LAS f32x4*)(uL + t * 16 + 4 * k);
                bu += bb[4 * k] * q[0]; bu += bb[4 * k + 1] * q[1]; bu += bb[4 * k + 2] * q[2]; bu += bb[4 * k + 3] * q[3]; }
            const float nxr = ar * xr - ai * xi + bu.x, nxi = ar * xi + ai * xr + bu.y; xr = nxr; xi = nxi;
            if (OUT) *(LAS unsigned*)(XL + (t * 136 + 2 * lane) * 2) = pk2(xr, xi);
        }
        if (OUT) {
            LDS_WAIT(); asm volatile("" ::: "memory");
            f32x4 y = (f32x4){0.f, 0.f, 0.f, 0.f};
#pragma unroll
            for (int s = 0; s < 4; ++s) { const bf16x8 xa = *(const LAS bf16x8*)(XL + (fr * 136 + 32 * s + 8 * fq) * 2); y = MFMA16(xa, cfrag[s], y); }
#pragma unroll
            for (int j = 0; j < 4; ++j) { bf16_t* up = urow + (size_t)(4 * fq + j) * PW + fr; const float yn = y[j] + dsk * bf2f(*up);
                const float x3 = yn * yn * yn; *up = f2bf(0.5f * yn * (1.f + tanhf(0.7978845608028654f * (yn + 0.044715f * x3)))); }
        }
        LDS_WAIT(); asm volatile("" ::: "memory");
    }
    if (!OUT) ((f32x2v*)(F.ws + WS_S5ST))[(size_t)item * 64 + lane] = (f32x2v){xr, xi};
}
template <bool OUT> __device__ __forceinline__ void s5_pass(Frame& F, int l) {
    LAS unsigned char* wl = F.lds + RING_OFF + F.wave * 6144;
    const int gw = F.vcu * NWAVES + F.wave, NGW = F.G * NWAVES;
    for (int it = gw; it < BATCH * 8 * 32; it += NGW) { const int b = it >> 8, gq = (it >> 5) & 7, c = it & 31;
#pragma unroll 1
        for (int gi = 0; gi < 4; ++gi) s5_item<OUT>(F, l, ((b * 32 + 4 * gq + gi) << 5) + c, wl); }
}
__device__ __forceinline__ void s5_carry(Frame& F, int l) {
    const f32x2v* ST = (const f32x2v*)(F.ws + WS_S5ST); f32x2v* ST2 = (f32x2v*)(F.ws + WS_S5ST2);
    int b = -1, g = 0;
    if (F.G == 256) { if ((F.vcu & 31) < 4) { b = F.vcu >> 5; g = (F.vcu & 3) * 8 + F.wave; } }
    else { const int gw = F.vcu * NWAVES + F.wave; if (gw < BATCH * 32) { b = gw >> 5; g = gw & 31; } }
    if (b < 0) return;
    const int bg = b * 32 + g;
    const f32x2v a64 = ((const f32x2v*)(F.ws + WS_S5TAB + S5T_A64))[g * 64 + F.lane];
    const f32x2v* st = ST + (size_t)bg * 32 * 64 + F.lane; f32x2v* st2 = ST2 + (size_t)bg * 32 * 64 + F.lane; f32x2v e[32];
#pragma unroll
    for (int c = 0; c < 32; ++c) e[c] = st[c * 64];
    float xr = 0.f, xi = 0.f; asm volatile("" : "+v"(xr), "+v"(xi));
#pragma unroll
    for (int c = 0; c < 32; ++c) { st2[c * 64] = (f32x2v){xr, xi}; const float nxr = a64.x * xr - a64.y * xi + e[c].x, nxi = a64.x * xi + a64.y * xr + e[c].y; xr = nxr; xi = nxi; }
}

constexpr int GL_QD = 0, GL_KD = 9216, GL_KRT = 18432, GL_VT = 27648, GL_ATT = 46080, GL_WAL = 55296, GL_END = GL_WAL + 17 * 64 * 4;
__device__ __forceinline__ void gla_pass1(Frame& F, int l) {
    bf16_t* proj = (bf16_t*)(F.ws + WS_R0);
    const float* w_alpha = F.in[F.z + 12] + l * 16 * 256; const float* b_alpha = F.in[F.z + 13] + l * 256;
    float* dST = (float*)(F.ws + WS_GLA); float* decay = (float*)(F.ws + WS_DECAY); unsigned* OI = (unsigned*)(F.ws + WS_OI);
    LAS unsigned char* L = F.lds + RING_OFF;
    LAS float* wal = (LAS float*)(L + GL_WAL);
    const int w = F.wave;
    for (int item = F.vcu; item < BATCH * 4 * 32; item += F.G) {
        int lane_ = F.lane; asm volatile("" : "+v"(lane_));
        const int lane = lane_, t = w * 64 + lane, fr = lane & 15, fq = lane >> 4;
        const int b = item >> 7, h = (item >> 5) & 3, n = item & 31;
        const size_t row0 = (size_t)b * SEQ + 64 * n;
        for (int i = t; i < 17 * 64; i += NWAVES * 64) wal[i] = (i < 1024) ? w_alpha[(i >> 6) * 256 + h * 64 + (i & 63)] : b_alpha[h * 64 + (i & 63)];
#pragma unroll
        for (int i = 0; i < 2; ++i) { const int id = t + 512 * i, s = id & 63, e0 = (id >> 6) * 8;
            const u32x4 vv = *(const u32x4*)(proj + (row0 + s) * PW + C_GV + h * 128 + e0);
#pragma unroll
            for (int k = 0; k < 4; ++k) { *(LAS bf16_t*)(L + GL_VT + ((e0 + 2 * k) * 72 + s) * 2) = (bf16_t)(vv[k] & 0xffffu); *(LAS bf16_t*)(L + GL_VT + ((e0 + 2 * k + 1) * 72 + s) * 2) = (bf16_t)(vv[k] >> 16); } }
        __syncthreads();
        {
            const int c = lane, d0 = 8 * w;
            const bf16_t* rowp = proj + (row0 + c) * PW;
            const u32x4 a0 = *(const u32x4*)(rowp + C_GA), a1 = *(const u32x4*)(rowp + C_GA + 8);
            float al[16];
#pragma unroll
            for (int k = 0; k < 4; ++k) { al[2 * k] = blo(a0[k]); al[2 * k + 1] = bhi(a0[k]); al[8 + 2 * k] = blo(a1[k]); al[8 + 2 * k + 1] = bhi(a1[k]); }
            float bb[8];
#pragma unroll
            for (int i = 0; i < 8; ++i) { float z = wal[1024 + d0 + i];
#pragma unroll
                for (int j = 0; j < 16; ++j) z += al[j] * wal[j * 64 + d0 + i];
                bb[i] = (fminf(z, 0.f) - log1pf(__expf(-fabsf(z)))) * (1.f / 16.f); }
#pragma unroll
            for (int i = 0; i < 8; ++i) {
#pragma unroll
                for (int o = 1; o < 64; o <<= 1) { const float up = __int_as_float(__builtin_amdgcn_ds_bpermute((lane - o) << 2, __float_as_int(bb[i]))); if (lane >= o) bb[i] += up; } }
            const u32x4 qv = *(const u32x4*)(rowp + C_GQ + h * 64 + d0), kv = *(const u32x4*)(rowp + C_GK + h * 64 + d0);
            float qd[8], kd[8], kr[8];
#pragma unroll
            for (int i = 0; i < 8; ++i) { const float bl = __int_as_float(__builtin_amdgcn_readlane(__float_as_int(bb[i]), 63)); const float q = (i & 1) ? bhi(qv[i >> 1]) : blo(qv[i >> 1]), k = (i & 1) ? bhi(kv[i >> 1]) : blo(kv[i >> 1]);
                qd[i] = q * __expf(bb[i]); kd[i] = k * __expf(-bb[i]); kr[i] = k * __expf(bl - bb[i]);
                if (lane == 63) decay[(size_t)item * 64 + d0 + i] = __expf(bl); }
            u32x4 qw, kw;
#pragma unroll
            for (int k = 0; k < 4; ++k) { qw[k] = pk2(qd[2 * k], qd[2 * k + 1]); kw[k] = pk2(kd[2 * k], kd[2 * k + 1]); }
            *(LAS u32x4*)(L + GL_QD + (c * 72 + d0) * 2) = qw; *(LAS u32x4*)(L + GL_KD + (c * 72 + d0) * 2) = kw;
            *(u32x4*)(proj + (row0 + c) * PW + C_GQ + h * 64 + d0) = qw;
#pragma unroll
            for (int i = 0; i < 8; ++i) *(LAS bf16_t*)(L + GL_KRT + ((d0 + i) * 72 + c) * 2) = f2bf(kr[i]);
        }
        __syncthreads();
        {
            const int ct = w >> 1;
#pragma unroll
            for (int si = 0; si < 2; ++si) { const int st = 2 * (w & 1) + si;
                f32x4 acc = (f32x4){0.f, 0.f, 0.f, 0.f};
                if (st <= ct) {
#pragma unroll
                    for (int ks = 0; ks < 2; ++ks) { const bf16x8 a = *(const LAS bf16x8*)(L + GL_QD + ((16 * ct + fr) * 72 + 32 * ks + 8 * fq) * 2), bq = *(const LAS bf16x8*)(L + GL_KD + ((16 * st + fr) * 72 + 32 * ks + 8 * fq) * 2);
                        acc = MFMA16(a, bq, acc); } }
#pragma unroll
                for (int j = 0; j < 4; ++j) { const int cc = 16 * ct + 4 * fq + j, ss = 16 * st + fr; *(LAS bf16_t*)(L + GL_ATT + (cc * 72 + ss) * 2) = f2bf(ss <= cc ? acc[j] : 0.f); } }
        }
        __syncthreads();
        {
            bf16x8 vf[2];
#pragma unroll
            for (int ks = 0; ks < 2; ++ks) vf[ks] = *(const LAS bf16x8*)(L + GL_VT + ((16 * w + fr) * 72 + 32 * ks + 8 * fq) * 2);
#pragma unroll
            for (int ct = 0; ct < 4; ++ct) { f32x4 acc = (f32x4){0.f, 0.f, 0.f, 0.f};
#pragma unroll
                for (int ks = 0; ks < 2; ++ks) { const bf16x8 a = *(const LAS bf16x8*)(L + GL_ATT + ((16 * ct + fr) * 72 + 32 * ks + 8 * fq) * 2); acc = MFMA16(a, vf[ks], acc); }
                uint2 o; o.x = pk2(acc[0], acc[1]); o.y = pk2(acc[2], acc[3]);
                *(uint2*)(OI + ((((size_t)item * 4 + ct) * 8 + w) * 64 + lane) * 2) = o; }
#pragma unroll
            for (int dt = 0; dt < 4; ++dt) { f32x4 acc = (f32x4){0.f, 0.f, 0.f, 0.f};
#pragma unroll
                for (int ks = 0; ks < 2; ++ks) { const bf16x8 bk = *(const LAS bf16x8*)(L + GL_KRT + ((16 * dt + fr) * 72 + 32 * ks + 8 * fq) * 2); acc = MFMA16(vf[ks], bk, acc); }
#pragma unroll
                for (int j = 0; j < 4; ++j) dST[((size_t)item * 128 + 16 * w + 4 * fq + j) * 64 + 16 * dt + fr] = acc[j]; }
        }
        __syncthreads();
    }
}
__device__ __forceinline__ void gla_pass2(Frame& F) {
    const float* dST = (const float*)(F.ws + WS_GLA); const float* decay = (const float*)(F.ws + WS_DECAY); unsigned* SPT = (unsigned*)(F.ws + WS_SPT);
    for (int idx = F.vcu * (NWAVES * 64) + F.tid; idx < 32 * 4096; idx += F.G * NWAVES * 64) {
        const int bh = idx >> 12, j = idx & 4095, e = j >> 5, d2 = (j & 31) * 2;
        float sx = 0.f, sy = 0.f;
#pragma unroll 1
        for (int n0 = 0; n0 < 32; n0 += 8) {
            f32x2v dv[8], dc[8];
#pragma unroll
            for (int k = 0; k < 8; ++k) { const size_t item = (size_t)bh * 32 + n0 + k; dv[k] = *(const f32x2v*)(dST + (item * 128 + e) * 64 + d2); dc[k] = *(const f32x2v*)(decay + item * 64 + d2); }
#pragma unroll
            for (int k = 0; k < 8; ++k) { const size_t item = (size_t)bh * 32 + n0 + k; SPT[((item * 128 + e) * 64 + d2) >> 1] = pk2(sx, sy); sx = dc[k].x * sx + dv[k].x; sy = dc[k].y * sy + dv[k].y; }
        }
    }
}
__device__ __forceinline__ void gla_pass3(Frame& F, int l) {
    bf16_t* proj = (bf16_t*)(F.ws + WS_R0); const bf16_t* SPT = (const bf16_t*)(F.ws + WS_SPT); const unsigned* OI = (const unsigned*)(F.ws + WS_OI);
    const float* norm_g = F.in[F.z + 14] + l * 512;
    const int ct = F.wave & 3;
    for (int item = F.vcu * 2 + (F.wave >> 2); item < BATCH * 4 * 32; item += F.G * 2) {
        int lane_ = F.lane; asm volatile("" : "+v"(lane_));
        const int lane = lane_, fr = lane & 15, fq = lane >> 4;
        const int b = item >> 7, h = (item >> 5) & 3, n = item & 31;
        const size_t row0 = (size_t)b * SEQ + 64 * n + 16 * ct;
        bf16x8 qa[2];
#pragma unroll
        for (int ks = 0; ks < 2; ++ks) qa[ks] = *(const bf16x8*)(proj + (row0 + fr) * PW + C_GQ + h * 64 + 32 * ks + 8 * fq);
        f32x4 acc[8];
#pragma unroll
        for (int et = 0; et < 8; ++et) { const uint2 oi = *(const uint2*)(OI + ((((size_t)item * 4 + ct) * 8 + et) * 64 + lane) * 2);
            acc[et] = (f32x4){blo(oi.x), bhi(oi.x), blo(oi.y), bhi(oi.y)};
#pragma unroll
            for (int ks = 0; ks < 2; ++ks) { const bf16x8 sb = *(const bf16x8*)(SPT + ((size_t)item * 128 + 16 * et + fr) * 64 + 32 * ks + 8 * fq); acc[et] = MFMA16(qa[ks], sb, acc[et]); } }
        float ss[4];
#pragma unroll
        for (int j = 0; j < 4; ++j) { float s = 0.f;
#pragma unroll
            for (int et = 0; et < 8; ++et) s += acc[et][j] * acc[et][j];
            s += swz_xor<1>(s); s += swz_xor<2>(s); s += swz_xor<4>(s); s += swz_xor<8>(s);
            ss[j] = rsqrtf(s * (1.f / 128.f) + EPS); }
#pragma unroll
        for (int et = 0; et < 8; ++et) { const float ng = norm_g[h * 128 + 16 * et + fr];
#pragma unroll
            for (int j = 0; j < 4; ++j) { bf16_t* rp = proj + (row0 + 4 * fq + j) * PW + h * 128 + 16 * et + fr; const float rr = bf2f(rp[C_GR]);
                rp[C_YGLA] = f2bf(acc[et][j] * ss[j] * ng * siluf_(rr)); } }
    }
}


__device__ __forceinline__ void run_phase(Frame& F, int ph) {
    bf16_t* wb = (bf16_t*)(F.ws + WS_W); bf16_t* u = (bf16_t*)(F.ws + WS_U); bf16_t* y = (bf16_t*)(F.ws + WS_Y);
    bf16_t* hid = (bf16_t*)(F.ws + WS_R0); bf16_t* proj = (bf16_t*)(F.ws + WS_R0);
#if defined(TAB_KERNEL)
    if (ph == PH_PROLOGUE) { ada_phase(F); convert_layer(F, 0); return; }
#else
    if (ph == PH_PROLOGUE) { ada_phase(F); convert_layer(F, 0); s5_tables(F, 0); return; }
#endif
    if (ph == PH_ROW0) { rowpass_phase(F, 0, 0); return; }
    const int l = (ph - PH_LAYER0) / NPL, s = (ph - PH_LAYER0) % NPL;
    const int cid = F.cid;
    switch (s) {
    case S_UP1: case S_UP2: {
        typedef pg8::GemmT<D, D, D, 0, 0> GT; GT g{u, wb + (s == S_UP1 ? W_UP1 : W_UP2)}; pg8::StaticOrder S; S.init(M, 2 * DFF, F.G, cid);
        pg8::EpiSwiGLU E{hid}; pg8::gemm_phase<pg8::EpiSwiGLU, pg8::StaticOrder, GT, true, true>(F.lds + RING_OFF, g, S, E); break; }
    case S_DN1: case S_DN2: {
        typedef pg8::GemmT<DFF, DFF, DFF, 0, 0> GT; GT g{hid, wb + (s == S_DN1 ? W_DN1 : W_DN2)}; pg8::StaticOrder S; S.init(M, D, F.G, cid);
        typedef pg8::EpiStore<D, 0> ET; ET E{y}; pg8::gemm_phase<ET, pg8::StaticOrder, GT, true, true>(F.lds + RING_OFF, g, S, E); break; }
    case S_ROWA: rowpass_phase(F, l, 1); break;
    case S_WIN: {
        typedef pg8::GemmT<D, D, D, 0, 0> GT; GT g{u, wb + W_IN}; pg8::StaticOrder S; S.init(M, PW, F.G, cid);
        typedef pg8::EpiStore<PW, 1> ET; ET E{proj}; pg8::gemm_phase<ET, pg8::StaticOrder, GT, true, true>(F.lds + RING_OFF, g, S, E); break; }
    case S_DFIN: dfin_phase(F, l); break;
    case S_GLU: {
        typedef pg8::GemmT<PW, 512, 512, 0, 0> GT; GT g{proj + C_YS5PRE, wb + W_GLU}; pg8::StaticOrder S; S.init(M, 1024, F.G, cid);
        pg8::EpiGLU E{proj, F.in[F.z + 26] + l * 1024}; pg8::gemm_phase<pg8::EpiGLU, pg8::StaticOrder, GT, true, true>(F.lds + RING_OFF, g, S, E); break; }
    case S_BRANCH: {
        typedef pg8::GemmT<PW, 512, 512, 512 * 2, 1024 * 512 * 2> GT; GT g{proj + C_YGLA, wb + W_BR}; pg8::StaticOrder S; S.init(M, D, F.G, cid, 3);
        pg8::EpiBranch E{proj}; pg8::gemm_phase<pg8::EpiBranch, pg8::StaticOrder, GT, true, true>(F.lds + RING_OFF, g, S, E); break; }
    case S_WOUT: {
        typedef pg8::GemmT<PW, D, D, 0, 0> GT; GT g{proj + C_MERGED, wb + W_OUT}; pg8::StaticOrder S; S.init(M, D, F.G, cid);
        typedef pg8::EpiStore<D, 0> ET; ET E{y}; pg8::gemm_phase<ET, pg8::StaticOrder, GT, true, true>(F.lds + RING_OFF, g, S, E); break; }
    case S_ROWB: rowpass_phase(F, l, 2); break;
    case S_ROWC: rowpass_phase(F, l, 3); if (l + 1 < DEPTH) { convert_layer(F, l + 1);
#if !defined(TAB_KERNEL)
            s5_tables(F, l + 1);
#endif
        } break;
    case S_MIX1: if (F.rep == 0) gla_pass1(F, l); s5_pass<false>(F, l); break;
    case S_MIX2: gla_pass2(F); s5_carry(F, l); break;
    case S_MIX3: gla_pass3(F, l); if (F.rep == 0) s5_pass<true>(F, l); break;
    case S_ATTN: { const attn_body::StaticOrder S(F.G, F.vcu); attn_body::attn_phase<attn_body::StaticOrder>(F.ldsg + RING_OFF, (const attn_body::bf16*)proj, F.in[F.z + 2], S); break; }
    default: break;
    }
}

__device__ __forceinline__ const void* opaque_sptr(const void* p) {
    unsigned lo = (unsigned)(uintptr_t)p, hi = (unsigned)((uintptr_t)p >> 32); asm volatile("" : "+s"(lo), "+s"(hi)); const void* q = (const void*)(((uintptr_t)hi << 32) | lo);
#if defined(__HIP_DEVICE_COMPILE__)
    __builtin_assume(!__builtin_amdgcn_is_shared(q)); __builtin_assume(!__builtin_amdgcn_is_private(q));
#endif
    return q;
}
__device__ __forceinline__ const void* opaque_ptr(const void* p) {
    unsigned lo = (unsigned)(uintptr_t)p, hi = (unsigned)((uintptr_t)p >> 32); asm volatile("" : "+v"(lo), "+v"(hi));
    lo = __builtin_amdgcn_readfirstlane(lo); hi = __builtin_amdgcn_readfirstlane(hi); return (const void*)(((uintptr_t)hi << 32) | lo);
}
#if defined(TAB_KERNEL)
__global__ void __launch_bounds__(NWAVES * 64) k_tables(Args args) {
    Frame F; F.lds = nullptr; F.ldsg = nullptr; F.tid = threadIdx.x; F.lane = F.tid & 63; F.wave = F.tid >> 6; F.G = 4; F.z = 0; F.cid = 0; F.rep = 0;
    F.in = args.in; F.out = args.out; F.ws = args.ws; F.vcu = blockIdx.x & 3;
    s5_tables(F, (int)(blockIdx.x >> 2));
}
#endif
__global__ void __launch_bounds__(NWAVES * 64, 2) mk_fwd(Args args) {
    extern __shared__ __attribute__((aligned(16))) unsigned char lds[];
    Frame F;
    F.lds = (LAS unsigned char*)lds; F.ldsg = (char*)lds;
    F.tid = threadIdx.x; F.lane = F.tid & 63; F.wave = __builtin_amdgcn_readfirstlane(F.tid >> 6);
    F.G = gridDim.x; int vcu0; { const int bx = blockIdx.x; vcu0 = (F.G % 8 == 0) ? (bx % 8) * (F.G / 8) + bx / 8 : bx; } F.vcu = vcu0; F.cid = blockIdx.x; F.z = 0;
    F.in = args.in; F.out = args.out; F.ws = args.ws;
    for (int u = F.tid; u < (LDS_BYTES - LDSCTL_OFF) / 4; u += NWAVES * 64) ((LAS unsigned*)(F.lds + LDSCTL_OFF))[u] = 0u;
    __syncthreads();
    XcdBarrier bar; bar.bar = (unsigned*)(args.ws + WS_CTL) + CW_BAR; bar.x = 0; bar.st = nullptr;
    const bool multi = (__builtin_amdgcn_readfirstlane(args.ph_hi) - __builtin_amdgcn_readfirstlane(args.ph_lo)) > 1;
    if (multi) bar = xcd_barrier_post((unsigned*)(args.ws + WS_CTL) + CW_BAR, (volatile LAS unsigned*)(F.lds + MISC_OFF) + 8);
    const int ph_lo = __builtin_amdgcn_readfirstlane(args.ph_lo), ph_hi = __builtin_amdgcn_readfirstlane(args.ph_hi);
#if defined(DBL_MASK)
    for (int it_ = 2 * ph_lo; it_ < 2 * ph_hi; ++it_) {
        const int ph = it_ >> 1; { const int s_ = ph < PH_LAYER0 ? 16 + ph : (ph - PH_LAYER0) % NPL; if ((it_ & 1) && !((DBL_MASK >> s_) & 1)) continue; }
#else
    for (int ph = ph_lo; ph < ph_hi; ++ph) {
#endif
        int t_ = threadIdx.x; asm volatile("" : "+v"(t_));
        F.tid = t_; F.lane = t_ & 63; F.wave = __builtin_amdgcn_readfirstlane(t_ >> 6);
        { int z_ = 0, v_ = vcu0, g_ = (int)gridDim.x, c_ = (int)blockIdx.x; asm volatile("" : "+s"(z_), "+s"(v_), "+s"(g_), "+s"(c_));
          F.z = z_; F.vcu = v_; F.G = g_; F.cid = c_;
          F.ws = args.ws + z_; F.out = args.out + z_; }
#if defined(DBL_MASK)
        F.rep = it_ & 1;
#else
        F.rep = 0;
#endif
        run_phase(F, ph);
#if defined(DBL_MASK)
        if (it_ + 1 < 2 * ph_hi) {
#else
        if (ph + 1 < ph_hi) {
#endif
            XcdBarrier b2 = bar; b2.bar = bar.bar + F.z; { unsigned x_ = bar.x; asm volatile("" : "+s"(x_)); b2.x = x_; } xcd_barrier(b2); }
    }
}

extern "C" void kernel_launch(void* const* d_in, const int* in_sizes, int n_in, void* d_out, int out_size, void* d_ws, size_t ws_size, hipStream_t stream) {
    static int grid = 0;
    if (grid == 0) {
        if (n_in != 29 || in_sizes[0] != M * D || out_size != M * D || ws_size < WS_END) {
            fprintf(stderr, "kernel_launch: unexpected shapes/workspace: n_in %d in0 %d out %d ws %zu (need %zu)\n", n_in, n_in > 0 ? in_sizes[0] : -1, out_size, ws_size, (size_t)WS_END); grid = -1; return; }
        int dev = 0, cus = 0;
        if (hipGetDevice(&dev) != hipSuccess || hipDeviceGetAttribute(&cus, hipDeviceAttributeMultiprocessorCount, dev) != hipSuccess) { grid = -1; return; }
        if (hipFuncSetAttribute((const void*)mk_fwd, hipFuncAttributeMaxDynamicSharedMemorySize, LDS_BYTES) != hipSuccess) { fprintf(stderr, "kernel_launch: hipFuncSetAttribute failed\n"); grid = -1; return; }
        grid = cus;
    }
    if (grid < 0) return;
    Args a{};
    for (int i = 0; i < 29; ++i) a.in[i] = (const float*)d_in[i];
    a.out = (float*)d_out; a.ws = (unsigned char*)d_ws;
    if (hipMemsetAsync((char*)d_ws + WS_CTL, 0, CTL_ZERO_BYTES, stream) != hipSuccess) { fprintf(stderr, "kernel_launch: memset failed\n"); return; }
    a.ph_lo = 0; a.ph_hi = N_PHASES;
#if defined(TAB_KERNEL)
    hipLaunchKernelGGL(k_tables, dim3(8), dim3(NWAVES * 64), 0, stream, a);
#endif
    hipLaunchKernelGGL(mk_fwd, dim3(grid), dim3(NWAVES * 64), LDS_BYTES, stream, a);
}
```
